# Optimizing an MI355X kernel written in HIP

```python
import jax
import jax.numpy as jnp
from jax import lax
import numpy as np


D_MODEL = 1024
BATCH = 8
SEQ = 4096
DEPTH = 4

GRID_W = 64
CTX_LEN = 256
NORM_EPS = 1e-6
ROPE_BASE = 10000.0
NEG_INF = -1e30

A_HEADS = 8
A_KV_HEADS = 2
A_HEAD_DIM = 64
WINDOW = 128
A_BLOCK = 128
B_WIDTH = 512
B_GROUPS = 4
B_CHUNK = 128
C_HEADS = 8
C_Q_LORA = 384
C_KV_LORA = 256
C_NOPE = 64
C_ROPE = 32
C_V = 64
C_BLOCK = 128
D_WIDTH = 512
D_CONV = 3
N_EXPERTS = 16
EXPERT_FF = 1024
EC_FACTOR = 2

A_Q_W = A_HEADS * A_HEAD_DIM
A_KV_W = A_KV_HEADS * A_HEAD_DIM
EVEN_CTX_COLS = 2 * A_KV_W
EVEN_IN = EVEN_CTX_COLS + A_Q_W + 2 * B_WIDTH
EVEN_OUT = A_Q_W + B_WIDTH
ODD_CTX_COLS = C_KV_LORA + C_ROPE
ODD_IN = ODD_CTX_COLS + C_Q_LORA + 3 * D_WIDTH
ODD_OUT = C_HEADS * C_V + D_WIDTH
N_EVEN = (DEPTH + 1) // 2
N_ODD = DEPTH // 2

kernel_name = 'hybrid_diffusion_backbone'


def rms_norm(x, g):
    xf = x.astype(jnp.float32)
    y = xf * lax.rsqrt(jnp.mean(xf * xf, axis=-1, keepdims=True) + NORM_EPS)
    return (y * g.astype(jnp.float32)).astype(x.dtype)


def layer_norm(x, g):
    xf = x.astype(jnp.float32)
    mu = jnp.mean(xf, axis=-1, keepdims=True)
    var = jnp.mean(jnp.square(xf - mu), axis=-1, keepdims=True)
    return ((xf - mu) * lax.rsqrt(var + NORM_EPS) * g.astype(jnp.float32)).astype(x.dtype)


def axial_rope_tables(rows, rot_dim):
    row = jnp.repeat(jnp.arange(rows, dtype=jnp.float32), GRID_W)
    col = jnp.tile(jnp.arange(GRID_W, dtype=jnp.float32), rows)
    n_freq = rot_dim // 4
    inv_freq = ROPE_BASE ** (-jnp.arange(n_freq, dtype=jnp.float32) / n_freq)
    ang = jnp.concatenate([row[:, None] * inv_freq[None, :], col[:, None] * inv_freq[None, :]], axis=-1)
    return jnp.cos(ang), jnp.sin(ang)


def apply_rope(x, cos, sin):
    x1, x2 = jnp.split(x, 2, axis=-1)
    cs = cos[None, :, None, :].astype(x.dtype)
    sn = sin[None, :, None, :].astype(x.dtype)
    return jnp.concatenate([x1 * cs - x2 * sn, x2 * cs + x1 * sn], axis=-1)


def gqa_attend(q, k, v, mask, sink, scale):
    s = jnp.einsum('bqhgd,bkhd->bhgqk', q, k).astype(jnp.float32) * scale
    if mask is not None:
        s = jnp.where(mask, s, NEG_INF)
    if sink is not None:
        sk = jnp.broadcast_to(sink.astype(jnp.float32)[None, :, :, None, None], s.shape[:-1] + (1,))
        s = jnp.concatenate([s, sk], axis=-1)
    p = jax.nn.softmax(s, axis=-1)
    if sink is not None:
        p = p[..., :-1]
    return jnp.einsum('bhgqk,bkhd->bqhgd', p.astype(v.dtype), v)


def window_attention(q, k, v, k_ctx, v_ctx, sink_g, scale):
    bsz, n = q.shape[0], q.shape[1]
    g = A_HEADS // A_KV_HEADS
    nb = n // A_BLOCK
    span = A_BLOCK + 2 * WINDOW
    pad = ((0, 0), (WINDOW, WINDOW), (0, 0), (0, 0))
    kp = jnp.pad(k, pad)
    vp = jnp.pad(v, pad)
    qi = jnp.arange(A_BLOCK)
    kj = jnp.arange(span)
    band = jnp.abs(kj[None, :] - WINDOW - qi[:, None]) <= WINDOW
    ctx_ok = jnp.ones((A_BLOCK, k_ctx.shape[1]), dtype=jnp.bool_)

    def block(nidx):
        start = nidx * A_BLOCK
        qb = lax.dynamic_slice_in_dim(q, start, A_BLOCK, axis=1).reshape(bsz, A_BLOCK, A_KV_HEADS, g, A_HEAD_DIM)
        kb = lax.dynamic_slice_in_dim(kp, start, span, axis=1)
        vb = lax.dynamic_slice_in_dim(vp, start, span, axis=1)
        kpos = start - WINDOW + kj
        mask = band & ((kpos >= 0) & (kpos < n))[None, :]
        mask = jnp.concatenate([mask, ctx_ok], axis=1)
        o = gqa_attend(qb, jnp.concatenate([kb, k_ctx], axis=1), jnp.concatenate([vb, v_ctx], axis=1), mask, sink_g, scale)
        return o.reshape(bsz, A_BLOCK, A_Q_W)

    out = lax.map(block, jnp.arange(nb))
    return jnp.moveaxis(out, 0, 1).reshape(bsz, n, A_Q_W)


def dense_block_attention(q, k_all, v_all, scale):
    bsz, n, h, _ = q.shape
    dv = v_all.shape[-1]
    nb = n // C_BLOCK

    def block(nidx):
        qb = lax.dynamic_slice_in_dim(q, nidx * C_BLOCK, C_BLOCK, axis=1)
        return gqa_attend(qb[:, :, :, None], k_all, v_all, None, None, scale)[:, :, :, 0]

    out = lax.map(block, jnp.arange(nb))
    return jnp.moveaxis(out, 0, 1).reshape(bsz, n, h * dv)


def spatial_gating(z, norm_g, w_s, b_s):
    bsz, n, _ = z.shape
    u, v = jnp.split(jax.nn.gelu(z), 2, axis=-1)
    v = layer_norm(v, norm_g)
    vc = v.reshape(bsz, n // B_CHUNK, B_CHUNK, B_GROUPS, B_WIDTH // B_GROUPS)
    mixed = jnp.einsum('gpq,bcqgd->bcpgd', w_s, vc) + b_s.T[None, None, :, :, None]
    return u * mixed.reshape(bsz, n, B_WIDTH)


def gated_short_conv(z, conv_w):
    gb, gc, hh = jnp.split(z, 3, axis=-1)
    u = gc * hh
    n = u.shape[1]
    half = D_CONV // 2
    up = jnp.pad(u, ((0, 0), (half, half), (0, 0)))
    conv = sum(up[:, j:j + n] * conv_w[j] for j in range(D_CONV))
    return gb * conv


def mla_q(cq, q_norm_g, w_uq, cos, sin):
    bsz, n, _ = cq.shape
    q = (rms_norm(cq, q_norm_g) @ w_uq).reshape(bsz, n, C_HEADS, C_NOPE + C_ROPE)
    q_nope, q_rope = q[..., :C_NOPE], q[..., C_NOPE:]
    if cos is not None:
        q_rope = apply_rope(q_rope, cos, sin)
    return jnp.concatenate([q_nope, q_rope], axis=-1)


def mla_kv(ckv, kr, kv_norm_g, w_ukv, cos, sin):
    bsz, n, _ = ckv.shape
    kv = (rms_norm(ckv, kv_norm_g) @ w_ukv).reshape(bsz, n, C_HEADS, C_NOPE + C_V)
    k_nope, v = kv[..., :C_NOPE], kv[..., C_NOPE:]
    kr = kr[:, :, None, :]
    if cos is not None:
        kr = apply_rope(kr, cos, sin)
    k = jnp.concatenate([k_nope, jnp.broadcast_to(kr, (bsz, n, C_HEADS, C_ROPE))], axis=-1)
    return k, v


def even_mixer(h_lat, h_ctx, w_in, sink, sgu_norm_g, sgu_w, sgu_b, w_out, cos, sin, need_ctx):
    bsz, n_lat, _ = h_lat.shape
    n_ctx = h_ctx.shape[1]
    g = A_HEADS // A_KV_HEADS
    scale = A_HEAD_DIM ** -0.5
    sink_g = sink.reshape(A_KV_HEADS, g)
    z_lat = h_lat @ w_in
    z_ctx = h_ctx @ (w_in if need_ctx else w_in[:, :EVEN_CTX_COLS])
    k_ctx = z_ctx[..., :A_KV_W].reshape(bsz, n_ctx, A_KV_HEADS, A_HEAD_DIM)
    v_ctx = z_ctx[..., A_KV_W:EVEN_CTX_COLS].reshape(bsz, n_ctx, A_KV_HEADS, A_HEAD_DIM)
    k_lat = apply_rope(z_lat[..., :A_KV_W].reshape(bsz, n_lat, A_KV_HEADS, A_HEAD_DIM), cos, sin)
    v_lat = z_lat[..., A_KV_W:EVEN_CTX_COLS].reshape(bsz, n_lat, A_KV_HEADS, A_HEAD_DIM)
    q_lat = apply_rope(z_lat[..., EVEN_CTX_COLS:EVEN_CTX_COLS + A_Q_W].reshape(bsz, n_lat, A_HEADS, A_HEAD_DIM), cos, sin)
    o_lat = window_attention(q_lat, k_lat, v_lat, k_ctx, v_ctx, sink_g, scale)
    s_lat = spatial_gating(z_lat[..., EVEN_CTX_COLS + A_Q_W:], sgu_norm_g, sgu_w, sgu_b)
    y_lat = jnp.concatenate([o_lat, s_lat], axis=-1) @ w_out
    if not need_ctx:
        return y_lat, None
    q_ctx = z_ctx[..., EVEN_CTX_COLS:EVEN_CTX_COLS + A_Q_W].reshape(bsz, n_ctx, A_KV_HEADS, g, A_HEAD_DIM)
    o_ctx = gqa_attend(q_ctx, k_ctx, v_ctx, None, sink_g, scale).reshape(bsz, n_ctx, A_Q_W)
    s_ctx = spatial_gating(z_ctx[..., EVEN_CTX_COLS + A_Q_W:], sgu_norm_g, sgu_w, sgu_b)
    y_ctx = jnp.concatenate([o_ctx, s_ctx], axis=-1) @ w_out
    return y_lat, y_ctx


def odd_mixer(h_lat, h_ctx, w_in, q_norm_g, w_uq, kv_norm_g, w_ukv, conv_w, w_out, cos, sin, need_ctx):
    bsz, n_ctx = h_ctx.shape[0], h_ctx.shape[1]
    scale = (C_NOPE + C_ROPE) ** -0.5
    z_lat = h_lat @ w_in
    z_ctx = h_ctx @ (w_in if need_ctx else w_in[:, :ODD_CTX_COLS])
    k_ctx, v_ctx = mla_kv(z_ctx[..., :C_KV_LORA], z_ctx[..., C_KV_LORA:ODD_CTX_COLS], kv_norm_g, w_ukv, None, None)
    k_lat, v_lat = mla_kv(z_lat[..., :C_KV_LORA], z_lat[..., C_KV_LORA:ODD_CTX_COLS], kv_norm_g, w_ukv, cos, sin)
    q_lat = mla_q(z_lat[..., ODD_CTX_COLS:ODD_CTX_COLS + C_Q_LORA], q_norm_g, w_uq, cos, sin)
    k_all = jnp.concatenate([k_lat, k_ctx], axis=1)
    v_all = jnp.concatenate([v_lat, v_ctx], axis=1)
    o_lat = dense_block_attention(q_lat, k_all, v_all, scale)
    c_lat = gated_short_conv(z_lat[..., ODD_CTX_COLS + C_Q_LORA:], conv_w)
    y_lat = jnp.concatenate([o_lat, c_lat], axis=-1) @ w_out
    if not need_ctx:
        return y_lat, None
    q_ctx = mla_q(z_ctx[..., ODD_CTX_COLS:ODD_CTX_COLS + C_Q_LORA], q_norm_g, w_uq, None, None)
    o_ctx = gqa_attend(q_ctx[:, :, :, None], k_ctx, v_ctx, None, None, scale)[:, :, :, 0].reshape(bsz, n_ctx, C_HEADS * C_V)
    c_ctx_out = gated_short_conv(z_ctx[..., ODD_CTX_COLS + C_Q_LORA:], conv_w)
    y_ctx = jnp.concatenate([o_ctx, c_ctx_out], axis=-1) @ w_out
    return y_lat, y_ctx


def expert_choice_ffn(h, w_router, w1, w3, w2):
    n_tok, d = h.shape[1], h.shape[2]
    cap = EC_FACTOR * n_tok // N_EXPERTS
    aff = jax.nn.softmax(jnp.einsum('bnd,de->bne', h, w_router).astype(jnp.float32), axis=-1)
    gate, idx = lax.top_k(jnp.swapaxes(aff, 1, 2), cap)
    xs = jax.vmap(lambda hb, ib: hb[ib])(h, idx)
    a = jnp.einsum('becd,edf->becf', xs, w1)
    b = jnp.einsum('becd,edf->becf', xs, w3)
    y = jnp.einsum('becf,efd->becd', jax.nn.silu(a) * b, w2) * gate[..., None].astype(h.dtype)

    def combine(yb, ib):
        return jnp.zeros((n_tok, d), h.dtype).at[ib.reshape(-1)].add(yb.reshape(-1, d))

    return jax.vmap(combine)(y, idx)


def setup_inputs(seed: int = 0) -> dict:
    key = jax.random.key(seed)
    ks = iter(jax.random.split(key, 32))
    D = D_MODEL

    def nrm(shape, scale):
        return jax.random.normal(next(ks), shape, jnp.float32) * scale

    return {
        'x': nrm((BATCH, SEQ, D), 1.0),
        'c': nrm((BATCH, D), 1.0),
        'ctx': nrm((BATCH, CTX_LEN, D), 1.0),
        'c_ctx': nrm((D,), 1.0),
        'mod_w': nrm((DEPTH, D, 6 * D), 0.5 * D ** -0.5),
        'mod_b': nrm((DEPTH, 6 * D), 0.01),
        'norm1_g': 1.0 + nrm((DEPTH, D), 0.05),
        'norm2_g': 1.0 + nrm((DEPTH, D), 0.05),
        'ev_w_in': nrm((N_EVEN, D, EVEN_IN), D ** -0.5),
        'ev_sink': nrm((N_EVEN, A_HEADS), 0.5),
        'ev_sgu_norm_g': 1.0 + nrm((N_EVEN, B_WIDTH), 0.05),
        'ev_sgu_w': nrm((N_EVEN, B_GROUPS, B_CHUNK, B_CHUNK), B_CHUNK ** -0.5),
        'ev_sgu_b': nrm((N_EVEN, B_GROUPS, B_CHUNK), 0.1),
        'ev_w_out': nrm((N_EVEN, EVEN_OUT, D), EVEN_OUT ** -0.5),
        'od_w_in': nrm((N_ODD, D, ODD_IN), D ** -0.5),
        'od_q_norm_g': 1.0 + nrm((N_ODD, C_Q_LORA), 0.05),
        'od_w_uq': nrm((N_ODD, C_Q_LORA, C_HEADS * (C_NOPE + C_ROPE)), C_Q_LORA ** -0.5),
        'od_kv_norm_g': 1.0 + nrm((N_ODD, C_KV_LORA), 0.05),
        'od_w_ukv': nrm((N_ODD, C_KV_LORA, C_HEADS * (C_NOPE + C_V)), C_KV_LORA ** -0.5),
        'od_conv_w': nrm((N_ODD, D_CONV, D_WIDTH), D_CONV ** -0.5),
        'od_w_out': nrm((N_ODD, ODD_OUT, D), ODD_OUT ** -0.5),
        'router_w': nrm((DEPTH, D, N_EXPERTS), D ** -0.5),
        'exp_w1': nrm((DEPTH, N_EXPERTS, D, EXPERT_FF), D ** -0.5),
        'exp_w3': nrm((DEPTH, N_EXPERTS, D, EXPERT_FF), D ** -0.5),
        'exp_w2': nrm((DEPTH, N_EXPERTS, EXPERT_FF, D), EXPERT_FF ** -0.5),
        'final_g': 1.0 + nrm((D,), 0.05),
    }


def reference(x, c, ctx, c_ctx, mod_w, mod_b, norm1_g, norm2_g, ev_w_in, ev_sink, ev_sgu_norm_g, ev_sgu_w, ev_sgu_b, ev_w_out, od_w_in, od_q_norm_g, od_w_uq, od_kv_norm_g, od_w_ukv, od_conv_w, od_w_out, router_w, exp_w1, exp_w3, exp_w2, final_g):
    rows = x.shape[1] // GRID_W
    cos_a, sin_a = axial_rope_tables(rows, A_HEAD_DIM)
    cos_c, sin_c = axial_rope_tables(rows, C_ROPE)
    silu_c = jax.nn.silu(c)
    silu_cc = jax.nn.silu(c_ctx)[None, :]
    x_lat, x_ctx = x, ctx
    for layer in range(DEPTH):
        need_ctx = layer < DEPTH - 1
        m_lat = jnp.split((silu_c @ mod_w[layer] + mod_b[layer])[:, None, :], 6, axis=-1)
        m_ctx = jnp.split((silu_cc @ mod_w[layer] + mod_b[layer])[:, None, :], 6, axis=-1)
        h_lat = rms_norm(x_lat, norm1_g[layer]) * (1 + m_lat[1]) + m_lat[0]
        h_ctx = rms_norm(x_ctx, norm1_g[layer]) * (1 + m_ctx[1]) + m_ctx[0]
        i = layer // 2
        if layer % 2 == 0:
            y_lat, y_ctx = even_mixer(h_lat, h_ctx, ev_w_in[i], ev_sink[i], ev_sgu_norm_g[i], ev_sgu_w[i], ev_sgu_b[i], ev_w_out[i], cos_a, sin_a, need_ctx)
        else:
            y_lat, y_ctx = odd_mixer(h_lat, h_ctx, od_w_in[i], od_q_norm_g[i], od_w_uq[i], od_kv_norm_g[i], od_w_ukv[i], od_conv_w[i], od_w_out[i], cos_c, sin_c, need_ctx)
        x_lat = x_lat + m_lat[2] * y_lat
        h_lat = rms_norm(x_lat, norm2_g[layer]) * (1 + m_lat[4]) + m_lat[3]
        x_lat = x_lat + m_lat[5] * expert_choice_ffn(h_lat, router_w[layer], exp_w1[layer], exp_w3[layer], exp_w2[layer])
        if need_ctx:
            x_ctx = x_ctx + m_ctx[2] * y_ctx
            h_ctx = rms_norm(x_ctx, norm2_g[layer]) * (1 + m_ctx[4]) + m_ctx[3]
            x_ctx = x_ctx + m_ctx[5] * expert_choice_ffn(h_ctx, router_w[layer], exp_w1[layer], exp_w3[layer], exp_w2[layer])
    return rms_norm(x_lat, final_g)
```

```cpp
#include <hip/hip_runtime.h>
#include <cstdio>
#include <cstdint>

#ifndef MFMA_MASK
#define MFMA_MASK 0x3f
#endif
#ifndef MFMA_ATT
#define MFMA_ATT 3
#endif
#ifndef REPEAT_MASK
#define REPEAT_MASK 0
#endif
#ifndef MFMA_SGU
#define MFMA_SGU 1
#endif
#ifndef ATT_CREF
#define ATT_CREF 1
#endif
#ifndef N2_MFMA
#define N2_MFMA 1
#endif
#ifndef FP8_FFN
#define FP8_FFN 1
#endif
#ifndef FP8_F1
#define FP8_F1 FP8_FFN
#endif
#ifndef FP8_F2
#define FP8_F2 FP8_FFN
#endif
#ifndef FP8_Y
#define FP8_Y 1
#endif
#ifndef MK_PER_PHASE
#define MK_PER_PHASE 0
#endif

constexpr int D = 1024, BATCH = 8, SEQ = 4096, DEPTH = 4, CTXL = 256;
constexpr int NLAT = BATCH * SEQ, NCTX = BATCH * CTXL, MT = NLAT + NCTX;
constexpr int NE = 16, FF = 1024, CAP_L = 512, CAP_C = 32, EROWS = BATCH * (CAP_L + CAP_C);
constexpr int GROWS = NE * EROWS;
constexpr int ZE = 1792, ZO = 2304;
constexpr float EPS = 1e-6f;
constexpr float RS_SCALE = 16777216.0f, RS_INV = 1.0f / 16777216.0f;
constexpr float F8_SA = 16.f, F8_SW = 64.f, F8_SG = 8.f, F8_SY = 16.f;
constexpr float LOG2E_ = 1.4426950408889634f;
constexpr float QSCALE_E = 0.125f * LOG2E_, QSCALE_O = 0.10206207261596577f * LOG2E_;
constexpr int NWAVES = 8, NT = 512;

constexpr size_t MiB = 1u << 20;
constexpr size_t WS_CTL = 0, CTL_ZERO_BYTES = 1 * MiB;
constexpr size_t WS_MODV = 1 * MiB;
constexpr size_t WS_TAB = 2 * MiB;
constexpr size_t WS_WSB = 2 * MiB + 1536 * 1024;
constexpr size_t WS_AFF = 4 * MiB;
constexpr size_t WS_AFFT = 7 * MiB;
constexpr size_t WS_INV = 10 * MiB;
constexpr size_t WS_SRC = 13 * MiB;
constexpr size_t WS_RS = 14 * MiB;
constexpr size_t WS_WSMALL = 16 * MiB;
constexpr size_t OFF_WINE = 0, SZ_WINE = (size_t)ZE * D * 2;
constexpr size_t OFF_WOUTE = OFF_WINE + 2 * SZ_WINE, SZ_WOUT = (size_t)D * D * 2;
constexpr size_t OFF_WINO = OFF_WOUTE + 2 * SZ_WOUT, SZ_WINO = (size_t)ZO * D * 2;
constexpr size_t OFF_WUQ = OFF_WINO + 2 * SZ_WINO, SZ_WUQ = (size_t)768 * 384 * 2;
constexpr size_t OFF_WUKV = OFF_WUQ + 2 * SZ_WUQ, SZ_WUKV = (size_t)1024 * 256 * 2;
constexpr size_t OFF_WOUTO = OFF_WUKV + 2 * SZ_WUKV;
static_assert(OFF_WOUTO + 2 * SZ_WOUT <= 28 * MiB, "small weights");
constexpr size_t WS_W13 = 44 * MiB, SZ_W13 = (size_t)2048 * 1024 * 2;
constexpr size_t WS_W2 = 300 * MiB, SZ_W2 = (size_t)1024 * 1024 * 2;
constexpr size_t WS_X = 428 * MiB;
constexpr size_t WS_H = 564 * MiB;
constexpr size_t WS_Z = 632 * MiB;
constexpr size_t WS_Y = 785 * MiB;
constexpr size_t WS_Q = WS_Y, WS_KV = WS_Y + 52 * MiB;
constexpr size_t WS_END = 921 * MiB;
static_assert(WS_W13 + 64 * SZ_W13 <= WS_W2 && WS_W2 + 64 * SZ_W2 <= WS_X && WS_X + (size_t)MT * D * 4 <= WS_H && WS_H + (size_t)MT * D * 2 <= WS_Z, "ws map 1");
static_assert(WS_Z + (size_t)MT * ZO * 2 <= WS_Y && WS_Z + (size_t)GROWS * 1024 * 2 <= WS_Y && WS_Y + (size_t)GROWS * 1024 * 2 <= WS_END, "ws map 2");
static_assert(WS_Q + (size_t)MT * 768 * 2 <= WS_KV && WS_KV + (size_t)MT * 1024 * 2 <= WS_END, "ws map 3");
constexpr int CW_BAR = 4096;

constexpr int RING_BYTES = 131072;
constexpr int LDS_BYTES = 163840;
constexpr int LDSCTL_OFF = LDS_BYTES - 1024, MISC_OFF = LDSCTL_OFF + 320;

#define GAS __attribute__((address_space(1)))
#define LAS __attribute__((address_space(3)))
typedef unsigned short bf16;
typedef unsigned v4u __attribute__((ext_vector_type(4)));
typedef unsigned v2u __attribute__((ext_vector_type(2)));
typedef float f32x4 __attribute__((ext_vector_type(4)));
#define LDS_WAIT() asm volatile("s_waitcnt lgkmcnt(0)" ::: "memory")
#define VM_WAIT() asm volatile("s_waitcnt vmcnt(0)" ::: "memory")
__device__ __forceinline__ unsigned f2bf(float f) { unsigned u = __builtin_bit_cast(unsigned, f); return (u + 0x7fffu + ((u >> 16) & 1u)) >> 16; }
typedef float f32x2_ __attribute__((ext_vector_type(2)));
typedef __bf16 bf16x2_ __attribute__((ext_vector_type(2)));
__device__ __forceinline__ unsigned pk2(float lo, float hi) { f32x2_ v = {lo, hi}; bf16x2_ b = __builtin_convertvector(v, bf16x2_); return __builtin_bit_cast(unsigned, b); }
__device__ __forceinline__ float bflo(unsigned w) { return __builtin_bit_cast(float, w << 16); }
__device__ __forceinline__ float bfhi(unsigned w) { return __builtin_bit_cast(float, w & 0xffff0000u); }
__device__ __forceinline__ float bf2f(bf16 h) { return __builtin_bit_cast(float, (unsigned)h << 16); }
__device__ __forceinline__ unsigned pk4_fp8(float a, float b, float c, float d) { int w = 0; w = __builtin_amdgcn_cvt_pk_fp8_f32(a, b, w, false); w = __builtin_amdgcn_cvt_pk_fp8_f32(c, d, w, true); return (unsigned)w; }
__device__ __forceinline__ float clampf_(float x, float m) { return fminf(fmaxf(x, -m), m); }
template <bool W32> __device__ __forceinline__ void lane_swap(float v, float& r0, float& r1) {
    float a = v, b = v;
    if constexpr (W32) asm volatile("s_nop 1\n\tv_permlane32_swap_b32 %0, %1" : "+v"(a), "+v"(b));
    else asm volatile("s_nop 1\n\tv_permlane16_swap_b32 %0, %1" : "+v"(a), "+v"(b));
    r0 = a; r1 = b;
}
template <int CTRL> __device__ __forceinline__ float dpp_(float v) { return __builtin_bit_cast(float, __builtin_amdgcn_update_dpp(0, __builtin_bit_cast(int, v), CTRL, 0xF, 0xF, true)); }
__device__ __forceinline__ float wave_sum(float v) {
    v += dpp_<0xB1>(v); v += dpp_<0x4E>(v); v += dpp_<0x141>(v); v += dpp_<0x140>(v);
    float a, b; lane_swap<false>(v, a, b); v = a + b; lane_swap<true>(v, a, b); return a + b;
}
__device__ __forceinline__ float wave_max(float v) {
    v = fmaxf(v, dpp_<0xB1>(v)); v = fmaxf(v, dpp_<0x4E>(v)); v = fmaxf(v, dpp_<0x141>(v)); v = fmaxf(v, dpp_<0x140>(v));
    float a, b; lane_swap<false>(v, a, b); v = fmaxf(a, b); lane_swap<true>(v, a, b); return fmaxf(a, b);
}
__device__ __forceinline__ float sigmoidf_(float x) { return __builtin_amdgcn_rcpf(1.0f + __builtin_amdgcn_exp2f(-1.4426950408889634f * x)); }
__device__ __forceinline__ float gelu_tanh(float x) { return x * sigmoidf_(1.5957691216057308f * (x + 0.044715f * x * x * x)); }
__device__ __forceinline__ float siluf_(float x) { return x * sigmoidf_(x); }
__device__ __forceinline__ f32x2_ gelu_tanh2(f32x2_ x) {
    constexpr float c2 = -1.5957691216057308f * 1.4426950408889634f, c1 = c2 * 0.044715f;
    const f32x2_ w = (x * x) * c1 + c2, t = x * w;
    const f32x2_ d = (f32x2_){__builtin_amdgcn_exp2f(t.x), __builtin_amdgcn_exp2f(t.y)} + 1.0f;
    return x * (f32x2_){__builtin_amdgcn_rcpf(d.x), __builtin_amdgcn_rcpf(d.y)};
}
template <int SIN_NUM, int SOUT_NUM> __device__ __forceinline__ f32x2_ silu_gate2(f32x2_ a, f32x2_ b) {
    constexpr float inv = 1.0f / (float)SIN_NUM, k1 = -1.4426950408889634f * inv, k2 = inv * inv * (float)SOUT_NUM;
    const f32x2_ t = a * k1;
    const f32x2_ d = (f32x2_){__builtin_amdgcn_exp2f(t.x), __builtin_amdgcn_exp2f(t.y)} + 1.0f;
    return ((a * b) * k2) * (f32x2_){__builtin_amdgcn_rcpf(d.x), __builtin_amdgcn_rcpf(d.y)};
}

#define XB_TMO      128
#define XB_XCNT(j)  (256  + 64 * (j))
#define XB_XSUB(j)  (1280 + 64 * (j))
#define XB_XGEN(j)  (2304 + 64 * (j))
#define XB_TOP      3328
#define XB_TOPGEN   3392
#define XCD_BAR_WORDS 3456
#define XB_SPIN_CAP (1u << 25)
__device__ __forceinline__ unsigned xb_ld(unsigned* p)              { return __hip_atomic_load(p, __ATOMIC_RELAXED, __HIP_MEMORY_SCOPE_AGENT); }
__device__ __forceinline__ unsigned xb_add(unsigned* p, unsigned v) { return __hip_atomic_fetch_add(p, v, __ATOMIC_RELAXED, __HIP_MEMORY_SCOPE_AGENT); }
__device__ __forceinline__ unsigned xb_xcc_id() { return (unsigned)__builtin_amdgcn_s_getreg((3 << 11) | 20) & 0xFu; }
#define XB_SPIN(cond, bar) do { unsigned _sp = 0; while (cond) { __builtin_amdgcn_s_sleep(1); \
    if ((++_sp & 255u) == 0u) { if (xb_ld(&(bar)[XB_TMO])) break; if (_sp > XB_SPIN_CAP) { atomicAdd(&(bar)[XB_TMO], 1u); break; } } } } while (0)
struct XcdBarrier { unsigned* bar; unsigned x; volatile LAS unsigned* st; };
__device__ __forceinline__ XcdBarrier xcd_barrier_post(unsigned* bar, volatile LAS unsigned* st) {
    XcdBarrier b; b.bar = bar; b.x = xb_xcc_id(); b.st = st;
    if (threadIdx.x == 0) (void)xb_add(&bar[XB_XCNT(b.x)], 1u);
    return b;
}
__device__ __forceinline__ void xcd_barrier_complete(unsigned* bar, unsigned x, unsigned& nloc, unsigned& nx) {
    const unsigned G = gridDim.x * gridDim.y * gridDim.z;
    unsigned sum, cnt, mine, sp = 0u;
    for (;;) {
        sum = 0u; cnt = 0u; mine = 0u;
#pragma unroll
        for (unsigned j = 0; j < 16; ++j) { const unsigned c = xb_ld(&bar[XB_XCNT(j)]); sum += c; cnt += (c > 0u) ? 1u : 0u; mine = (j == x) ? c : mine; }
        if (sum == G) break;
        __builtin_amdgcn_s_sleep(1);
        if ((++sp & 255u) == 0u) { if (xb_ld(&bar[XB_TMO])) break; if (sp > XB_SPIN_CAP) { atomicAdd(&bar[XB_TMO], 1u); break; } }
    }
    nloc = mine > 0u ? mine : 1u; nx = cnt > 0u ? cnt : 1u;
}
__device__ __forceinline__ void xcd_barrier(const XcdBarrier& b) {
    asm volatile("s_waitcnt vmcnt(0)" ::: "memory");
    __syncthreads();
    if (threadIdx.x == 0) {
        unsigned* bar = b.bar;
        __builtin_amdgcn_s_waitcnt(0);
        unsigned nloc = b.st[0], nx = b.st[1];
        if (nloc == 0u) { xcd_barrier_complete(bar, b.x, nloc, nx); b.st[0] = nloc; b.st[1] = nx; }
        const unsigned old = xb_add(&bar[XB_XSUB(b.x)], 1u);
        const unsigned gen = old / nloc;
        if (old + 1u == (gen + 1u) * nloc) {
            __builtin_amdgcn_fence(__ATOMIC_RELEASE, "agent");
            asm volatile("s_waitcnt vmcnt(0)" ::: "memory");
            const unsigned og = xb_add(&bar[XB_TOP], 1u);
            const unsigned tg = og / nx;
            if (og + 1u == (tg + 1u) * nx) xb_add(&bar[XB_TOPGEN], 1u);
            else XB_SPIN(xb_ld(&bar[XB_TOPGEN]) == tg, bar);
            __builtin_amdgcn_fence(__ATOMIC_ACQUIRE, "agent");
            xb_add(&bar[XB_XGEN(b.x)], 1u);
            asm volatile("s_waitcnt vmcnt(0)" ::: "memory");
        } else {
            XB_SPIN(xb_ld(&bar[XB_XGEN(b.x)]) == gen, bar);
            __builtin_amdgcn_fence(__ATOMIC_ACQUIRE, "agent");
            asm volatile("s_waitcnt vmcnt(0)" ::: "memory");
        }
    }
    __syncthreads();
}

struct Frame {
    LAS unsigned char* lds;
    int tid, lane, wave, vcu, G;
    float* out;
    unsigned char* ws;
};
#define IN_X 0
#define IN_C 1
#define IN_CTX 2
#define IN_CCTX 3
#define IN_MODW 4
#define IN_MODB 5
#define IN_N1G 6
#define IN_N2G 7
#define IN_EVWIN 8
#define IN_EVSINK 9
#define IN_EVSGUG 10
#define IN_EVSGUW 11
#define IN_EVSGUB 12
#define IN_EVWOUT 13
#define IN_ODWIN 14
#define IN_ODQG 15
#define IN_ODWUQ 16
#define IN_ODKVG 17
#define IN_ODWUKV 18
#define IN_ODCONV 19
#define IN_ODWOUT 20
#define IN_ROUTER 21
#define IN_W1 22
#define IN_W3 23
#define IN_W2 24
#define IN_FING 25

__device__ __forceinline__ const float* inp(const Frame& F, int k) { return (const float*)(const GAS float*)(*(volatile LAS unsigned long long*)(F.lds + LDSCTL_OFF + 8 * k)); }
__device__ __forceinline__ int row_r(int row) { return row < NLAT ? (row >> 12) : 8; }
__device__ __forceinline__ int row_b(int row) { return row < NLAT ? (row >> 12) : ((row - NLAT) >> 8); }
__device__ __forceinline__ const float* modv(const Frame& F, int layer, int r, int which) { return (const float*)(F.ws + WS_MODV) + ((size_t)(layer * 9 + r) * 6 + which) * 1024; }

__device__ __forceinline__ void conv_item(const float* src, const float* src2, int ld_src, int K, bf16* dst, int kb, int nb, int kind, const float* kscale, LAS float* scr, int lane) {
    const int k0 = kb * 64, n0 = nb * 32, np = n0 + (lane & 31);
    const float* sp = src; int oc = np;
    if (kind == 1) {
        if (np < 128) { const int h = np >> 6, w = np & 63; oc = h * 64 + (w >> 1) + 32 * (w & 1); }
        else if (np >= 256 && np < 768) { const int w0 = np - 256, h = w0 >> 6, w = w0 & 63; oc = 256 + h * 64 + (w >> 1) + 32 * (w & 1); }
    } else if (kind == 2) {
        if (np < 256) oc = np; else if (np < 640) oc = np + 32; else if (np < 672) { const int w = np - 640; oc = 256 + (w >> 1) + 16 * (w & 1); } else if (np < 2208) oc = np; else oc = -1;
    } else if (kind == 3) {
        const int h = np / 96, w = np % 96; if (w >= 64) { const int w2 = w - 64; oc = h * 96 + 64 + (w2 >> 1) + 16 * (w2 & 1); }
    } else if (kind == 4) {
        const int half = (np >> 7) & 1; oc = (np >> 8) * 128 + (np & 127); sp = half ? src2 : src;
    }
#pragma unroll 8
    for (int i = 0; i < 32; ++i) { const int kk = 2 * i + (lane >> 5); float v = (oc >= 0) ? sp[(size_t)(k0 + kk) * ld_src + oc] : 0.f; if (kscale) v *= kscale[k0 + kk]; scr[kk * 33 + (lane & 31)] = v; }
    LDS_WAIT(); asm volatile("" ::: "memory");
    const int c = lane & 7;
#pragma unroll
    for (int j = 0; j < 4; ++j) { const int n = (lane >> 3) + 8 * j; const LAS float* s = scr + (8 * c) * 33 + n;
        v4u o; o.x = pk2(s[0 * 33], s[1 * 33]); o.y = pk2(s[2 * 33], s[3 * 33]); o.z = pk2(s[4 * 33], s[5 * 33]); o.w = pk2(s[6 * 33], s[7 * 33]);
        *(v4u*)(dst + (size_t)(n0 + n) * K + k0 + 8 * c) = o; }
    LDS_WAIT(); asm volatile("" ::: "memory");
}

__device__ __forceinline__ void conv_item_fp8(const float* src, const float* src2, int ld_src, int K, unsigned char* dst, int kb, int nb, int kind, LAS float* scr, int lane) {
    const int k0 = kb * 128, n0 = nb * 32, np = n0 + 4 * (lane & 7), kr = lane >> 3;
    const float* sp = src; int oc = np;
    if (kind == 4) { const int half = (np >> 7) & 1; oc = (np >> 8) * 128 + (np & 127); sp = half ? src2 : src; }
    sp += (size_t)(k0 + kr) * ld_src + oc;
#pragma unroll 8
    for (int i = 0; i < 16; ++i) { const f32x4 v = *(const f32x4*)(sp + (size_t)(8 * i) * ld_src); *(LAS f32x4*)(scr + (8 * i + kr) * 36 + 4 * (lane & 7)) = v * F8_SW; }
    LDS_WAIT(); asm volatile("" ::: "memory");
    const int n = lane >> 1, h = lane & 1;
    unsigned char* d = dst + (size_t)(n0 + n) * K + k0 + 64 * h;
#pragma unroll
    for (int q = 0; q < 4; ++q) { const LAS float* sc = scr + (64 * h + 16 * q) * 36 + n; v4u o;
        o.x = pk4_fp8(sc[0 * 36], sc[1 * 36], sc[2 * 36], sc[3 * 36]);   o.y = pk4_fp8(sc[4 * 36], sc[5 * 36], sc[6 * 36], sc[7 * 36]);
        o.z = pk4_fp8(sc[8 * 36], sc[9 * 36], sc[10 * 36], sc[11 * 36]); o.w = pk4_fp8(sc[12 * 36], sc[13 * 36], sc[14 * 36], sc[15 * 36]);
        *(v4u*)(d + 16 * q) = o; }
    LDS_WAIT(); asm volatile("" ::: "memory");
}
constexpr int CI_WINE = 16 * 56, CI_WOUT = 16 * 32, CI_WINO = 16 * 72, CI_WUQ = 6 * 24, CI_WUKV = 4 * 32;
constexpr int CI_SMALL = CI_WINE + CI_WOUT + CI_WINO + CI_WUQ + CI_WUKV + CI_WOUT, CI_SMALL2 = 2 * CI_SMALL;
constexpr int CI_W13 = FP8_F1 ? 8 * 64 : 16 * 64, CI_W2 = FP8_F2 ? 8 * 32 : 16 * 32, CI_PER_LAYER = 16 * (CI_W13 + CI_W2);
__device__ __forceinline__ void conv_items(Frame& F, int lo, int hi, int worker, int nworkers) {
    LAS float* scr = (LAS float*)(F.lds + F.wave * 18432);
    const int gw = worker * NWAVES + F.wave, NGW = nworkers * NWAVES;
    unsigned char* wsm = F.ws + WS_WSMALL;
    for (int it = lo + gw; it < hi; it += NGW) {
        int r = it;
        if (r < CI_SMALL2) {
            const int i = r / CI_SMALL; r %= CI_SMALL;
            if (r < CI_WINE) { conv_item(inp(F, IN_EVWIN) + (size_t)i * D * ZE, nullptr, ZE, D, (bf16*)(wsm + OFF_WINE + i * SZ_WINE), r / 56, r % 56, 1, nullptr, scr, F.lane); continue; } r -= CI_WINE;
            if (r < CI_WOUT) { conv_item(inp(F, IN_EVWOUT) + (size_t)i * D * D, nullptr, D, D, (bf16*)(wsm + OFF_WOUTE + i * SZ_WOUT), r / 32, r % 32, 0, nullptr, scr, F.lane); continue; } r -= CI_WOUT;
            if (r < CI_WINO) { conv_item(inp(F, IN_ODWIN) + (size_t)i * D * 2208, nullptr, 2208, D, (bf16*)(wsm + OFF_WINO + i * SZ_WINO), r / 72, r % 72, 2, nullptr, scr, F.lane); continue; } r -= CI_WINO;
            if (r < CI_WUQ) { conv_item(inp(F, IN_ODWUQ) + (size_t)i * 384 * 768, nullptr, 768, 384, (bf16*)(wsm + OFF_WUQ + i * SZ_WUQ), r / 24, r % 24, 3, inp(F, IN_ODQG) + i * 384, scr, F.lane); continue; } r -= CI_WUQ;
            if (r < CI_WUKV) { conv_item(inp(F, IN_ODWUKV) + (size_t)i * 256 * 1024, nullptr, 1024, 256, (bf16*)(wsm + OFF_WUKV + i * SZ_WUKV), r / 32, r % 32, 0, inp(F, IN_ODKVG) + i * 256, scr, F.lane); continue; } r -= CI_WUKV;
            conv_item(inp(F, IN_ODWOUT) + (size_t)i * D * D, nullptr, D, D, (bf16*)(wsm + OFF_WOUTO + i * SZ_WOUT), r / 32, r % 32, 0, nullptr, scr, F.lane); continue;
        }
        r -= CI_SMALL2;
        const int layer = r / CI_PER_LAYER; r %= CI_PER_LAYER;
        if (r < 16 * CI_W13) { const int le = layer * 16 + r / CI_W13; r %= CI_W13;
            if constexpr (FP8_F1) conv_item_fp8(inp(F, IN_W1) + (size_t)le * D * FF, inp(F, IN_W3) + (size_t)le * D * FF, FF, D, F.ws + WS_W13 + (size_t)le * (SZ_W13 / 2), r / 64, r % 64, 4, scr, F.lane);
            else conv_item(inp(F, IN_W1) + (size_t)le * D * FF, inp(F, IN_W3) + (size_t)le * D * FF, FF, D, (bf16*)(F.ws + WS_W13 + (size_t)le * SZ_W13), r / 64, r % 64, 4, nullptr, scr, F.lane);
            continue; }
        r -= 16 * CI_W13;
        { const int le = layer * 16 + r / CI_W2; r %= CI_W2;
            if constexpr (FP8_F2) conv_item_fp8(inp(F, IN_W2) + (size_t)le * FF * D, nullptr, D, FF, F.ws + WS_W2 + (size_t)le * (SZ_W2 / 2), r / 32, r % 32, 0, scr, F.lane);
            else conv_item(inp(F, IN_W2) + (size_t)le * FF * D, nullptr, D, FF, (bf16*)(F.ws + WS_W2 + (size_t)le * SZ_W2), r / 32, r % 32, 0, nullptr, scr, F.lane); }
    }
}
#define CONV_TAIL(S_, layer_, f0_, f1_) do { const int rem_ = (S_).nwg % F.G; if ((layer_) < DEPTH - 1 && rem_ != 0 && (int)blockIdx.x >= rem_) { LAUNDER(); \
        const int base_ = CI_SMALL2 + ((layer_) + 1) * CI_PER_LAYER; conv_items(F, base_ + CI_PER_LAYER * (f0_) / 64, base_ + CI_PER_LAYER * (f1_) / 64, (int)blockIdx.x - rem_, F.G - rem_); } } while (0)
__device__ __forceinline__ void p0_prologue(Frame& F) {
    {
        LAS float* s = (LAS float*)F.lds;
        LAS float* red = s + 9 * 1024;
        for (int i = F.tid; i < 9 * 1024; i += NT) { const int r = i >> 10, k = i & 1023; const float v = (r < 8) ? inp(F, IN_C)[r * 1024 + k] : inp(F, IN_CCTX)[k]; s[i] = siluf_(v); }
        __syncthreads();
        for (int u = blockIdx.x; u < 4 * 48; u += F.G) {
            const int layer = u / 48, ch = u % 48, col = ch * 128 + (F.tid & 127), kq = F.tid >> 7;
            const float* W = inp(F, IN_MODW) + (size_t)layer * 1024 * 6144;
            float acc[9];
#pragma unroll
            for (int r = 0; r < 9; ++r) acc[r] = 0.f;
            for (int k = kq * 256; k < kq * 256 + 256; k += 16) {
                float w[16];
#pragma unroll
                for (int j = 0; j < 16; ++j) w[j] = W[(size_t)(k + j) * 6144 + col];
#pragma unroll
                for (int j = 0; j < 16; ++j)
#pragma unroll
                    for (int r = 0; r < 9; ++r) acc[r] += s[r * 1024 + k + j] * w[j]; }
#pragma unroll
            for (int r = 0; r < 9; ++r) red[(kq * 9 + r) * 128 + (F.tid & 127)] = acc[r];
            __syncthreads();
            for (int i = F.tid; i < 9 * 128; i += NT) { const int r = i >> 7, cc = i & 127; const float v = red[(0 * 9 + r) * 128 + cc] + red[(1 * 9 + r) * 128 + cc] + red[(2 * 9 + r) * 128 + cc] + red[(3 * 9 + r) * 128 + cc];
                const int c6 = ch * 128 + cc; ((float*)(F.ws + WS_MODV))[(size_t)(layer * 9 + r) * 6144 + c6] = v + inp(F, IN_MODB)[layer * 6144 + c6]; }
            __syncthreads();
        }
        __syncthreads();
    }
    {
        float* ca = (float*)(F.ws + WS_TAB); float* sa = ca + 4096 * 32; float* cc = sa + 4096 * 32; float* sc = cc + 4096 * 16;
        for (int i = blockIdx.x * NT + F.tid; i < 4096 * 32; i += F.G * NT) { const int pos = i >> 5, j = i & 31; const float inv = powf(10000.0f, -(float)(j & 15) / 16.0f);
            const float ang = (float)((j < 16) ? (pos >> 6) : (pos & 63)) * inv; ca[i] = cosf(ang); sa[i] = sinf(ang); }
        for (int i = blockIdx.x * NT + F.tid; i < 4096 * 16; i += F.G * NT) { const int pos = i >> 4, j = i & 15; const float inv = powf(10000.0f, -(float)(j & 7) / 8.0f);
            const float ang = (float)((j < 8) ? (pos >> 6) : (pos & 63)) * inv; cc[i] = cosf(ang); sc[i] = sinf(ang); }
    }
    {
        const float* w = inp(F, IN_EVSGUW); bf16* o = (bf16*)(F.ws + WS_WSB);
        for (int i = blockIdx.x * NT + F.tid; i < 2 * 4 * 128 * 128; i += F.G * NT) o[i] = (bf16)f2bf(w[i]);
    }
    {
        constexpr int TOT = CI_SMALL2 + CI_PER_LAYER, CUT = TOT / 10;
        if (F.G > 192) { if ((int)blockIdx.x >= 192) conv_items(F, TOT - CUT, TOT, (int)blockIdx.x - 192, F.G - 192); conv_items(F, 0, TOT - CUT, F.vcu, F.G); }
        else conv_items(F, 0, TOT, F.vcu, F.G);
    }
}

__device__ __forceinline__ void load_row4(const float* p, int lane, f32x4 (&v)[4]) {
    const f32x4* q = (const f32x4*)p + lane;
#pragma unroll
    for (int j = 0; j < 4; ++j) v[j] = q[64 * j];
}
__device__ __forceinline__ void load_row4b(const bf16* p, int lane, v2u (&v)[4]) {
    const v2u* q = (const v2u*)p + lane;
#pragma unroll
    for (int j = 0; j < 4; ++j) v[j] = q[64 * j];
}
__device__ __forceinline__ f32x4 bf4(v2u w) { return (f32x4){bflo(w.x), bfhi(w.x), bflo(w.y), bfhi(w.y)}; }
__device__ __forceinline__ void n1_phase(Frame& F, int layer, bool dummy = false) {
    const int gw = F.vcu * NWAVES + F.wave, NGW = F.G * NWAVES;
    bf16* X = (bf16*)(F.ws + WS_X);
    bf16* H = (bf16*)(F.ws + WS_H);
    const bf16* Y = (const bf16*)(F.ws + WS_Y);
    const int* INV = (const int*)(F.ws + WS_INV); const float* AFF = (const float*)(F.ws + WS_AFF);
    const float* xin = inp(F, IN_X); const float* cin = inp(F, IN_CTX);
    const int nrows = (layer == 4) ? NLAT : MT, rpw = (nrows + NGW - 1) / NGW, r0 = gw * rpw, r1 = (r0 + rpw < nrows) ? r0 + rpw : nrows;
    if (r0 >= r1) return;
    f32x4 xn[4]; v2u xb[4]; int invn = -1; float affn = 0.f;
#pragma unroll
    for (int j = 0; j < 4; ++j) { xn[j] = (f32x4){0.f, 0.f, 0.f, 0.f}; xb[j] = (v2u){0u, 0u}; }
#define N1_FETCH(row_) do { if (layer == 0) load_row4((row_) < NLAT ? xin + (size_t)(row_) * 1024 : cin + (size_t)((row_) - NLAT) * 1024, F.lane, xn); else load_row4b(X + (size_t)(row_) * 1024, F.lane, xb); \
        if (layer > 0 && F.lane < 16) { invn = ((row_) < NLAT) ? INV[((size_t)((row_) >> 12) * 16 + F.lane) * 4096 + ((row_) & 4095)] : INV[(size_t)NLAT * 16 + ((size_t)(((row_) - NLAT) >> 8) * 16 + F.lane) * 256 + (((row_) - NLAT) & 255)]; \
            affn = AFF[(size_t)(row_) * 16 + F.lane]; } } while (0)
    N1_FETCH(r0);
    int rcur = -1;
    f32x4 cA[4], cB[4], g2[4];
#pragma unroll
    for (int j = 0; j < 4; ++j) { cA[j] = (f32x4){0.f, 0.f, 0.f, 0.f}; cB[j] = cA[j]; g2[j] = cA[j]; }
    for (int row = r0; row < r1; ++row) {
        f32x4 x[4];
#pragma unroll
        for (int j = 0; j < 4; ++j) x[j] = (layer == 0) ? xn[j] : bf4(xb[j]);
        const int inv = invn; const float aff = affn;
        if (row + 1 < r1) N1_FETCH(row + 1);
        const int r = row_r(row);
        if (r != rcur) {
            rcur = r;
            if (layer > 0) load_row4(modv(F, layer - 1, r, 5), F.lane, g2);
            if (layer < 4) { f32x4 g[4], sc[4]; load_row4(inp(F, IN_N1G) + layer * 1024, F.lane, g); load_row4(modv(F, layer, r, 1), F.lane, sc); load_row4(modv(F, layer, r, 0), F.lane, cB);
#pragma unroll
                for (int j = 0; j < 4; ++j) cA[j] = g[j] * (sc[j] + 1.0f); }
            else load_row4(inp(F, IN_FING), F.lane, cA);
        }
        if (layer > 0) {
            unsigned long long mask = __ballot(F.lane < 16 && inv >= 0);
            f32x4 acc[4];
#pragma unroll
            for (int j = 0; j < 4; ++j) acc[j] = (f32x4){0.f, 0.f, 0.f, 0.f};
            while (mask) {
                const int e0 = __builtin_ctzll(mask); mask &= mask - 1;
                const bool two = mask != 0; const int e1 = two ? __builtin_ctzll(mask) : e0; if (two) mask &= mask - 1;
                const int s0 = __builtin_amdgcn_readlane(inv, e0), s1 = __builtin_amdgcn_readlane(inv, e1);
                const float ga = __builtin_bit_cast(float, __builtin_amdgcn_readlane(__builtin_bit_cast(int, aff), e0)), gb = two ? __builtin_bit_cast(float, __builtin_amdgcn_readlane(__builtin_bit_cast(int, aff), e1)) : 0.f;
                if constexpr (FP8_Y) {
                    const unsigned* ya = (const unsigned*)((const unsigned char*)Y + (size_t)(e0 * EROWS + s0) * 1024) + F.lane; const unsigned* yb = (const unsigned*)((const unsigned char*)Y + (size_t)(e1 * EROWS + s1) * 1024) + F.lane;
                    unsigned wa[4], wb[4];
#pragma unroll
                    for (int j = 0; j < 4; ++j) { wa[j] = ya[64 * j]; wb[j] = yb[64 * j]; }
                    const float ga_ = ga * (1.0f / F8_SY), gb_ = gb * (1.0f / F8_SY);
#pragma unroll
                    for (int j = 0; j < 4; ++j) { const f32x2_ a0 = __builtin_amdgcn_cvt_pk_f32_fp8((int)wa[j], false), a1 = __builtin_amdgcn_cvt_pk_f32_fp8((int)wa[j], true), b0 = __builtin_amdgcn_cvt_pk_f32_fp8((int)wb[j], false), b1 = __builtin_amdgcn_cvt_pk_f32_fp8((int)wb[j], true);
                        acc[j].x += ga_ * a0.x + gb_ * b0.x; acc[j].y += ga_ * a0.y + gb_ * b0.y; acc[j].z += ga_ * a1.x + gb_ * b1.x; acc[j].w += ga_ * a1.y + gb_ * b1.y; }
                } else {
                const v2u* ya = (const v2u*)(Y + (size_t)(e0 * EROWS + s0) * 1024) + F.lane; const v2u* yb = (const v2u*)(Y + (size_t)(e1 * EROWS + s1) * 1024) + F.lane;
                v2u wa[4], wb[4];
#pragma unroll
                for (int j = 0; j < 4; ++j) { wa[j] = ya[64 * j]; wb[j] = yb[64 * j]; }
#pragma unroll
                for (int j = 0; j < 4; ++j) { acc[j].x += ga * bflo(wa[j].x) + gb * bflo(wb[j].x); acc[j].y += ga * bfhi(wa[j].x) + gb * bfhi(wb[j].x); acc[j].z += ga * bflo(wa[j].y) + gb * bflo(wb[j].y); acc[j].w += ga * bfhi(wa[j].y) + gb * bfhi(wb[j].y); }
                }
            }
#pragma unroll
            for (int j = 0; j < 4; ++j) x[j] += g2[j] * acc[j];
        }
        float ss = 0.f;
#pragma unroll
        for (int j = 0; j < 4; ++j) ss += (x[j].x * x[j].x + x[j].y * x[j].y) + (x[j].z * x[j].z + x[j].w * x[j].w);
        const float rstd = 1.0f / sqrtf(wave_sum(ss) * (1.0f / 1024.0f) + EPS);
        if (layer == 4) {
            f32x4* o = (f32x4*)(F.out + (size_t)row * 1024) + F.lane;
#pragma unroll
            for (int j = 0; j < 4; ++j) o[64 * j] = x[j] * rstd * cA[j];
        } else {
            v2u* xo = (v2u*)((dummy ? (bf16*)(F.ws + WS_X + 68 * MiB) : X) + (size_t)row * 1024) + F.lane;
#pragma unroll
            for (int j = 0; j < 4; ++j) { v2u w; w.x = pk2(x[j].x, x[j].y); w.y = pk2(x[j].z, x[j].w); xo[64 * j] = w; }
            v2u* ho = (v2u*)((dummy ? (bf16*)(F.ws + WS_Z) : H) + (size_t)row * 1024) + F.lane;
#pragma unroll
            for (int j = 0; j < 4; ++j) { const f32x4 h = x[j] * rstd * cA[j] + cB[j]; v2u w; w.x = pk2(h.x, h.y); w.y = pk2(h.z, h.w); ho[64 * j] = w; }
            if ((layer & 1) && F.lane == 0) { unsigned long long* rs = (unsigned long long*)(F.ws + WS_RS); rs[row] = 0ull; rs[MT + row] = 0ull; }
        }
    }
#undef N1_FETCH
}

__device__ __forceinline__ void n2_phase(Frame& F, int layer) {
    const int gw = F.vcu * NWAVES + F.wave, NGW = F.G * NWAVES;
    const bf16* X = (const bf16*)(F.ws + WS_X);
    bf16* H = (bf16*)(F.ws + WS_H);
    LAS float* wr = (LAS float*)F.lds;
    const float* rw = inp(F, IN_ROUTER) + (size_t)layer * 1024 * 16;
    for (int i = F.tid; i < 16384; i += NT) { const int k = i >> 4, e = i & 15; wr[e * 1024 + k] = rw[i]; }
    __syncthreads();
    float* AFF = (float*)(F.ws + WS_AFF); float* AFFT = (float*)(F.ws + WS_AFFT);
    const bool need_ctx = layer < DEPTH - 1;
    const int nrows = need_ctx ? MT : NLAT, rpw = (nrows + NGW - 1) / NGW, r0 = gw * rpw, r1 = (r0 + rpw < nrows) ? r0 + rpw : nrows;
    const int b5 = (F.lane >> 5) & 1, b4 = (F.lane >> 4) & 1, b3 = (F.lane >> 3) & 1, b2 = (F.lane >> 2) & 1, emine = (F.lane >> 2) & 15;
    if (r0 < r1) {
        v2u xn[4]; load_row4b(X + (size_t)r0 * 1024, F.lane, xn);
        int rcur = -1; f32x4 cA[4], cB[4];
#pragma unroll
        for (int j = 0; j < 4; ++j) { cA[j] = (f32x4){0.f, 0.f, 0.f, 0.f}; cB[j] = cA[j]; }
        for (int row = r0; row < r1; ++row) {
            f32x4 x[4];
#pragma unroll
            for (int j = 0; j < 4; ++j) x[j] = bf4(xn[j]);
            if (row + 1 < r1) load_row4b(X + (size_t)(row + 1) * 1024, F.lane, xn);
            const int r = row_r(row);
            if (r != rcur) { rcur = r; f32x4 g[4], sc[4]; load_row4(inp(F, IN_N2G) + layer * 1024, F.lane, g); load_row4(modv(F, layer, r, 4), F.lane, sc); load_row4(modv(F, layer, r, 3), F.lane, cB);
#pragma unroll
                for (int j = 0; j < 4; ++j) cA[j] = g[j] * (sc[j] + 1.0f); }
            float ss = 0.f;
#pragma unroll
            for (int j = 0; j < 4; ++j) ss += (x[j].x * x[j].x + x[j].y * x[j].y) + (x[j].z * x[j].z + x[j].w * x[j].w);
            const float rstd = 1.0f / sqrtf(wave_sum(ss) * (1.0f / 1024.0f) + EPS);
            f32x4 h[4];
            if constexpr (FP8_F1) {
                unsigned* ho = (unsigned*)((unsigned char*)H + (size_t)row * 1024) + F.lane;
#pragma unroll
                for (int j = 0; j < 4; ++j) { h[j] = x[j] * rstd * cA[j] + cB[j]; ho[64 * j] = pk4_fp8(clampf_(h[j].x * F8_SA, 448.f), clampf_(h[j].y * F8_SA, 448.f), clampf_(h[j].z * F8_SA, 448.f), clampf_(h[j].w * F8_SA, 448.f)); }
            } else {
                v2u* ho = (v2u*)(H + (size_t)row * 1024) + F.lane;
#pragma unroll
                for (int j = 0; j < 4; ++j) { h[j] = x[j] * rstd * cA[j] + cB[j]; v2u w; w.x = pk2(h[j].x, h[j].y); w.y = pk2(h[j].z, h[j].w); ho[64 * j] = w; }
            }
            float a[16];
#pragma unroll
            for (int e = 0; e < 16; ++e) { float t = 0.f;
#pragma unroll
                for (int j = 0; j < 4; ++j) { const f32x4 w = *(const LAS f32x4*)(wr + e * 1024 + 256 * j + 4 * F.lane); t += (h[j].x * w.x + h[j].y * w.y) + (h[j].z * w.z + h[j].w * w.w); }
                a[e] = t; if ((e & 3) == 3) asm volatile("" ::: "memory"); }
            float bq[8], cq[4], dq[2];
#pragma unroll
            for (int j = 0; j < 8; ++j) { const float keep = b5 ? a[j + 8] : a[j], send = b5 ? a[j] : a[j + 8]; bq[j] = keep + __shfl_xor(send, 32); }
#pragma unroll
            for (int j = 0; j < 4; ++j) { const float keep = b4 ? bq[j + 4] : bq[j], send = b4 ? bq[j] : bq[j + 4]; cq[j] = keep + __shfl_xor(send, 16); }
#pragma unroll
            for (int j = 0; j < 2; ++j) { const float keep = b3 ? cq[j + 2] : cq[j], send = b3 ? cq[j] : cq[j + 2]; dq[j] = keep + __shfl_xor(send, 8); }
            float lg = (b2 ? dq[1] : dq[0]) + __shfl_xor(b2 ? dq[0] : dq[1], 4);
            lg += __shfl_xor(lg, 2); lg += __shfl_xor(lg, 1);
            float mx = lg;
#pragma unroll
            for (int o = 4; o < 64; o <<= 1) mx = fmaxf(mx, __shfl_xor(mx, o));
            const float p = expf(lg - mx); float den = p;
#pragma unroll
            for (int o = 4; o < 64; o <<= 1) den += __shfl_xor(den, o);
            const float mine = p / den;
            if ((F.lane & 3) == 0) {
                AFF[(size_t)row * 16 + emine] = mine;
                if (row < NLAT) AFFT[((size_t)(row >> 12) * 16 + emine) * 4096 + (row & 4095)] = mine;
                else { const int rc = row - NLAT; AFFT[(size_t)NLAT * 16 + ((size_t)(rc >> 8) * 16 + emine) * 256 + (rc & 255)] = mine; }
            }
        }
    }
    __syncthreads();
}

__device__ __forceinline__ void n2_row_valu(Frame& F, int layer, int row, const v2u (&xr)[4], const LAS float* wr, const LAS float* ca, const LAS float* cb) {
    unsigned char* H2 = F.ws + WS_H; float* AFF = (float*)(F.ws + WS_AFF); float* AFFT = (float*)(F.ws + WS_AFFT);
    const int b5 = (F.lane >> 5) & 1, b4 = (F.lane >> 4) & 1, b3 = (F.lane >> 3) & 1, b2 = (F.lane >> 2) & 1, emine = (F.lane >> 2) & 15;
    f32x4 x[4];
#pragma unroll
    for (int j = 0; j < 4; ++j) x[j] = bf4(xr[j]);
    float ss = 0.f;
#pragma unroll
    for (int j = 0; j < 4; ++j) ss += (x[j].x * x[j].x + x[j].y * x[j].y) + (x[j].z * x[j].z + x[j].w * x[j].w);
    const float rstd = 1.0f / sqrtf(wave_sum(ss) * (1.0f / 1024.0f) + EPS);
    f32x4 h[4];
    unsigned* ho = (unsigned*)(H2 + (size_t)row * 1024) + F.lane;
#pragma unroll
    for (int j = 0; j < 4; ++j) { const f32x4 cA = *(const LAS f32x4*)(ca + 256 * j + 4 * F.lane), cB = *(const LAS f32x4*)(cb + 256 * j + 4 * F.lane);
        h[j] = x[j] * rstd * cA + cB; ho[64 * j] = pk4_fp8(clampf_(h[j].x * F8_SA, 448.f), clampf_(h[j].y * F8_SA, 448.f), clampf_(h[j].z * F8_SA, 448.f), clampf_(h[j].w * F8_SA, 448.f)); }
    float a[16];
#pragma unroll
    for (int e = 0; e < 16; ++e) { float t = 0.f;
#pragma unroll
        for (int j = 0; j < 4; ++j) { const f32x4 w = *(const LAS f32x4*)(wr + e * 1028 + 256 * j + 4 * F.lane); t += (h[j].x * w.x + h[j].y * w.y) + (h[j].z * w.z + h[j].w * w.w); }
        a[e] = t; if ((e & 3) == 3) asm volatile("" ::: "memory"); }
    float bq[8], cq[4], dq[2];
#pragma unroll
    for (int j = 0; j < 8; ++j) { const float keep = b5 ? a[j + 8] : a[j], send = b5 ? a[j] : a[j + 8]; bq[j] = keep + __shfl_xor(send, 32); }
#pragma unroll
    for (int j = 0; j < 4; ++j) { const float keep = b4 ? bq[j + 4] : bq[j], send = b4 ? bq[j] : bq[j + 4]; cq[j] = keep + __shfl_xor(send, 16); }
#pragma unroll
    for (int j = 0; j < 2; ++j) { const float keep = b3 ? cq[j + 2] : cq[j], send = b3 ? cq[j] : cq[j + 2]; dq[j] = keep + __shfl_xor(send, 8); }
    float lg = (b2 ? dq[1] : dq[0]) + __shfl_xor(b2 ? dq[0] : dq[1], 4);
    lg += __shfl_xor(lg, 2); lg += __shfl_xor(lg, 1);
    float mx = lg;
#pragma unroll
    for (int o = 4; o < 64; o <<= 1) mx = fmaxf(mx, __shfl_xor(mx, o));
    const float p = expf(lg - mx); float den = p;
#pragma unroll
    for (int o = 4; o < 64; o <<= 1) den += __shfl_xor(den, o);
    const float mine = p / den;
    if ((F.lane & 3) == 0) {
        AFF[(size_t)row * 16 + emine] = mine;
        if (row < NLAT) AFFT[((size_t)(row >> 12) * 16 + emine) * 4096 + (row & 4095)] = mine;
        else { const int rc = row - NLAT; AFFT[(size_t)NLAT * 16 + ((size_t)(rc >> 8) * 16 + emine) * 256 + (rc & 255)] = mine; }
    }
}
__device__ __forceinline__ void n2_phase_mfma(Frame& F, int layer) {
    typedef short n2v8 __attribute__((ext_vector_type(8)));
    const bf16* X = (const bf16*)(F.ws + WS_X);
    unsigned char* H2 = F.ws + WS_H;
    LAS unsigned short* AH = (LAS unsigned short*)F.lds;
    LAS unsigned short* AL = AH + 32 * 64 * 8;
    LAS float* CA = (LAS float*)(F.lds + 65536);
    LAS float* CB = CA + 1024;
    LAS float* CP = CB + 1024;
    LAS float* CC = CP + 512;
    LAS float* CA8 = (LAS float*)(F.lds + 77824);
    LAS float* CB8 = CA8 + 1024;
    LAS float* WR = (LAS float*)(F.lds + 86016);
    const float* rw = inp(F, IN_ROUTER) + (size_t)layer * 16384;
    float* AFF = (float*)(F.ws + WS_AFF); float* AFFT = (float*)(F.ws + WS_AFFT);
    const bool need_ctx = layer < DEPTH - 1;
    const int nunits = NLAT / 128;
    const int gwv = F.vcu * NWAVES + F.wave, NGWV = F.G * NWAVES;
    const int q = F.lane >> 4, rl = F.lane & 15;
    int rcur = -1;
    if (need_ctx) {
        v2u xc[4]; const bool has_ctx = NLAT + gwv < MT;
        load_row4b(X + (size_t)(has_ctx ? NLAT + gwv : 0) * 1024, F.lane, xc);
        { for (int i = F.tid; i < 16384; i += NT) { const int k = i >> 4, e = i & 15; WR[e * 1028 + k] = rw[i]; }
          const float* g = inp(F, IN_N2G) + layer * 1024; const float* sc = modv(F, layer, 8, 4); const float* sh = modv(F, layer, 8, 3);
          for (int k = F.tid; k < 1024; k += NT) { CA8[k] = g[k] * (sc[k] + 1.0f); CB8[k] = sh[k]; } }
        __syncthreads();
        if (has_ctx) n2_row_valu(F, layer, NLAT + gwv, xc, WR, CA8, CB8);
        for (int row = NLAT + gwv + NGWV; row < MT; row += NGWV) { v2u xq[4]; load_row4b(X + (size_t)row * 1024, F.lane, xq); n2_row_valu(F, layer, row, xq, WR, CA8, CB8); }
    }
    for (int u = F.vcu; u < nunits; u += F.G) {
        const int row0 = u * 128, r = row_r(row0), row = row0 + F.wave * 16 + rl;
        const v4u* xp = (const v4u*)(X + (size_t)row * 1024) + 2 * q;
        v4u x[32];
#pragma unroll
        for (int s = 0; s < 32; ++s) x[s] = xp[(s >> 1) * 8 + (s & 1)];
        if (r != rcur) {
            rcur = r;
            __syncthreads();
            { const float* g = inp(F, IN_N2G) + layer * 1024; const float* sc = modv(F, layer, r, 4); const float* sh = modv(F, layer, r, 3);
              for (int k = F.tid; k < 1024; k += NT) { CA[k] = g[k] * (sc[k] + 1.0f) * F8_SA; CB[k] = sh[k] * F8_SA; } }
            __syncthreads();
            { const int e = F.tid & 15; float cpart = 0.f;
#pragma unroll 4
              for (int i = 0; i < 32; ++i) { const int idx = F.tid + NT * i, k = idx >> 4; const float w = rw[idx]; const float wf = CA[k] * (1.0f / F8_SA) * w; cpart += CB[k] * (1.0f / F8_SA) * w;
                  const unsigned hi = f2bf(wf); const unsigned lo = f2bf(wf - __builtin_bit_cast(float, hi << 16));
                  const int c = k >> 3, j = k & 7, st = (c >> 3) * 2 + (c & 1), qq = (c & 7) >> 1, off = ((st * 64 + qq * 16 + e) * 8 + j);
                  AH[off] = (unsigned short)hi; AL[off] = (unsigned short)lo; }
              CP[(F.tid >> 4) * 16 + e] = cpart; }
            __syncthreads();
            if (F.tid < 16) { float c = 0.f; for (int gi = 0; gi < 32; ++gi) c += CP[gi * 16 + F.tid]; CC[F.tid] = c; }
            __syncthreads();
        }
        f32x4 acc = {0.f, 0.f, 0.f, 0.f}, acc2 = acc, acc3 = acc;
#pragma unroll
        for (int s = 0; s < 32; ++s) {
            const n2v8 xb = __builtin_bit_cast(n2v8, x[s]);
            const n2v8 ah = *(const LAS n2v8*)(AH + (s * 64 + F.lane) * 8), al = *(const LAS n2v8*)(AL + (s * 64 + F.lane) * 8);
            acc = __builtin_amdgcn_mfma_f32_16x16x32_bf16(ah, xb, acc, 0, 0, 0);
            acc2 = __builtin_amdgcn_mfma_f32_16x16x32_bf16(al, xb, acc2, 0, 0, 0);
            acc3 = __builtin_amdgcn_mfma_f32_16x16x32_bf16(xb, xb, acc3, 0, 0, 0);
        }
        const int i3 = F.lane & 3;
        const float dsel = i3 == 0 ? acc3[0] : i3 == 1 ? acc3[1] : i3 == 2 ? acc3[2] : acc3[3];
        const float ss = __shfl(dsel, ((rl >> 2) << 4) + rl);
        const float rstd = 1.0f / sqrtf(ss * (1.0f / 1024.0f) + EPS);
        {
            const f32x4 cc = *(const LAS f32x4*)(CC + 4 * q);
            float lg[4];
#pragma unroll
            for (int i = 0; i < 4; ++i) lg[i] = rstd * (acc[i] + acc2[i]) + cc[i];
            float mx = fmaxf(fmaxf(lg[0], lg[1]), fmaxf(lg[2], lg[3]));
            { float t0, t1; lane_swap<false>(mx, t0, t1); mx = fmaxf(t0, t1); lane_swap<true>(mx, t0, t1); mx = fmaxf(t0, t1); }
            float pe[4], den = 0.f;
#pragma unroll
            for (int i = 0; i < 4; ++i) { pe[i] = expf(lg[i] - mx); den += pe[i]; }
            { float t0, t1; lane_swap<false>(den, t0, t1); den = t0 + t1; lane_swap<true>(den, t0, t1); den = t0 + t1; }
            const float rden = 1.0f / den;
            f32x4 af; af.x = pe[0] * rden; af.y = pe[1] * rden; af.z = pe[2] * rden; af.w = pe[3] * rden;
            *(f32x4*)(AFF + (size_t)row * 16 + 4 * q) = af;
            float* at = (row < NLAT) ? AFFT + ((size_t)(row >> 12) * 16 + 4 * q) * 4096 + (row & 4095) : AFFT + (size_t)NLAT * 16 + ((size_t)((row - NLAT) >> 8) * 16 + 4 * q) * 256 + ((row - NLAT) & 255);
            const int astr = (row < NLAT) ? 4096 : 256;
            at[0] = af.x; at[astr] = af.y; at[2 * astr] = af.z; at[3 * astr] = af.w;
        }
        unsigned char* hrow = H2 + (size_t)row * 1024 + q * 16;
#pragma unroll
        for (int p = 0; p < 16; ++p) {
            const LAS f32x4* ca = (const LAS f32x4*)(CA + p * 64 + q * 16); const LAS f32x4* cb = (const LAS f32x4*)(CB + p * 64 + q * 16);
            v4u o;
#pragma unroll
            for (int hh = 0; hh < 2; ++hh) {
                const v4u xv = x[2 * p + hh]; const f32x4 a0 = ca[2 * hh], a1 = ca[2 * hh + 1], b0 = cb[2 * hh], b1 = cb[2 * hh + 1];
                const unsigned w0 = pk4_fp8(clampf_(bflo(xv.x) * rstd * a0.x + b0.x, 448.f), clampf_(bfhi(xv.x) * rstd * a0.y + b0.y, 448.f), clampf_(bflo(xv.y) * rstd * a0.z + b0.z, 448.f), clampf_(bfhi(xv.y) * rstd * a0.w + b0.w, 448.f));
                const unsigned w1 = pk4_fp8(clampf_(bflo(xv.z) * rstd * a1.x + b1.x, 448.f), clampf_(bfhi(xv.z) * rstd * a1.y + b1.y, 448.f), clampf_(bflo(xv.w) * rstd * a1.z + b1.z, 448.f), clampf_(bfhi(xv.w) * rstd * a1.w + b1.w, 448.f));
                if (hh == 0) { o.x = w0; o.y = w1; } else { o.z = w0; o.w = w1; }
            }
            *(v4u*)(hrow + p * 64) = o;
        }
    }
    __syncthreads();
}

__device__ __forceinline__ void topk_phase(Frame& F, int layer) {
    LAS unsigned* vals = (LAS unsigned*)F.lds;
    LAS unsigned* hist = vals + 4096;
    LAS unsigned* wsum = hist + 256;
    LAS unsigned* sel = wsum + 16;
    const bool need_ctx = layer < DEPTH - 1;
    const int nunits = need_ctx ? 256 : 128;
    const float* AFFT = (const float*)(F.ws + WS_AFFT);
    int* INV = (int*)(F.ws + WS_INV); int* SRC = (int*)(F.ws + WS_SRC);
    for (int u = blockIdx.x; u < nunits; u += F.G) {
        const bool isctx = u >= 128; const int be = u & 127, b = be >> 4, e = be & 15;
        const int n = isctx ? 256 : 4096, cap = isctx ? CAP_C : CAP_L;
        const float* src = isctx ? AFFT + (size_t)NLAT * 16 + (size_t)be * 256 : AFFT + (size_t)be * 4096;
        const int per = isctx ? 1 : 8; const bool act = isctx ? (F.tid < 256) : true;
        unsigned mv[8];
#pragma unroll
        for (int j = 0; j < 8; ++j) { mv[j] = 0u; if (act && j < per) { mv[j] = __builtin_bit_cast(unsigned, src[F.tid * per + j]); vals[F.tid * per + j] = mv[j]; } }
        __syncthreads();
        unsigned prefix = 0u, pmask = 0u; int need = cap;
        for (int pass = 0; pass < 4; ++pass) {
            const int shift = 24 - 8 * pass;
            if (F.tid < 256) hist[F.tid] = 0u;
            __syncthreads();
            for (int i = F.tid; i < n; i += NT) { const unsigned v = vals[i]; if ((v & pmask) == prefix) __hip_atomic_fetch_add(&hist[(v >> shift) & 255u], 1u, __ATOMIC_RELAXED, __HIP_MEMORY_SCOPE_WORKGROUP); }
            __syncthreads();
            if (F.wave == 0) {
                const unsigned c0 = hist[4 * F.lane], c1 = hist[4 * F.lane + 1], c2 = hist[4 * F.lane + 2], c3 = hist[4 * F.lane + 3];
                const unsigned sl = c0 + c1 + c2 + c3; unsigned incl = sl;
#pragma unroll
                for (int o = 1; o < 64; o <<= 1) { const unsigned t = __shfl_down(incl, o); if (F.lane + o < 64) incl += t; }
                const unsigned ab3 = incl - sl, ab2 = ab3 + c3, ab1 = ab2 + c2, ab0 = ab1 + c1;
                const unsigned nd = (unsigned)need;
                if (ab3 < nd && ab3 + c3 >= nd) { sel[0] = 4u * F.lane + 3u; sel[1] = nd - ab3; }
                if (ab2 < nd && ab2 + c2 >= nd) { sel[0] = 4u * F.lane + 2u; sel[1] = nd - ab2; }
                if (ab1 < nd && ab1 + c1 >= nd) { sel[0] = 4u * F.lane + 1u; sel[1] = nd - ab1; }
                if (ab0 < nd && ab0 + c0 >= nd) { sel[0] = 4u * F.lane; sel[1] = nd - ab0; }
            }
            __syncthreads();
            prefix |= sel[0] << shift; pmask |= 255u << shift; need = (int)sel[1];
            __syncthreads();
        }
        const unsigned T = prefix;
        unsigned cg = 0u, ce = 0u;
#pragma unroll
        for (int j = 0; j < 8; ++j) if (act && j < per) { cg += (mv[j] > T) ? 1u : 0u; ce += (mv[j] == T) ? 1u : 0u; }
        unsigned pk = cg | (ce << 16), incl = pk;
#pragma unroll
        for (int o = 1; o < 64; o <<= 1) { const unsigned t = __shfl_up(incl, o); if (F.lane >= o) incl += t; }
        if (F.lane == 63) wsum[F.wave] = incl;
        __syncthreads();
        unsigned base = 0u;
        for (int w = 0; w < F.wave; ++w) base += wsum[w];
        unsigned excl = base + incl - pk;
        unsigned g0 = excl & 0xffffu, e0 = excl >> 16;
        if (act) {
#pragma unroll
            for (int j = 0; j < 8; ++j) if (j < per) {
                const int t = F.tid * per + j; const bool gt = mv[j] > T, eq = mv[j] == T;
                const bool s = gt || (eq && (int)e0 < need);
                const int slot = (int)g0 + ((int)e0 < need ? (int)e0 : need);
                const int hrow = isctx ? NLAT + b * 256 + t : b * 4096 + t;
                const int gi = isctx ? BATCH * CAP_L + b * CAP_C + slot : b * CAP_L + slot;
                INV[(isctx ? (size_t)NLAT * 16 + (size_t)be * 256 : (size_t)be * 4096) + t] = s ? gi : -1;
                if (s) SRC[e * EROWS + gi] = hrow;
                g0 += gt ? 1u : 0u; e0 += eq ? 1u : 0u;
            }
        }
        __syncthreads();
    }
}

template <int W> __device__ __forceinline__ void store_bf16(bf16* p, const float (&v)[W]) {
    if constexpr (W == 4) { v2u w; w.x = pk2(v[0], v[1]); w.y = pk2(v[2], v[3]); *(v2u*)p = w; }
    else { v4u w; w.x = pk2(v[0], v[1]); w.y = pk2(v[2], v[3]); w.z = pk2(v[4], v[5]); w.w = pk2(v[6], v[7]); *(v4u*)p = w; }
}
struct EpiInEven {
    static constexpr int GROUPS = 1;
    bf16* Z; const float* cosa; const float* sina;
    template <int W> __device__ __forceinline__ void chunk(int row, int col, const float (&v)[W]) const {
        float o[W];
        if (col < 128 || (col >= 256 && col < 768)) {
            const float qs = col >= 256 ? QSCALE_E : 1.0f;
            if (row < NLAT) { const int pos = row & 4095, i0 = (col & 63) >> 1;
                float cc[W / 2], ss[W / 2];
                if constexpr (W == 8) { const f32x4 c4 = *(const f32x4*)(cosa + pos * 32 + i0), s4 = *(const f32x4*)(sina + pos * 32 + i0); cc[0] = c4.x; cc[1] = c4.y; cc[2] = c4.z; cc[3] = c4.w; ss[0] = s4.x; ss[1] = s4.y; ss[2] = s4.z; ss[3] = s4.w; }
                else {
#pragma unroll
                    for (int p = 0; p < W / 2; ++p) { cc[p] = cosa[pos * 32 + i0 + p]; ss[p] = sina[pos * 32 + i0 + p]; } }
#pragma unroll
                for (int p = 0; p < W / 2; ++p) { const float c = cc[p] * qs, s = ss[p] * qs; o[2 * p] = v[2 * p] * c - v[2 * p + 1] * s; o[2 * p + 1] = v[2 * p + 1] * c + v[2 * p] * s; } }
            else {
#pragma unroll
                for (int j = 0; j < W; ++j) o[j] = v[j] * qs; }
        } else if (col >= 768) {
#pragma unroll
            for (int j = 0; j < W; j += 2) { const f32x2_ g = gelu_tanh2((f32x2_){v[j], v[j + 1]}); o[j] = g.x; o[j + 1] = g.y; }
        } else {
#pragma unroll
            for (int j = 0; j < W; ++j) o[j] = v[j];
        }
        store_bf16<W>(Z + (size_t)row * ZE + col, o);
    }
};
struct EpiInOdd {
    static constexpr int GROUPS = 1;
    bf16* Z; const float* cosc; const float* sinc; unsigned long long* rs;
    template <int W> __device__ __forceinline__ float ssq(const float (&v)[W]) const { float s = 0.f;
#pragma unroll
        for (int j = 0; j < W; ++j) s += v[j] * v[j]; return s; }
    __device__ __forceinline__ int stat_kind(int col) const { return col < 256 ? 1 : (col < 640 ? 2 : 0); }
    __device__ __forceinline__ void add_stat(int row, int kind, float s) const { atomicAdd(rs + (kind == 1 ? MT : 0) + row, (unsigned long long)(s * RS_SCALE)); }
    template <int W> __device__ __forceinline__ void chunk(int row, int col, const float (&v)[W]) const {
        float o[W];
        if (col >= 640 && col < 672 && row < NLAT) { const int pos = row & 4095, i0 = (col - 640) >> 1;
#pragma unroll
            for (int p = 0; p < W / 2; ++p) { const float c = cosc[pos * 16 + i0 + p], s = sinc[pos * 16 + i0 + p]; o[2 * p] = v[2 * p] * c - v[2 * p + 1] * s; o[2 * p + 1] = v[2 * p + 1] * c + v[2 * p] * s; }
        } else {
#pragma unroll
            for (int j = 0; j < W; ++j) o[j] = v[j];
        }
        store_bf16<W>(Z + (size_t)row * ZO + col, o);
    }
};
struct EpiUpQ {
    static constexpr int GROUPS = 1;
    bf16* Q; const float* cosc; const float* sinc; const unsigned long long* rs;
    static constexpr bool ROWCTX = true;
    __device__ __forceinline__ float rowctx(int row) const { return QSCALE_O * __builtin_amdgcn_rsqf((float)rs[row] * (RS_INV / 384.0f) + EPS); }
    template <int W> __device__ __forceinline__ void chunk(int row, int col, const float (&v)[W]) const { chunk_r<W>(row, col, v, rowctx(row)); }
    template <int W> __device__ __forceinline__ void chunk_r(int row, int col, const float (&v)[W], const float rstd) const {
        float o[W]; const int w = col % 96;
        if (w >= 64 && row < NLAT) { const int pos = row & 4095, i0 = (w - 64) >> 1;
            float cc[W / 2], ss[W / 2];
            if constexpr (W == 8) { const f32x4 c4 = *(const f32x4*)(cosc + pos * 16 + i0), s4 = *(const f32x4*)(sinc + pos * 16 + i0); cc[0] = c4.x; cc[1] = c4.y; cc[2] = c4.z; cc[3] = c4.w; ss[0] = s4.x; ss[1] = s4.y; ss[2] = s4.z; ss[3] = s4.w; }
            else {
#pragma unroll
                for (int p = 0; p < W / 2; ++p) { cc[p] = cosc[pos * 16 + i0 + p]; ss[p] = sinc[pos * 16 + i0 + p]; } }
#pragma unroll
            for (int p = 0; p < W / 2; ++p) { const float c = cc[p], s = ss[p]; o[2 * p] = (v[2 * p] * c - v[2 * p + 1] * s) * rstd; o[2 * p + 1] = (v[2 * p + 1] * c + v[2 * p] * s) * rstd; }
        } else {
#pragma unroll
            for (int j = 0; j < W; ++j) o[j] = v[j] * rstd;
        }
        store_bf16<W>(Q + (size_t)row * 768 + col, o);
    }
};
struct EpiUpKV {
    static constexpr int GROUPS = 1;
    bf16* KV; const unsigned long long* rs;
    static constexpr bool ROWCTX = true;
    __device__ __forceinline__ float rowctx(int row) const { return __builtin_amdgcn_rsqf((float)rs[MT + row] * (RS_INV / 256.0f) + EPS); }
    template <int W> __device__ __forceinline__ void chunk(int row, int col, const float (&v)[W]) const { chunk_r<W>(row, col, v, rowctx(row)); }
    template <int W> __device__ __forceinline__ void chunk_r(int row, int col, const float (&v)[W], const float rstd) const {
        float o[W];
#pragma unroll
        for (int j = 0; j < W; ++j) o[j] = v[j] * rstd;
        store_bf16<W>(KV + (size_t)row * 1024 + col, o);
    }
};
struct EpiOut {
    static constexpr int GROUPS = 2;
    bf16* X; const float* mod;
    static constexpr bool GATES = true;
    __device__ __forceinline__ void gates(int row0, int col, f32x4& g0, f32x4& g1) const { const float* g = mod + ((size_t)row_r(row0) * 6 + 2) * 1024 + col; g0 = *(const f32x4*)g; g1 = *(const f32x4*)(g + 4); }
    __device__ __forceinline__ void chunk_g(int row, int col, const float (&v)[8], const f32x4 g0, const f32x4 g1) const {
        bf16* x = X + (size_t)row * 1024 + col; const v4u xv = *(const v4u*)x; v4u o;
        o.x = pk2(bflo(xv.x) + g0.x * v[0], bfhi(xv.x) + g0.y * v[1]); o.y = pk2(bflo(xv.y) + g0.z * v[2], bfhi(xv.y) + g0.w * v[3]);
        o.z = pk2(bflo(xv.z) + g1.x * v[4], bfhi(xv.z) + g1.y * v[5]); o.w = pk2(bflo(xv.w) + g1.z * v[6], bfhi(xv.w) + g1.w * v[7]);
        *(v4u*)x = o;
    }
    template <int W> __device__ __forceinline__ void chunk(int row, int col, const float (&v)[W]) const {
        const float* g = mod + ((size_t)row_r(row) * 6 + 2) * 1024 + col;
        bf16* x = X + (size_t)row * 1024 + col;
        if constexpr (W == 8) {
            const f32x4 g0 = *(const f32x4*)g, g1 = *(const f32x4*)(g + 4); const v4u xv = *(const v4u*)x; v4u o;
            o.x = pk2(bflo(xv.x) + g0.x * v[0], bfhi(xv.x) + g0.y * v[1]); o.y = pk2(bflo(xv.y) + g0.z * v[2], bfhi(xv.y) + g0.w * v[3]);
            o.z = pk2(bflo(xv.z) + g1.x * v[4], bfhi(xv.z) + g1.y * v[5]); o.w = pk2(bflo(xv.w) + g1.z * v[6], bfhi(xv.w) + g1.w * v[7]);
            *(v4u*)x = o;
        } else {
#pragma unroll
            for (int j = 0; j < W; j += 4) { const f32x4 gv = *(const f32x4*)(g + j); const v2u xv = *(const v2u*)(x + j); v2u o;
                o.x = pk2(bflo(xv.x) + gv.x * v[j], bfhi(xv.x) + gv.y * v[j + 1]); o.y = pk2(bflo(xv.y) + gv.z * v[j + 2], bfhi(xv.y) + gv.w * v[j + 3]); *(v2u*)(x + j) = o; }
        }
    }
};
struct EpiNull {
    static constexpr int GROUPS = 1;
    template <int W> __device__ __forceinline__ void chunk(int, int, const float (&v)[W]) const {
#pragma unroll
        for (int j = 0; j < W; ++j) asm volatile("" :: "v"(v[j])); }
};
struct EpiF1 {
    static constexpr int GROUPS = 1;
    bf16* Gm;
    static constexpr bool PAIR = (FP8_F2 != 0);
    __device__ __forceinline__ v2u pack8(const float (&a)[8], const float (&b)[8]) const {
        float o[8];
#pragma unroll
        for (int j = 0; j < 8; j += 2) { constexpr int SIN = FP8_F1 ? (int)(F8_SA * F8_SW) : 1, SOUT = (int)F8_SG;
            const f32x2_ g = silu_gate2<SIN, SOUT>((f32x2_){a[j], a[j + 1]}, (f32x2_){b[j], b[j + 1]}); o[j] = clampf_(g.x, 448.f); o[j + 1] = clampf_(g.y, 448.f); }
        v2u w; w.x = pk4_fp8(o[0], o[1], o[2], o[3]); w.y = pk4_fp8(o[4], o[5], o[6], o[7]); return w;
    }
    __device__ __forceinline__ void pair_dual(int row, int f, int fq, const float (&a0)[8], const float (&b0)[8], const float (&a1)[8], const float (&b1)[8]) const {
        v2u x = pack8(a0, b0), y = pack8(a1, b1);
        asm volatile("s_nop 1\n\tv_permlane16_swap_b32 %0, %1" : "+v"(x.x), "+v"(y.x));
        asm volatile("s_nop 1\n\tv_permlane16_swap_b32 %0, %1" : "+v"(x.y), "+v"(y.y));
        const bool odd = fq & 1;
        *(v4u*)((unsigned char*)Gm + (size_t)(row + (odd ? 16 : 0)) * 1024 + f - (odd ? 8 : 0)) = (v4u){x.x, x.y, y.x, y.y};
    }
    template <int W> __device__ __forceinline__ void dual(int row, int f, const float (&a)[W], const float (&b)[W]) const {
        float o[W];
        constexpr float inv = FP8_F1 ? 1.0f / (F8_SA * F8_SW) : 1.0f;
#pragma unroll
        for (int j = 0; j < W; j += 2) { constexpr int SIN = FP8_F1 ? (int)(F8_SA * F8_SW) : 1, SOUT = FP8_F2 ? (int)F8_SG : 1;
            const f32x2_ g = silu_gate2<SIN, SOUT>((f32x2_){a[j], a[j + 1]}, (f32x2_){b[j], b[j + 1]}); o[j] = g.x; o[j + 1] = g.y; }
        if constexpr (FP8_F2) {
#pragma unroll
            for (int j = 0; j < W; ++j) o[j] = clampf_(o[j], 448.f);
            unsigned char* gp = (unsigned char*)Gm + (size_t)row * 1024 + f;
            if constexpr (W == 8) { v2u w; w.x = pk4_fp8(o[0], o[1], o[2], o[3]); w.y = pk4_fp8(o[4], o[5], o[6], o[7]); *(v2u*)gp = w; }
            else *(unsigned*)gp = pk4_fp8(o[0], o[1], o[2], o[3]);
        } else store_bf16<W>(Gm + (size_t)row * 1024 + f, o);
    }
};
struct EpiF2 {
    static constexpr int GROUPS = 1;
    bf16* Y;
    static constexpr bool PAIR = (FP8_Y != 0);
    __device__ __forceinline__ v2u pack8(const float (&v)[8]) const {
        constexpr float sc = (FP8_F2 ? 1.0f / (F8_SG * F8_SW) : 1.0f) * F8_SY;
        float o[8];
#pragma unroll
        for (int j = 0; j < 8; j += 2) { const f32x2_ t = (f32x2_){v[j], v[j + 1]} * sc; o[j] = clampf_(t.x, 448.f); o[j + 1] = clampf_(t.y, 448.f); }
        v2u w; w.x = pk4_fp8(o[0], o[1], o[2], o[3]); w.y = pk4_fp8(o[4], o[5], o[6], o[7]); return w;
    }
    __device__ __forceinline__ void pair(int row, int col, int fq, const float (&va)[8], const float (&vb)[8]) const {
        v2u a = pack8(va), b = pack8(vb);
        asm volatile("s_nop 1\n\tv_permlane16_swap_b32 %0, %1" : "+v"(a.x), "+v"(b.x));
        asm volatile("s_nop 1\n\tv_permlane16_swap_b32 %0, %1" : "+v"(a.y), "+v"(b.y));
        const bool odd = fq & 1;
        *(v4u*)((unsigned char*)Y + (size_t)(row + (odd ? 16 : 0)) * 1024 + col - (odd ? 8 : 0)) = (v4u){a.x, a.y, b.x, b.y};
    }
    template <int W> __device__ __forceinline__ void chunk(int row, int col, const float (&v)[W]) const {
        constexpr float sc = (FP8_F2 ? 1.0f / (F8_SG * F8_SW) : 1.0f) * (FP8_Y ? F8_SY : 1.0f);
        float o[W];
#pragma unroll
        for (int j = 0; j < W; j += 2) { const f32x2_ t = (f32x2_){v[j], v[j + 1]} * sc; o[j] = t.x; o[j + 1] = t.y; }
        if constexpr (FP8_Y) {
#pragma unroll
            for (int j = 0; j < W; ++j) o[j] = clampf_(o[j], 448.f);
            unsigned char* yp = (unsigned char*)Y + (size_t)row * 1024 + col;
            if constexpr (W == 8) { v2u w; w.x = pk4_fp8(o[0], o[1], o[2], o[3]); w.y = pk4_fp8(o[4], o[5], o[6], o[7]); *(v2u*)yp = w; }
            else *(unsigned*)yp = pk4_fp8(o[0], o[1], o[2], o[3]);
        } else store_bf16<W>(Y + (size_t)row * 1024 + col, o);
    }
};

namespace pg8 {
#define PG8_LAS __attribute__((address_space(3)))
typedef unsigned short bf16_t;
typedef short bf16x8 __attribute__((ext_vector_type(8)));
typedef float f32x4 __attribute__((ext_vector_type(4)));
typedef int v8i_t __attribute__((ext_vector_type(8)));
typedef int v4i_t __attribute__((ext_vector_type(4)));
constexpr int BM = 256, BK = 64, HALF = 128, HTB = HALF * BK * 2, STAGE_BYTES = 8 * HTB, NXCD = 8, WGM = 8;
template <int SW> __host__ __device__ __forceinline__ int lds_byte(int r, int c) { const int st = (r >> 4) * 2 + (c >> 5), rr = r & 15, cc = c & 31, ob = rr * 64 + cc * 2; return st * 1024 + (ob ^ (((ob >> 9) & 1) << SW)); }
template <int SW> __host__ __device__ __forceinline__ void stage_rc(int b, int& R, int& C) { const int st = b / 1024, sb = b % 1024, swz = sb ^ (((sb >> 9) & 1) << SW); R = (st >> 1) * 16 + swz / 64; C = (st & 1) * 32 + (swz % 64) / 2; }
__host__ __device__ __forceinline__ int perm32(int rho) { const int n = rho >> 4, i = rho & 15; return 8 * (i >> 2) + 4 * n + (i & 3); }
struct Unit { int pm, pn, brow; };
struct Gemm { const bf16_t* A; const bf16_t* Bt; int lda, ldb, K; const int* gather; };
struct StaticOrder {
    int nM, nN, nwg, G, c, bpe, lat_only;
    __device__ void init(int M, int N, int G_, int c_, int bpe_, int lat_only_ = 0) { nM = M / BM; nN = N / BM; nwg = nM * nN; G = G_; c = c_; bpe = bpe_; lat_only = lat_only_; }
    __device__ bool next(int i, Unit& u) const {
        const long L = (long)i * G + c; if (L >= nwg) return false;
        int wgid = (int)L; { const int q = nwg / NXCD, r = nwg % NXCD, xcd = wgid % NXCD, off = wgid / NXCD; wgid = (xcd < r ? xcd * (q + 1) : r * (q + 1) + (xcd - r) * q) + off; }
        const int nig = WGM * nN, gid = wgid / nig, fm = gid * WGM, gsz = (nM - fm) < WGM ? (nM - fm) : WGM;
        u.pm = fm + ((wgid % nig) % gsz); u.pn = (wgid % nig) / gsz; if (lat_only) u.pm = (u.pm >> 4) * 17 + (u.pm & 15); u.brow = u.pn * BM + (bpe ? (u.pm / 17) * bpe : 0); return true;
    }
};
template <class E, class = void> struct EpiRowCtx { static constexpr bool value = false; };
template <class E> struct EpiRowCtx<E, decltype((void)E::ROWCTX, void())> { static constexpr bool value = E::ROWCTX; };
template <class E, class = void> struct EpiGates { static constexpr bool value = false; };
template <class E> struct EpiGates<E, decltype((void)E::GATES, void())> { static constexpr bool value = E::GATES; };
template <class E, class = void> struct EpiPair { static constexpr bool value = false; };
template <class E> struct EpiPair<E, decltype((void)E::PAIR, void())> { static constexpr bool value = E::PAIR; };
template <bool DUAL, int STAT, class E>
__device__ __forceinline__ void run_epi(const E& e, const f32x4 (&acc)[2][2][4][2], const Unit& u, int wr, int wc, int fr, int fq) {
    if constexpr (EpiRowCtx<E>::value && !DUAL && STAT == 0) {
#pragma unroll
        for (int ai = 0; ai < 2; ++ai)
#pragma unroll
            for (int m = 0; m < 4; ++m) {
                const int row = u.pm * BM + ai * HALF + wr * 64 + m * 16 + fr;
                const float rc = e.rowctx(row);
#pragma unroll
                for (int bj = 0; bj < 2; ++bj) {
                    const float v[8] = {acc[ai][bj][m][0][0], acc[ai][bj][m][0][1], acc[ai][bj][m][0][2], acc[ai][bj][m][0][3], acc[ai][bj][m][1][0], acc[ai][bj][m][1][1], acc[ai][bj][m][1][2], acc[ai][bj][m][1][3]};
                    e.template chunk_r<8>(row, u.pn * BM + bj * HALF + wc * 32 + 8 * fq, v, rc);
                }
                if ((m % E::GROUPS) == E::GROUPS - 1) asm volatile("" ::: "memory");
            }
        return;
    }
    if constexpr (EpiGates<E>::value && !DUAL && STAT == 0) {
        f32x4 g0[2], g1[2];
#pragma unroll
        for (int bj = 0; bj < 2; ++bj) e.gates(u.pm * BM, u.pn * BM + bj * HALF + wc * 32 + 8 * fq, g0[bj], g1[bj]);
#pragma unroll
        for (int ai = 0; ai < 2; ++ai)
#pragma unroll
            for (int m = 0; m < 4; ++m) {
#pragma unroll
                for (int bj = 0; bj < 2; ++bj) {
                    const float v[8] = {acc[ai][bj][m][0][0], acc[ai][bj][m][0][1], acc[ai][bj][m][0][2], acc[ai][bj][m][0][3], acc[ai][bj][m][1][0], acc[ai][bj][m][1][1], acc[ai][bj][m][1][2], acc[ai][bj][m][1][3]};
                    e.chunk_g(u.pm * BM + ai * HALF + wr * 64 + m * 16 + fr, u.pn * BM + bj * HALF + wc * 32 + 8 * fq, v, g0[bj], g1[bj]);
                }
                if ((m % E::GROUPS) == E::GROUPS - 1) asm volatile("" ::: "memory");
            }
        return;
    }
    if constexpr (EpiPair<E>::value && DUAL) {
#pragma unroll
        for (int ai = 0; ai < 2; ++ai)
#pragma unroll
            for (int m = 0; m < 4; m += 2) {
                const float a0[8] = {acc[ai][0][m][0][0], acc[ai][0][m][0][1], acc[ai][0][m][0][2], acc[ai][0][m][0][3], acc[ai][0][m][1][0], acc[ai][0][m][1][1], acc[ai][0][m][1][2], acc[ai][0][m][1][3]};
                const float b0[8] = {acc[ai][1][m][0][0], acc[ai][1][m][0][1], acc[ai][1][m][0][2], acc[ai][1][m][0][3], acc[ai][1][m][1][0], acc[ai][1][m][1][1], acc[ai][1][m][1][2], acc[ai][1][m][1][3]};
                const float a1[8] = {acc[ai][0][m + 1][0][0], acc[ai][0][m + 1][0][1], acc[ai][0][m + 1][0][2], acc[ai][0][m + 1][0][3], acc[ai][0][m + 1][1][0], acc[ai][0][m + 1][1][1], acc[ai][0][m + 1][1][2], acc[ai][0][m + 1][1][3]};
                const float b1[8] = {acc[ai][1][m + 1][0][0], acc[ai][1][m + 1][0][1], acc[ai][1][m + 1][0][2], acc[ai][1][m + 1][0][3], acc[ai][1][m + 1][1][0], acc[ai][1][m + 1][1][1], acc[ai][1][m + 1][1][2], acc[ai][1][m + 1][1][3]};
                e.pair_dual(u.pm * BM + ai * HALF + wr * 64 + m * 16 + fr, u.pn * HALF + wc * 32 + 8 * fq, fq, a0, b0, a1, b1);
            }
        return;
    }
    if constexpr (EpiPair<E>::value && !DUAL && STAT == 0) {
#pragma unroll
        for (int ai = 0; ai < 2; ++ai)
#pragma unroll
            for (int m = 0; m < 4; m += 2)
#pragma unroll
                for (int bj = 0; bj < 2; ++bj) {
                    const float va[8] = {acc[ai][bj][m][0][0], acc[ai][bj][m][0][1], acc[ai][bj][m][0][2], acc[ai][bj][m][0][3], acc[ai][bj][m][1][0], acc[ai][bj][m][1][1], acc[ai][bj][m][1][2], acc[ai][bj][m][1][3]};
                    const float vb[8] = {acc[ai][bj][m + 1][0][0], acc[ai][bj][m + 1][0][1], acc[ai][bj][m + 1][0][2], acc[ai][bj][m + 1][0][3], acc[ai][bj][m + 1][1][0], acc[ai][bj][m + 1][1][1], acc[ai][bj][m + 1][1][2], acc[ai][bj][m + 1][1][3]};
                    e.pair(u.pm * BM + ai * HALF + wr * 64 + m * 16 + fr, u.pn * BM + bj * HALF + wc * 32 + 8 * fq, fq, va, vb);
                }
        return;
    }
#pragma unroll
    for (int ai = 0; ai < 2; ++ai)
#pragma unroll
        for (int m = 0; m < 4; ++m) {
            const int row = u.pm * BM + ai * HALF + wr * 64 + m * 16 + fr;
            if constexpr (DUAL) {
                const float a[8] = {acc[ai][0][m][0][0], acc[ai][0][m][0][1], acc[ai][0][m][0][2], acc[ai][0][m][0][3], acc[ai][0][m][1][0], acc[ai][0][m][1][1], acc[ai][0][m][1][2], acc[ai][0][m][1][3]};
                const float b[8] = {acc[ai][1][m][0][0], acc[ai][1][m][0][1], acc[ai][1][m][0][2], acc[ai][1][m][0][3], acc[ai][1][m][1][0], acc[ai][1][m][1][1], acc[ai][1][m][1][2], acc[ai][1][m][1][3]};
                e.template dual<8>(row, u.pn * HALF + wc * 32 + 8 * fq, a, b);
            } else {
#pragma unroll
                for (int bj = 0; bj < 2; ++bj) {
                    const int col = u.pn * BM + bj * HALF + wc * 32 + 8 * fq;
                    const float v[8] = {acc[ai][bj][m][0][0], acc[ai][bj][m][0][1], acc[ai][bj][m][0][2], acc[ai][bj][m][0][3], acc[ai][bj][m][1][0], acc[ai][bj][m][1][1], acc[ai][bj][m][1][2], acc[ai][bj][m][1][3]};
                    if constexpr (STAT) { const int kind = e.stat_kind(u.pn * BM + bj * HALF + wc * 32);
                        if (kind) { float s = e.template ssq<8>(v); s += __shfl_xor(s, 16); s += __shfl_xor(s, 32); if (fq == 0) e.add_stat(row, kind, s); } }
                    e.template chunk<8>(row, col, v);
                }
            }
            if ((m % E::GROUPS) == E::GROUPS - 1) asm volatile("" ::: "memory");
        }
}
template <bool DUAL, int STAT, bool GATHER, bool FP8, class Epi, class Sched>
__device__ __forceinline__ void gemm_phase(PG8_LAS unsigned char* lds, const Gemm g, const Sched& S, const Epi& E, const int tid  ) {
    const int wid = __builtin_amdgcn_readfirstlane(tid >> 6), lane = tid & 63, wr = wid >> 2, wc = wid & 3, fr = lane & 15, fq = lane >> 4;
    const int K = g.K, nt = K / BK;
    int RA[2], CA[2]; unsigned voffA[2], voffB[2];
#pragma unroll
    for (int i = 0; i < 2; ++i) { int R, C; stage_rc<FP8 ? 4 : 5>(tid * 16 + i * 8192, R, C); RA[i] = R; CA[i] = C; const int Rb = (R & ~31) + perm32(R & 31); voffA[i] = (unsigned)(R * g.lda + C) * 2u; voffB[i] = (unsigned)(Rb * g.ldb + C) * 2u; }
    const size_t kstep = (size_t)(BK * 2);
    const size_t hstepB = (size_t)HALF * g.ldb * 2, hstepA = (size_t)HALF * g.lda * 2, tstepA = 2 * hstepA;
    const unsigned ldsw = (unsigned)wid * 1024u;
    const int aoff = FP8 ? lds_byte<4>(wr * 64 + fr, fq * 16) : lds_byte<5>(wr * 64 + fr, fq * 8), boff = FP8 ? lds_byte<4>(wc * 32 + fr, fq * 16) : lds_byte<5>(wc * 32 + fr, fq * 8);
#define PG8_SA(b, h) (((b) * 2 + (h)) * HTB)
#define PG8_SB(b, h) ((4 + (b) * 2 + (h)) * HTB)
#define PG8_STAGE(bufoff, gbase, voff) do { _Pragma("unroll") for (int _i = 0; _i < 2; ++_i) \
        __builtin_amdgcn_global_load_lds((const unsigned*)((const char*)(gbase) + (voff)[_i]), (PG8_LAS unsigned*)(lds + (bufoff) + ldsw + _i * 8192), 16, 0, 0); } while (0)
#define PG8_LD16(p_) (*(const PG8_LAS v4i_t*)(p_))
#define PG8_LDA(dst, b, h) do { _Pragma("unroll") for (int m = 0; m < 4; ++m) { \
        if constexpr (FP8) { const v4i_t lo_ = PG8_LD16(lds + PG8_SA(b, h) + aoff + m * 2048), hi_ = PG8_LD16(lds + PG8_SA(b, h) + ((aoff + m * 2048) ^ 16)); dst##8[m] = __builtin_shufflevector(lo_, hi_, 0, 1, 2, 3, 4, 5, 6, 7); } \
        else { _Pragma("unroll") for (int k = 0; k < 2; ++k) dst[m][k] = *(const PG8_LAS bf16x8*)(lds + PG8_SA(b, h) + aoff + m * 2048 + k * 1024); } } } while (0)
#define PG8_LDB(dst, b, h) do { _Pragma("unroll") for (int n = 0; n < 2; ++n) { \
        if constexpr (FP8) { const v4i_t lo_ = PG8_LD16(lds + PG8_SB(b, h) + boff + n * 2048), hi_ = PG8_LD16(lds + PG8_SB(b, h) + ((boff + n * 2048) ^ 16)); dst##8[n] = __builtin_shufflevector(lo_, hi_, 0, 1, 2, 3, 4, 5, 6, 7); } \
        else { _Pragma("unroll") for (int k = 0; k < 2; ++k) dst[n][k] = *(const PG8_LAS bf16x8*)(lds + PG8_SB(b, h) + boff + n * 2048 + k * 1024); } } } while (0)
#define PG8_MMA(ai, bj, At, Bt) do { __builtin_amdgcn_s_setprio(1); _Pragma("unroll") for (int m = 0; m < 4; ++m) _Pragma("unroll") for (int n = 0; n < 2; ++n) { \
        if constexpr (FP8) asm volatile("v_mfma_scale_f32_16x16x128_f8f6f4 %0, %1, %2, %0, %3, %3 op_sel_hi:[0,0,0]" : "+v"(acc[ai][bj][m][n]) : "v"(Bt##8[n]), "v"(At##8[m]), "v"(one_scale));   \
        else { _Pragma("unroll") for (int k = 0; k < 2; ++k) acc[ai][bj][m][n] = __builtin_amdgcn_mfma_f32_16x16x32_bf16(Bt[n][k], At[m][k], acc[ai][bj][m][n], 0, 0, 0); } } __builtin_amdgcn_s_setprio(0); } while (0)
#define PG8_WAIT_V(n) asm volatile("s_waitcnt vmcnt(" #n ")" ::: "memory")
#define PG8_WAIT_L(n) asm volatile("s_waitcnt lgkmcnt(" #n ")" ::: "memory")
#define PG8_BAR __builtin_amdgcn_s_barrier()
#define PG8_SCHED __builtin_amdgcn_sched_barrier(0)
#define PG8_AOFFS(dst, u) do { _Pragma("unroll") for (int _h = 0; _h < 2; ++_h) _Pragma("unroll") for (int _i = 0; _i < 2; ++_i) { const int _m = (u).pm * BM + _h * HALF + RA[_i]; \
        const int _r = g.gather ? g.gather[_m] : _m; dst[_h][_i] = (unsigned)(_r * g.lda + CA[_i]) * 2u; } } while (0)
    Unit cur, nxt; int ui = 0;
    if (!S.next(0, cur)) return;
    f32x4 acc[2][2][4][2];
#pragma unroll
    for (int a = 0; a < 2; ++a)
#pragma unroll
        for (int b = 0; b < 2; ++b)
#pragma unroll
            for (int m = 0; m < 4; ++m)
#pragma unroll
                for (int n = 0; n < 2; ++n) acc[a][b][m][n] = (f32x4){0.f, 0.f, 0.f, 0.f};
    bf16x8 At[FP8 ? 1 : 4][2], B0[FP8 ? 1 : 2][2], B1[FP8 ? 1 : 2][2];
    v8i_t At8[FP8 ? 4 : 1], B08[FP8 ? 2 : 1], B18[FP8 ? 2 : 1];
    int one_scale = 0x7f7f7f7f; asm volatile("" : "+v"(one_scale));
    unsigned curA[GATHER ? 2 : 1][2], nxtA[GATHER ? 2 : 1][2];
    const char* cA = (const char*)g.A; const char* nA = cA;
    if constexpr (GATHER) { PG8_AOFFS(curA, cur); } else { cA += (size_t)cur.pm * tstepA; }
#define PG8_STA(bufoff, base, offs, h, kof) do { if constexpr (GATHER) { PG8_STAGE(bufoff, (base) + (kof), (offs)[h]); } else { PG8_STAGE(bufoff, (base) + (kof) + (h) * hstepA, voffA); } } while (0)
    const char* cB = (const char*)g.Bt + (size_t)cur.brow * g.ldb * 2;
    PG8_STAGE(PG8_SB(0, 0), cB, voffB); PG8_STAGE(PG8_SB(0, 1), cB + hstepB, voffB); PG8_STA(PG8_SA(0, 0), cA, curA, 0, 0); PG8_STA(PG8_SA(0, 1), cA, curA, 1, 0);
    if (wr == 1) PG8_BAR;
    PG8_WAIT_V(2); PG8_BAR;
    PG8_STAGE(PG8_SB(1, 0), cB + kstep, voffB); PG8_STA(PG8_SA(1, 0), cA, curA, 0, kstep); PG8_STAGE(PG8_SB(1, 1), cB + hstepB + kstep, voffB);
    PG8_WAIT_V(6); PG8_BAR;
    for (;;) {
        const bool has_next = S.next(ui + 1, nxt);
        if constexpr (GATHER) {
            if (has_next) { PG8_AOFFS(nxtA, nxt); }
            else {
#pragma unroll
                for (int h = 0; h < 2; ++h)
#pragma unroll
                    for (int i = 0; i < 2; ++i) nxtA[h][i] = curA[h][i]; }
        } else nA = has_next ? (const char*)g.A + (size_t)nxt.pm * tstepA : cA;
        const char* nB = has_next ? (const char*)g.Bt + (size_t)nxt.brow * g.ldb * 2 : cB;
#pragma unroll 1
        for (int t = 0; t < nt; t += 2) {
            const bool last = (t == nt - 2);
            const size_t k1 = (size_t)(t + 1) * kstep, k2 = last ? 0 : (size_t)(t + 2) * kstep, k3 = k2 + kstep;
            const char* b2 = last ? nB : cB + (size_t)(t + 2) * kstep; const char* b3 = b2 + kstep;
            const char* a2 = last ? nA : cA;
            unsigned sA[GATHER ? 2 : 1][2];
            if constexpr (GATHER) {
#pragma unroll
                for (int h = 0; h < 2; ++h)
#pragma unroll
                    for (int i = 0; i < 2; ++i) sA[h][i] = last ? nxtA[h][i] : curA[h][i]; }
            PG8_LDB(B0, 0, 0); PG8_LDB(B1, 0, 1); PG8_SCHED; PG8_LDA(At, 0, 0); PG8_STA(PG8_SA(1, 1), cA, curA, 1, k1);
            PG8_WAIT_V(8); PG8_WAIT_L(0); PG8_BAR; PG8_MMA(0, 0, At, B0); PG8_MMA(0, 1, At, B1); PG8_BAR; PG8_SCHED;
            PG8_LDA(At, 0, 1); PG8_STAGE(PG8_SB(0, 0), b2, voffB); PG8_STAGE(PG8_SB(0, 1), b2 + hstepB, voffB); PG8_STA(PG8_SA(0, 0), a2, sA, 0, k2);
            PG8_WAIT_V(8); PG8_WAIT_L(0); PG8_BAR; PG8_MMA(1, 0, At, B0); PG8_MMA(1, 1, At, B1); PG8_BAR; PG8_SCHED;
            PG8_LDB(B0, 1, 0); PG8_LDB(B1, 1, 1); PG8_SCHED; PG8_LDA(At, 1, 0); PG8_STA(PG8_SA(0, 1), a2, sA, 1, k2);
            PG8_WAIT_V(8); PG8_WAIT_L(0); PG8_BAR; PG8_MMA(0, 0, At, B0); PG8_MMA(0, 1, At, B1); PG8_BAR; PG8_SCHED;
            PG8_LDA(At, 1, 1); PG8_STAGE(PG8_SB(1, 0), b3, voffB); PG8_STAGE(PG8_SB(1, 1), b3 + hstepB, voffB); PG8_STA(PG8_SA(1, 0), a2, sA, 0, k3);
            PG8_WAIT_V(8); PG8_WAIT_L(0); PG8_BAR; PG8_MMA(1, 0, At, B0); PG8_MMA(1, 1, At, B1); PG8_BAR; PG8_SCHED;
        }
        if (wr == 0) PG8_BAR;
        if constexpr (FP8) asm volatile("s_nop 15\n\ts_nop 15" ::: "memory");
        run_epi<DUAL, STAT>(E, acc, cur, wr, wc, fr, fq);
        if (!has_next) break;
#pragma unroll
        for (int a = 0; a < 2; ++a)
#pragma unroll
            for (int b = 0; b < 2; ++b)
#pragma unroll
                for (int m = 0; m < 4; ++m)
#pragma unroll
                    for (int n = 0; n < 2; ++n) acc[a][b][m][n] = (f32x4){0.f, 0.f, 0.f, 0.f};
        cur = nxt; cB = nB; cA = nA; ++ui;
        if constexpr (GATHER) {
#pragma unroll
            for (int h = 0; h < 2; ++h)
#pragma unroll
                for (int i = 0; i < 2; ++i) curA[h][i] = nxtA[h][i]; }
        if (wr == 1) PG8_BAR;
    }
    PG8_WAIT_V(0);
    PG8_BAR;
#undef PG8_SA
#undef PG8_SB
#undef PG8_STAGE
#undef PG8_LDA
#undef PG8_LDB
#undef PG8_MMA
#undef PG8_LD16
#undef PG8_WAIT_V
#undef PG8_WAIT_L
#undef PG8_BAR
#undef PG8_SCHED
#undef PG8_AOFFS
#undef PG8_STA
}
}

struct ARowsPlain { const bf16* A; int lda; __device__ __forceinline__ const bf16* operator()(int m) const { return A + (size_t)m * lda; } };
struct ARowsGather { const bf16* A; int lda; const int* src; __device__ __forceinline__ const bf16* operator()(int m) const { return A + (size_t)src[m] * lda; } };
template <bool DUAL, int STAT, class AF, class Epi>
__device__ __forceinline__ void simple_gemm(Frame& F, int M, int N, int K, const AF& af, const bf16* Bt, int ldb, int brow_per_expert  , const Epi& E) {
    LAS float* As = (LAS float*)F.lds;
    LAS float* Bs = As + 16 * 132;
    const int nM = M / 128, nN = N / 256, ntile = nM * nN;
    const int ty = F.tid >> 5, tx = F.tid & 31;
    for (int t = F.vcu; t < ntile; t += F.G) {
        const int pm = t / nN, pn = t % nN, m0 = pm * 128, n0 = pn * 256;
        const bf16* Bb = Bt + (size_t)(brow_per_expert ? (m0 / EROWS) * brow_per_expert : 0) * ldb + (size_t)n0 * ldb;
        float lo[8][4], hi[8][4];
#pragma unroll
        for (int r = 0; r < 8; ++r)
#pragma unroll
            for (int j = 0; j < 4; ++j) { lo[r][j] = 0.f; hi[r][j] = 0.f; }
        const bf16* arow = af(m0 + (F.tid >> 2));
        for (int k0 = 0; k0 < K; k0 += 16) {
            { const v2u w = *(const v2u*)(arow + k0 + (F.tid & 3) * 4); const int kk = (F.tid & 3) * 4, m = F.tid >> 2;
              As[(kk + 0) * 132 + m] = bflo(w.x); As[(kk + 1) * 132 + m] = bfhi(w.x); As[(kk + 2) * 132 + m] = bflo(w.y); As[(kk + 3) * 132 + m] = bfhi(w.y); }
            { const v4u w = *(const v4u*)(Bb + (size_t)(F.tid >> 1) * ldb + k0 + (F.tid & 1) * 8); const int kk = (F.tid & 1) * 8, n = F.tid >> 1;
              Bs[(kk + 0) * 260 + n] = bflo(w.x); Bs[(kk + 1) * 260 + n] = bfhi(w.x); Bs[(kk + 2) * 260 + n] = bflo(w.y); Bs[(kk + 3) * 260 + n] = bfhi(w.y);
              Bs[(kk + 4) * 260 + n] = bflo(w.z); Bs[(kk + 5) * 260 + n] = bfhi(w.z); Bs[(kk + 6) * 260 + n] = bflo(w.w); Bs[(kk + 7) * 260 + n] = bfhi(w.w); }
            __syncthreads();
#pragma unroll 2
            for (int kk = 0; kk < 16; ++kk) {
                const f32x4 a0 = *(const LAS f32x4*)(As + kk * 132 + ty * 8), a1 = *(const LAS f32x4*)(As + kk * 132 + ty * 8 + 4);
                const f32x4 b0 = *(const LAS f32x4*)(Bs + kk * 260 + tx * 4), b1 = *(const LAS f32x4*)(Bs + kk * 260 + 128 + tx * 4);
                const float a[8] = {a0.x, a0.y, a0.z, a0.w, a1.x, a1.y, a1.z, a1.w};
#pragma unroll
                for (int r = 0; r < 8; ++r) { lo[r][0] += a[r] * b0.x; lo[r][1] += a[r] * b0.y; lo[r][2] += a[r] * b0.z; lo[r][3] += a[r] * b0.w;
                                              hi[r][0] += a[r] * b1.x; hi[r][1] += a[r] * b1.y; hi[r][2] += a[r] * b1.z; hi[r][3] += a[r] * b1.w; }
            }
            __syncthreads();
        }
#pragma unroll
        for (int r = 0; r < 8; ++r) { const int row = m0 + ty * 8 + r;
            if constexpr (DUAL) E.template dual<4>(row, (n0 >> 1) + tx * 4, lo[r], hi[r]);
            else {
                if constexpr (STAT) { const int c0 = n0 + tx * 4, c1 = c0 + 128; const int k0 = E.stat_kind(c0), k1 = E.stat_kind(c1);
                    if (k0) E.add_stat(row, k0, E.template ssq<4>(lo[r])); if (k1) E.add_stat(row, k1, E.template ssq<4>(hi[r])); }
                E.template chunk<4>(row, n0 + tx * 4, lo[r]); E.template chunk<4>(row, n0 + 128 + tx * 4, hi[r]); }
        }
    }
}

template <int NCH> __device__ __forceinline__ float dot_chunks(const v4u* qp, const bf16* k, float acc) {
#pragma unroll
    for (int c = 0; c < NCH; ++c) { const v4u kv = *(const v4u*)(k + 8 * c); const v4u qv = qp[c];
        acc += bflo(qv.x) * bflo(kv.x) + bfhi(qv.x) * bfhi(kv.x) + bflo(qv.y) * bflo(kv.y) + bfhi(qv.y) * bfhi(kv.y)
             + bflo(qv.z) * bflo(kv.z) + bfhi(qv.z) * bfhi(kv.z) + bflo(qv.w) * bflo(kv.w) + bfhi(qv.w) * bfhi(kv.w); }
    return acc;
}
template <bool ODD>
__device__ __forceinline__ void simple_attn(Frame& F, int layer) {
    const int gw = F.vcu * NWAVES + F.wave, NGW = F.G * NWAVES;
    const bool need_ctx = layer < DEPTH - 1;
    const int nrows = need_ctx ? MT : NLAT;
    const bf16* Z = (const bf16*)(F.ws + WS_Z); const bf16* Q = (const bf16*)(F.ws + WS_Q); const bf16* KV = (const bf16*)(F.ws + WS_KV);
    bf16* OS = (bf16*)(F.ws + WS_H);
    for (int task = gw; task < nrows * 8; task += NGW) {
        const int row = task >> 3, h = task & 7, b = row_b(row);
        const bool lat = row < NLAT; const int pos = row & 4095;
        v4u qp[ODD ? 12 : 8];
        { const bf16* q = ODD ? Q + (size_t)row * 768 + h * 96 : Z + (size_t)row * ZE + 256 + h * 64;
#pragma unroll
          for (int c = 0; c < (ODD ? 12 : 8); ++c) qp[c] = *(const v4u*)(q + 8 * c); }
        int nlatk, lat0;
        if (!lat) { nlatk = 0; lat0 = 0; }
        else if (ODD) { nlatk = 4096; lat0 = 0; }
        else { lat0 = pos - 128 < 0 ? 0 : pos - 128; const int hi_ = pos + 128 > 4095 ? 4095 : pos + 128; nlatk = hi_ - lat0 + 1; }
        const int nk = nlatk + 256;
        const int kvh = h >> 2;
        float m_l = -INFINITY, l_l = 0.f;
        for (int j = F.lane; j < nk; j += 64) {
            const int krow = j < nlatk ? b * 4096 + lat0 + j : NLAT + b * 256 + (j - nlatk);
            float s;
            if (ODD) { s = dot_chunks<8>(qp, KV + (size_t)krow * 1024 + h * 128, 0.f); s = dot_chunks<4>(qp + 8, Z + (size_t)krow * ZO + 640, s); }
            else s = dot_chunks<8>(qp, Z + (size_t)krow * ZE + kvh * 64, 0.f);
            if (s > m_l) { l_l = l_l * exp2f(m_l - s) + 1.0f; m_l = s; } else l_l += exp2f(s - m_l);
        }
        float mx = wave_max(m_l);
        float l = wave_sum(l_l * exp2f(m_l - mx));
        if (!ODD) { const float sk = inp(F, IN_EVSINK)[(layer >> 1) * 8 + h] * LOG2E_; const float m2 = fmaxf(mx, sk); l = l * exp2f(mx - m2) + exp2f(sk - m2); mx = m2; }
        const float rl = 1.0f / l;
        float acc[64];
#pragma unroll
        for (int d = 0; d < 64; ++d) acc[d] = 0.f;
        for (int j = F.lane; j < nk; j += 64) {
            const int krow = j < nlatk ? b * 4096 + lat0 + j : NLAT + b * 256 + (j - nlatk);
            float s; const bf16* vp;
            if (ODD) { s = dot_chunks<8>(qp, KV + (size_t)krow * 1024 + h * 128, 0.f); s = dot_chunks<4>(qp + 8, Z + (size_t)krow * ZO + 640, s); vp = KV + (size_t)krow * 1024 + h * 128 + 64; }
            else { s = dot_chunks<8>(qp, Z + (size_t)krow * ZE + kvh * 64, 0.f); vp = Z + (size_t)krow * ZE + 128 + kvh * 64; }
            const float p = exp2f(s - mx) * rl;
#pragma unroll
            for (int c = 0; c < 8; ++c) { const v4u vv = *(const v4u*)(vp + 8 * c);
                acc[8 * c + 0] += p * bflo(vv.x); acc[8 * c + 1] += p * bfhi(vv.x); acc[8 * c + 2] += p * bflo(vv.y); acc[8 * c + 3] += p * bfhi(vv.y);
                acc[8 * c + 4] += p * bflo(vv.z); acc[8 * c + 5] += p * bfhi(vv.z); acc[8 * c + 6] += p * bflo(vv.w); acc[8 * c + 7] += p * bfhi(vv.w); }
        }
        LAS float* red = (LAS float*)(F.lds + F.wave * 16640) + F.lane * 65;
#pragma unroll
        for (int d = 0; d < 64; ++d) red[d] = acc[d];
        LDS_WAIT(); asm volatile("" ::: "memory");
        const LAS float* rd = (const LAS float*)(F.lds + F.wave * 16640) + F.lane;
        float mine = 0.f;
#pragma unroll 8
        for (int l = 0; l < 64; ++l) mine += rd[l * 65];
        LDS_WAIT(); asm volatile("" ::: "memory");
        OS[(size_t)row * 1024 + h * 64 + F.lane] = (bf16)f2bf(mine);
    }
}


namespace att {
#define ATT_LAS __attribute__((address_space(3)))
typedef short bf16x8 __attribute__((ext_vector_type(8)));
typedef short s16x4 __attribute__((ext_vector_type(4)));
typedef float f32x16 __attribute__((ext_vector_type(16)));
typedef float f32x2_t __attribute__((ext_vector_type(2)));
typedef __bf16 bf16x2_t __attribute__((ext_vector_type(2)));
__device__ __forceinline__ int crow(int r, int hi) { return (r & 3) + 8 * (r >> 2) + 4 * hi; }
__device__ __forceinline__ unsigned cvtpk(float lo, float hi) { f32x2_t v = {lo, hi}; bf16x2_t b = __builtin_convertvector(v, bf16x2_t); return __builtin_bit_cast(unsigned, b); }
__device__ __forceinline__ s16x4 vtr(const ATT_LAS char* p) { return __builtin_bit_cast(s16x4, __builtin_amdgcn_ds_read_tr16_b64_v4i16((ATT_LAS s16x4*)p)); }
__device__ __forceinline__ void glds16(const void* sbase, unsigned voff, unsigned lds_dst) { unsigned keep;
    asm volatile("s_mov_b32 %0, m0\n\ts_mov_b32 m0, %3\n\ts_nop 0\n\tglobal_load_lds_dwordx4 %1, %2\n\ts_mov_b32 m0, %0" : "=&s"(keep) : "v"(voff), "s"(sbase), "s"(lds_dst) : "memory"); }
template <int DK, int TK> struct Geo {
    static constexpr int NCH = DK / 8, KB = NCH * TK * 16, VB = TK * 128, SLOT = KB + VB, NKP = NCH * (TK / 64), NVP = TK / 8, NPW = (NKP + NVP) / 8;
    static_assert((NKP + NVP) % 8 == 0, "pieces must divide over 8 waves");
};
struct Piece { const char* base; unsigned pitch, loff, voff; };
template <int DK, int TK> using PieceArr = Piece[Geo<DK, TK>::NPW];
struct Src { const char* kb0; unsigned kp0; const char* kb1; unsigned kp1; const char* vb; unsigned vp; };
template <int DK, int TK> __device__ __forceinline__ void make_pieces(PieceArr<DK, TK>& pc, const Src& s, int wave, int lane) {
    typedef Geo<DK, TK> G;
#pragma unroll
    for (int i = 0; i < G::NPW; ++i) {
        const int p = wave * G::NPW + i;
        if (p < G::NKP) { const int ch = p % G::NCH, kh = p / G::NCH; const bool a = ch < 8;
            pc[i].base = a ? s.kb0 + 16 * ch : s.kb1 + 16 * (ch - 8); pc[i].pitch = a ? s.kp0 : s.kp1; pc[i].loff = (unsigned)(ch * TK * 16 + kh * 1024);
            pc[i].voff = (unsigned)(kh * 64 + lane) * pc[i].pitch; }
        else { const int v = p - G::NKP, dh = v / (TK / 16), kg = v % (TK / 16);
            pc[i].base = s.vb + dh * 64; pc[i].pitch = s.vp; pc[i].loff = (unsigned)(G::KB + dh * TK * 64 + kg * 1024);
            pc[i].voff = (unsigned)(kg * 16 + (lane >> 2)) * s.vp + (unsigned)(lane & 3) * 16u; }
    }
}
__device__ __forceinline__ float rowmax32(const f32x16& p0, const f32x16& p1) {
    float ta = __builtin_fmaxf(__builtin_fmaxf(p0[0], p0[1]), p1[0]), tb = __builtin_fmaxf(__builtin_fmaxf(p0[2], p0[3]), p1[1]);
    ta = __builtin_fmaxf(__builtin_fmaxf(ta, p1[2]), p1[3]);
#pragma unroll
    for (int r = 4; r < 16; r += 4) { ta = __builtin_fmaxf(__builtin_fmaxf(ta, p0[r]), p0[r + 1]); tb = __builtin_fmaxf(__builtin_fmaxf(tb, p0[r + 2]), p0[r + 3]);
                                       ta = __builtin_fmaxf(__builtin_fmaxf(ta, p1[r]), p1[r + 1]); tb = __builtin_fmaxf(__builtin_fmaxf(tb, p1[r + 2]), p1[r + 3]); }
    const float m = __builtin_fmaxf(ta, tb);
    auto rr = __builtin_amdgcn_permlane32_swap(__builtin_bit_cast(unsigned, m), __builtin_bit_cast(unsigned, m), false, false);
    return __builtin_bit_cast(float, rr[0]);
}
__host__ __device__ constexpr int att_cum(int ngrp, int gi) {
    if (ngrp == 12) { int c = 0; for (int i = 0; i < gi; ++i) c += (i >= 8 || (i & 1)) ? 3 : 2; return c; }
    return gi * 32 / ngrp;
}
template <int DK, int TK, bool MASKED, class TileFn>
__device__ __forceinline__ void attn_unit(ATT_LAS unsigned char* lds, int tid, const bf16* qrow, int ntiles, const TileFn& tf, int qi, bool has_sink, float sink_l2, bf16* orow, const PieceArr<DK, TK>& pc) {
    typedef Geo<DK, TK> G;
    constexpr int SPT = TK / 64, NQ = DK / 16, NS = ATT_CREF ? NQ : NQ + 1, NGRP = 2 * NS;
    constexpr float THR = 8.0f;
    const int lane = tid & 63, r32 = lane & 31, hi = lane >> 5;
    bf16x8 qr[NQ];
#pragma unroll
    for (int d0 = 0; d0 < NQ; ++d0) qr[d0] = *(const bf16x8*)(qrow + d0 * 16 + hi * 8);
#pragma unroll
    for (int d0 = 0; d0 < NQ; ++d0) asm volatile("" : "+v"(qr[d0]));
    f32x16 o[2];
#pragma unroll
    for (int r = 0; r < 16; ++r) { o[0][r] = 0.f; o[1][r] = 0.f; }
    const f32x16 zero16 = {0.f, 0.f, 0.f, 0.f, 0.f, 0.f, 0.f, 0.f, 0.f, 0.f, 0.f, 0.f, 0.f, 0.f, 0.f, 0.f};
    const bf16x8 kone = {(short)(hi ? 0 : 0x3F80), 0, 0, 0, 0, 0, 0, 0};
#define ATT_QEXT(mr_) ((bf16x8){(short)(hi ? 0u : (cvtpk(-(mr_), 0.f) & 0xffffu)), 0, 0, 0, 0, 0, 0, 0})
    float mref = has_sink ? ceilf(sink_l2) : 0.f, l = (has_sink && hi == 0) ? __builtin_amdgcn_exp2f(sink_l2 - mref) : 0.f, alpha = 1.0f;
    bf16x8 qext = ATT_QEXT(mref);
    f32x16 mneg;
#pragma unroll
    for (int r = 0; r < 16; ++r) mneg[r] = ATT_CREF ? -mref : 0.f;
    const unsigned lds0 = (unsigned)(size_t)lds;
#define ATT_ISSUE(T, slotb) do { const int kr_ = tf.krow0(T); _Pragma("unroll") for (int i_ = 0; i_ < G::NPW; ++i_) \
        glds16(pc[i_].base + (size_t)kr_ * pc[i_].pitch, pc[i_].voff, (unsigned)__builtin_amdgcn_readfirstlane(lds0 + (unsigned)(slotb) + pc[i_].loff)); } while (0)
    const ATT_LAS char* kb0 = (const ATT_LAS char*)lds + hi * TK * 16 + r32 * 16;
    const ATT_LAS char* vb0 = (const ATT_LAS char*)lds + G::KB + ((lane >> 4) & 1) * 32 + (lane & 3) * 8 + (4 * hi + ((lane & 15) >> 2)) * 64;
#define ATT_SB() __builtin_amdgcn_sched_barrier(0)
#define ATT_MF(A_, B_, C_) __builtin_amdgcn_mfma_f32_32x32x16_bf16(A_, B_, C_, 0, 0, 0)
#define ATT_KLD(d_, A_, C_) do { A_ = *(const ATT_LAS bf16x8*)(kb_ + (d_) * 2 * TK * 16); C_ = *(const ATT_LAS bf16x8*)(kb_ + (d_) * 2 * TK * 16 + 512); } while (0)
#define ATT_VLD(j_, L_, H_) do { L_ = vtr(vb + ((j_) & 1) * TK * 64 + ((j_) >> 1) * 1024); H_ = vtr(vb + ((j_) & 1) * TK * 64 + ((j_) >> 1) * 1024 + 512); } while (0)
    if (__builtin_amdgcn_readfirstlane(tid) >= 256) __builtin_amdgcn_s_setprio(1);
    ATT_ISSUE(0, 0);
    asm volatile("s_waitcnt vmcnt(0) lgkmcnt(0)\n\ts_barrier" ::: "memory");
    if (ntiles > 1) ATT_ISSUE(1, G::SLOT);
    f32x16 pA0, pA1, pB0, pB1;
    { const ATT_LAS char* kb_ = kb0;
#pragma unroll
      for (int d0 = 0; d0 < NQ; ++d0) { bf16x8 ka, kc; ATT_KLD(d0, ka, kc); if (d0 == 0) { pA0 = ATT_MF(ka, qr[0], mneg); pA1 = ATT_MF(kc, qr[0], mneg); } else { pA0 = ATT_MF(ka, qr[d0], pA0); pA1 = ATT_MF(kc, qr[d0], pA1); } }
      if constexpr (!ATT_CREF) { pA0 = ATT_MF(kone, qext, pA0); pA1 = ATT_MF(kone, qext, pA1); } }
    if (!has_sink) {
        const float dl = ceilf(rowmax32(pA0, pA1));
#pragma unroll
        for (int r = 0; r < 16; ++r) { pA0[r] -= dl; pA1[r] -= dl; }
        mref = dl; qext = ATT_QEXT(mref);
        if constexpr (ATT_CREF) {
#pragma unroll
            for (int r = 0; r < 16; ++r) mneg[r] = -dl; }
    }
    int sl_cur = 0;
    const int ng = ntiles * SPT;
#define ATT_PCE(X0_, X1_, e) ((e) < 16 ? X0_[(e) & 15] : X1_[(e) & 15])
#define ATT_EXP1(X0_, X1_, e) do { if ((e) < 16) X0_[(e) & 15] = __builtin_amdgcn_exp2f(X0_[(e) & 15]); else X1_[(e) & 15] = __builtin_amdgcn_exp2f(X1_[(e) & 15]); } while (0)
#define ATT_EXP2(X0_, X1_, e) do { if ((e) < 16) { X0_[(e) & 15] = __builtin_amdgcn_exp2f(X0_[(e) & 15]); X0_[((e) & 15) + 1] = __builtin_amdgcn_exp2f(X0_[((e) & 15) + 1]); } \
        else { X1_[(e) & 15] = __builtin_amdgcn_exp2f(X1_[(e) & 15]); X1_[((e) & 15) + 1] = __builtin_amdgcn_exp2f(X1_[((e) & 15) + 1]); } } while (0)
#define ATT_VADD(acc_, x_) asm volatile("v_add_f32 %0, %0, %1" : "+v"(acc_) : "v"(x_))
#define ATT_VMUL(x_, y_) asm volatile("v_mul_f32 %0, %0, %1" : "+v"(x_) : "v"(y_))
#define ATT_STEP(C0_, C1_, N0_, N1_, G_) do { \
        const int g_ = (G_), T_ = g_ / SPT, sb_ = g_ % SPT; \
        int sl_next = sl_cur; \
        if (sb_ == SPT - 1 && g_ + 1 < ng) {        \
            sl_next = (sl_cur == 2 * G::SLOT) ? 0 : sl_cur + G::SLOT; \
            asm volatile("s_waitcnt vmcnt(0) lgkmcnt(0)\n\ts_barrier" ::: "memory"); \
            if (T_ + 2 < ntiles) { const int sl2 = (sl_next == 2 * G::SLOT) ? 0 : sl_next + G::SLOT; ATT_ISSUE(T_ + 2, sl2); } \
        } \
        if constexpr (MASKED) { const int kind = tf.kind(T_, sb_); \
            if (kind == 1) { _Pragma("unroll") for (int r = 0; r < 16; ++r) { const int kj = crow(r, hi); if (kj < qi) C0_[r] = -INFINITY; if (kj + 32 < qi) C1_[r] = -INFINITY; } } \
            else if (kind == 2) { _Pragma("unroll") for (int r = 0; r < 16; ++r) { const int kj = crow(r, hi); if (kj > qi) C0_[r] = -INFINITY; if (kj + 32 > qi) C1_[r] = -INFINITY; } } } \
        const float tm_ = rowmax32(C0_, C1_); \
        const float dl_ = tm_ > THR ? ceilf(tm_) : 0.f; \
        const float alpha_old = alpha; alpha = __builtin_amdgcn_exp2f(-dl_); mref += dl_; qext = ATT_QEXT(mref); \
        if (__builtin_amdgcn_ballot_w64(alpha_old != 1.0f) != 0ull) { _Pragma("unroll") for (int r = 0; r < 16; ++r) { ATT_VMUL(o[0][r], alpha_old); ATT_VMUL(o[1][r], alpha_old); } }        \
        if (ATT_CREF && __builtin_amdgcn_ballot_w64(dl_ != 0.f) != 0ull) { _Pragma("unroll") for (int r = 0; r < 16; ++r) mneg[r] -= dl_; }        \
        float ls0 = 0.f, ls1 = 0.f, ls2 = 0.f, ls3 = 0.f; unsigned pw[4][4];        \
        { const ATT_LAS char* kb_ = kb0 + sl_next + ((g_ + 1 < ng) ? (sb_ + 1) % SPT : sb_) * 1024; \
          const ATT_LAS char* vb = vb0 + sl_cur + sb_ * 4096; \
          bf16x8 ka[3], kc[3]; s16x4 vl[4], vh[4]; \
          ATT_KLD(0, ka[0], kc[0]); ATT_KLD(1, ka[1], kc[1]); \
          ATT_SB(); \
          _Pragma("unroll") for (int d0 = 0; d0 < NS; ++d0) {         \
              if (d0 + 2 < NQ) ATT_KLD(d0 + 2, ka[(d0 + 2) % 3], kc[(d0 + 2) % 3]); \
              if (d0 == NS - 2) { ATT_VLD(0, vl[0], vh[0]); ATT_VLD(1, vl[1], vh[1]); } \
              if (d0 == NS - 1) { ATT_VLD(2, vl[2], vh[2]); } \
              if (d0 == 0) N0_ = ATT_MF(ka[0], qr[0], mneg); else if (d0 < NQ) N0_ = ATT_MF(ka[d0 % 3], qr[d0 < NQ ? d0 : 0], N0_); else N0_ = ATT_MF(kone, qext, N0_); \
              ATT_SB(); \
              _Pragma("unroll") for (int e_ = att_cum(NGRP, 2 * d0); e_ < att_cum(NGRP, 2 * d0 + 1); ++e_) { ATT_EXP1(C0_, C1_, e_); } \
              ATT_SB(); \
              if (d0 == 0) N1_ = ATT_MF(kc[0], qr[0], mneg); else if (d0 < NQ) N1_ = ATT_MF(kc[d0 % 3], qr[d0 < NQ ? d0 : 0], N1_); else N1_ = ATT_MF(kone, qext, N1_); \
              ATT_SB(); \
              _Pragma("unroll") for (int e_ = att_cum(NGRP, 2 * d0 + 1); e_ < att_cum(NGRP, 2 * d0 + 2); ++e_) { ATT_EXP1(C0_, C1_, e_); } \
              if (d0 >= NS - 4) { const int k_ = d0 - (NS - 4); pw[0][k_] = cvtpk(C0_[2 * k_], C0_[2 * k_ + 1]); }        \
              ATT_SB(); \
          } \
          _Pragma("unroll") for (int j = 0; j < 8; ++j) {              \
              const bf16x8 vf = {vl[j & 3][0], vl[j & 3][1], vl[j & 3][2], vl[j & 3][3], vh[j & 3][0], vh[j & 3][1], vh[j & 3][2], vh[j & 3][3]}; \
              if (j + 3 < 8) ATT_VLD(j + 3, vl[(j + 3) & 3], vh[(j + 3) & 3]); \
              o[j & 1] = ATT_MF(vf, __builtin_bit_cast(bf16x8, (v4u){pw[j >> 1][0], pw[j >> 1][1], pw[j >> 1][2], pw[j >> 1][3]}), o[j & 1]); \
              ATT_SB(); \
              if (j < 6) { const int q_ = 1 + (j >> 1), h_ = 2 * (j & 1);         \
                  pw[q_][h_] = cvtpk(ATT_PCE(C0_, C1_, 8 * q_ + 2 * h_), ATT_PCE(C0_, C1_, 8 * q_ + 2 * h_ + 1)); pw[q_][h_ + 1] = cvtpk(ATT_PCE(C0_, C1_, 8 * q_ + 2 * h_ + 2), ATT_PCE(C0_, C1_, 8 * q_ + 2 * h_ + 3)); } \
              ATT_VADD(ls0, ATT_PCE(C0_, C1_, 4 * j)); ATT_VADD(ls1, ATT_PCE(C0_, C1_, 4 * j + 1)); ATT_VADD(ls2, ATT_PCE(C0_, C1_, 4 * j + 2)); ATT_VADD(ls3, ATT_PCE(C0_, C1_, 4 * j + 3)); \
              ATT_SB(); \
          } \
        } \
        l = l * alpha_old + ((ls0 + ls1) + (ls2 + ls3)); sl_cur = sl_next; \
    } while (0)
    int g = 0;
#pragma unroll 1
    for (; g + 1 < ng; g += 2) { ATT_STEP(pA0, pA1, pB0, pB1, g); ATT_STEP(pB0, pB1, pA0, pA1, g + 1); }
    if (g < ng) ATT_STEP(pA0, pA1, pB0, pB1, g);
#undef ATT_STEP
#undef ATT_PCE
#undef ATT_EXP2
#undef ATT_EXP1
#undef ATT_VADD
#undef ATT_VMUL
#undef ATT_ISSUE
#undef ATT_SB
#undef ATT_MF
#undef ATT_KLD
#undef ATT_VLD
#undef ATT_QEXT
    l += __shfl_xor(l, 32);
    const float rl = __builtin_amdgcn_rcpf(l);
#pragma unroll
    for (int d0 = 0; d0 < 2; ++d0)
#pragma unroll
        for (int g4 = 0; g4 < 4; g4 += 2) {
            v2u a, b2;
            a.x = cvtpk(o[d0][4 * g4] * rl, o[d0][4 * g4 + 1] * rl); a.y = cvtpk(o[d0][4 * g4 + 2] * rl, o[d0][4 * g4 + 3] * rl);
            b2.x = cvtpk(o[d0][4 * g4 + 4] * rl, o[d0][4 * g4 + 5] * rl); b2.y = cvtpk(o[d0][4 * g4 + 6] * rl, o[d0][4 * g4 + 7] * rl);
            asm volatile("s_nop 1\n\tv_permlane32_swap_b32 %0, %1" : "+v"(a.x), "+v"(b2.x));
            asm volatile("s_nop 1\n\tv_permlane32_swap_b32 %0, %1" : "+v"(a.y), "+v"(b2.y));
            *(v4u*)(orow + 32 * d0 + 8 * g4 + 8 * hi) = (v4u){a.x, a.y, b2.x, b2.y}; }
    __builtin_amdgcn_s_setprio(0);
    asm volatile("s_waitcnt lgkmcnt(0)\n\ts_barrier" ::: "memory");
}
}

struct OddTiles {
    int b, t0;
    __device__ __forceinline__ int krow0(int T) const { const int t = T + t0; return t < 32 ? b * 4096 + t * 128 : NLAT + b * 256 + (t - 32) * 128; }
    __device__ __forceinline__ int kind(int, int) const { return 0; }
};
struct EvenTiles {
    int b, qb, jlo, nlat;
    __device__ __forceinline__ int krow0(int T) const { return T < nlat ? b * 4096 + qb * 64 - 128 + 64 * (jlo + T) : NLAT + b * 256 + 64 * (T - nlat); }
    __device__ __forceinline__ int kind(int T, int) const { if (T >= nlat) return 0; const int j = jlo + T; return j == 0 ? 1 : (j == 4 ? 2 : 0); }
};
constexpr float LOG2E = 1.4426950408889634f;
constexpr float QSC_E = 0.125f * LOG2E, QSC_O = 0.10206207261596577f * LOG2E;

__device__ __forceinline__ void mfma_attn_odd(Frame& F, int layer) {
    const bool need_ctx = layer < DEPTH - 1;
    const bf16* Z = (const bf16*)(F.ws + WS_Z); const bf16* Q = (const bf16*)(F.ws + WS_Q); const bf16* KV = (const bf16*)(F.ws + WS_KV);
    bf16* OS = (bf16*)(F.ws + WS_H);
    const int nunits = 1024 + (need_ctx ? 64 : 0);
    const int r32 = F.lane & 31;
    for (int u = F.vcu; u < nunits; u += F.G) {
        int b, h, row0, t0, nt;
        if (u < 1024) { b = u >> 7; h = (u >> 4) & 7; row0 = b * 4096 + (u & 15) * 256; t0 = 0; nt = 34; }
        else { const int c = u - 1024; b = c >> 3; h = c & 7; row0 = NLAT + b * 256; t0 = 32; nt = 2; }
        att::Src s{(const char*)(KV + h * 128), 2048u, (const char*)(Z + 640), (unsigned)(ZO * 2), (const char*)(KV + h * 128 + 64), 2048u};
        att::Piece pc[att::Geo<96, 128>::NPW]; att::make_pieces<96, 128>(pc, s, F.wave, F.lane);
        const int row = row0 + F.wave * 32 + r32;
        att::attn_unit<96, 128, false>(F.lds, F.tid, Q + (size_t)row * 768 + h * 96, nt, OddTiles{b, t0}, 0, false, 0.f, OS + (size_t)row * 1024 + h * 64, pc);
    }
}
__device__ __forceinline__ void mfma_attn_even(Frame& F, int layer) {
    const bool need_ctx = layer < DEPTH - 1;
    const bf16* Z = (const bf16*)(F.ws + WS_Z);
    bf16* OS = (bf16*)(F.ws + WS_H);
    const int nunits = 1024 + (need_ctx ? 64 : 0);
    const int r32 = F.lane & 31;
    for (int u = F.vcu; u < nunits; u += F.G) {
        int b, kvh, row0; EvenTiles tf;
        if (u < 1024) { b = u >> 7; kvh = (u >> 6) & 1; const int qb = u & 63; row0 = b * 4096 + qb * 64; const int jlo = qb < 2 ? 2 - qb : 0, jhi = qb > 61 ? 65 - qb : 4; tf = EvenTiles{b, qb, jlo, jhi - jlo + 1}; }
        else { const int c = u - 1024; b = c >> 3; kvh = (c >> 2) & 1; row0 = NLAT + b * 256 + (c & 3) * 64; tf = EvenTiles{b, 0, 0, 0}; }
        att::Src s{(const char*)(Z + kvh * 64), (unsigned)(ZE * 2), nullptr, 0u, (const char*)(Z + 128 + kvh * 64), (unsigned)(ZE * 2)};
        att::Piece pc[att::Geo<64, 64>::NPW]; att::make_pieces<64, 64>(pc, s, F.wave, F.lane);
        const int head = kvh * 4 + (F.wave >> 1), qi = (F.wave & 1) * 32 + r32, row = row0 + qi;
        const float sink = inp(F, IN_EVSINK)[(layer >> 1) * 8 + head] * LOG2E;
        att::attn_unit<64, 64, true>(F.lds, F.tid, Z + (size_t)row * ZE + 256 + head * 64, tf.nlat + 4, tf, qi, true, sink, OS + (size_t)row * 1024 + head * 64, pc);
    }
}


__device__ __forceinline__ void mfma_sgu(Frame& F, int layer) {
    const int i2 = layer >> 1;
    const bool need_ctx = layer < DEPTH - 1;
    const int nunits = need_ctx ? 272 : 256;
    const bf16* Z = (const bf16*)(F.ws + WS_Z); bf16* OS = (bf16*)(F.ws + WS_H);
    LAS unsigned char* vn = F.lds;
    LAS float* st = (LAS float*)(F.lds + 131072);
    LAS float* ngl = st + 256;
    const bf16* WsB = (const bf16*)(F.ws + WS_WSB) + (size_t)i2 * 4 * 128 * 128;
    const float* bs = inp(F, IN_EVSGUB) + i2 * 4 * 128;
    { const float* ng = inp(F, IN_EVSGUG) + i2 * 512; for (int i = F.tid; i < 512; i += NT) ngl[i] = ng[i]; }
    const int r32 = F.lane & 31, hi = F.lane >> 5;
    const bool remap = F.G == 256;
    for (int it = 0; ; ++it) {
        int u;
        if (remap) { if (it == 0) u = F.vcu; else if (it == 1 && need_ctx && F.vcu >= 64 && F.vcu < 80) u = 256 + F.vcu - 64; else break; }
        else { u = F.vcu + it * F.G; if (u >= nunits) break; }
        const int row0 = u < 256 ? u * 128 : NLAT + (u - 256) * 128;
        __syncthreads();
        {
            v4u w[16];
#pragma unroll
            for (int i = 0; i < 16; ++i) w[i] = *(const v4u*)(Z + (size_t)(row0 + F.wave * 16 + i) * ZE + 1280 + 8 * F.lane);
#pragma unroll
            for (int i = 0; i < 16; ++i) {
                const float x[8] = {bflo(w[i].x), bfhi(w[i].x), bflo(w[i].y), bfhi(w[i].y), bflo(w[i].z), bfhi(w[i].z), bflo(w[i].w), bfhi(w[i].w)};
                float s = 0.f;
#pragma unroll
                for (int j = 0; j < 8; ++j) s += x[j];
                const float mean = wave_sum(s) * (1.0f / 512.0f); float q = 0.f;
#pragma unroll
                for (int j = 0; j < 8; ++j) q += (x[j] - mean) * (x[j] - mean);
                const float var = wave_sum(q) * (1.0f / 512.0f);
                if (F.lane == 0) { st[2 * (F.wave * 16 + i)] = mean; st[2 * (F.wave * 16 + i) + 1] = 1.0f / sqrtf(var + EPS); }
            }
        }
        __syncthreads();
#pragma unroll
        for (int k = 0; k < 4; ++k) {
            const int it = F.tid + NT * k, q = it & 127, blk = it >> 7;
            const float mean = st[2 * q], rstd = st[2 * q + 1];
            const bf16* zp = Z + (size_t)(row0 + q) * ZE + 1280 + blk * 32;
            LAS unsigned char* dst = vn + blk * 8192 + (q >> 4) * 1024 + (q & 15) * 64;
#pragma unroll
            for (int c = 0; c < 4; ++c) { const v4u w = *(const v4u*)(zp + 8 * c);
                const f32x4 g0 = *(const LAS f32x4*)(ngl + blk * 32 + 8 * c), g1 = *(const LAS f32x4*)(ngl + blk * 32 + 8 * c + 4);
                v4u o; o.x = pk2((bflo(w.x) - mean) * rstd * g0.x, (bfhi(w.x) - mean) * rstd * g0.y); o.y = pk2((bflo(w.y) - mean) * rstd * g0.z, (bfhi(w.y) - mean) * rstd * g0.w);
                o.z = pk2((bflo(w.z) - mean) * rstd * g1.x, (bfhi(w.z) - mean) * rstd * g1.y); o.w = pk2((bflo(w.w) - mean) * rstd * g1.z, (bfhi(w.w) - mean) * rstd * g1.w);
                *(LAS v4u*)(dst + 16 * c) = o; }
        }
        __syncthreads();
        const int pt = F.wave & 3, p = pt * 32 + r32;
        const LAS char* ab = (const LAS char*)vn + (8 * hi + ((F.lane & 15) >> 2)) * 64 + ((F.lane >> 4) & 1) * 32 + (F.lane & 3) * 8;
#pragma unroll 1
        for (int gg = 0; gg < 2; ++gg) {
            const int g = (F.wave >> 2) * 2 + gg;
            att::bf16x8 bw[8];
#pragma unroll
            for (int ks = 0; ks < 8; ++ks) bw[ks] = *(const att::bf16x8*)(WsB + ((size_t)g * 128 + p) * 128 + 16 * ks + 8 * hi);
            const float bias = bs[g * 128 + p];
#pragma unroll 1
            for (int dd = 0; dd < 4; ++dd) {
                const int dt = g * 4 + dd;
                att::f32x16 acc;
#pragma unroll
                for (int r = 0; r < 16; ++r) acc[r] = 0.f;
#pragma unroll
                for (int ks = 0; ks < 8; ++ks) {
                    const att::s16x4 lo = att::vtr(ab + dt * 8192 + ks * 1024), hh = att::vtr(ab + dt * 8192 + ks * 1024 + 256);
                    const att::bf16x8 af = {lo[0], lo[1], lo[2], lo[3], hh[0], hh[1], hh[2], hh[3]};
                    acc = __builtin_amdgcn_mfma_f32_32x32x16_bf16(af, bw[ks], acc, 0, 0, 0);
                }
                const bf16* up = Z + (size_t)(row0 + p) * ZE + 768 + dt * 32 + 4 * hi;
                bf16* op = OS + (size_t)(row0 + p) * 1024 + 512 + dt * 32 + 4 * hi;
#pragma unroll
                for (int g4 = 0; g4 < 4; ++g4) { const v2u uw = *(const v2u*)(up + 8 * g4);
                    v2u o; o.x = pk2(bflo(uw.x) * (acc[4 * g4] + bias), bfhi(uw.x) * (acc[4 * g4 + 1] + bias)); o.y = pk2(bflo(uw.y) * (acc[4 * g4 + 2] + bias), bfhi(uw.y) * (acc[4 * g4 + 3] + bias));
                    *(v2u*)(op + 8 * g4) = o; }
            }
        }
    }
    __syncthreads();
}

__device__ __forceinline__ void simple_sgu(Frame& F, int layer) {
    const int i2 = layer >> 1;
    const bool need_ctx = layer < DEPTH - 1;
    const int nunits = need_ctx ? 272 : 256;
    const bf16* Z = (const bf16*)(F.ws + WS_Z); bf16* OS = (bf16*)(F.ws + WS_H);
    LAS float* vn = (LAS float*)F.lds;
    LAS float* st = vn + 128 * 128;
    const float* ng = inp(F, IN_EVSGUG) + i2 * 512;
    const float* Ws = inp(F, IN_EVSGUW) + (size_t)i2 * 4 * 128 * 128;
    const float* bs = inp(F, IN_EVSGUB) + i2 * 4 * 128;
    for (int u = F.vcu; u < nunits; u += F.G) {
        const int row0 = u < 256 ? u * 128 : NLAT + (u - 256) * 128;
        for (int r = F.wave; r < 128; r += NWAVES) {
            const v4u w = *(const v4u*)(Z + (size_t)(row0 + r) * ZE + 1280 + 8 * F.lane);
            const float x[8] = {bflo(w.x), bfhi(w.x), bflo(w.y), bfhi(w.y), bflo(w.z), bfhi(w.z), bflo(w.w), bfhi(w.w)};
            float s = 0.f;
#pragma unroll
            for (int j = 0; j < 8; ++j) s += x[j];
            const float mean = wave_sum(s) * (1.0f / 512.0f); float q = 0.f;
#pragma unroll
            for (int j = 0; j < 8; ++j) q += (x[j] - mean) * (x[j] - mean);
            const float var = wave_sum(q) * (1.0f / 512.0f);
            if (F.lane == 0) { st[2 * r] = mean; st[2 * r + 1] = 1.0f / sqrtf(var + EPS); }
        }
        __syncthreads();
        for (int g = 0; g < 4; ++g) {
            for (int i = F.tid; i < 128 * 128; i += NT) { const int q = i >> 7, d = i & 127; const float x = bf2f(Z[(size_t)(row0 + q) * ZE + 1280 + g * 128 + d]); vn[i] = (x - st[2 * q]) * st[2 * q + 1] * ng[g * 128 + d]; }
            __syncthreads();
            const int p = F.tid >> 2, d0 = (F.tid & 3) * 32;
            float acc[32];
#pragma unroll
            for (int j = 0; j < 32; ++j) acc[j] = 0.f;
            const float* wrow = Ws + ((size_t)g * 128 + p) * 128;
            for (int q = 0; q < 128; ++q) { const float w = wrow[q];
#pragma unroll
                for (int j = 0; j < 32; j += 4) { const f32x4 v = *(const LAS f32x4*)(vn + q * 128 + d0 + j); acc[j] += w * v.x; acc[j + 1] += w * v.y; acc[j + 2] += w * v.z; acc[j + 3] += w * v.w; } }
            const float bias = bs[g * 128 + p];
            const bf16* up = Z + (size_t)(row0 + p) * ZE + 768 + g * 128 + d0;
            bf16* op = OS + (size_t)(row0 + p) * 1024 + 512 + g * 128 + d0;
#pragma unroll
            for (int j = 0; j < 32; j += 8) { const v4u uw = *(const v4u*)(up + j);
                float o[8] = {bflo(uw.x) * (acc[j] + bias), bfhi(uw.x) * (acc[j + 1] + bias), bflo(uw.y) * (acc[j + 2] + bias), bfhi(uw.y) * (acc[j + 3] + bias),
                              bflo(uw.z) * (acc[j + 4] + bias), bfhi(uw.z) * (acc[j + 5] + bias), bflo(uw.w) * (acc[j + 6] + bias), bfhi(uw.w) * (acc[j + 7] + bias)};
                store_bf16<8>(op + j, o); }
            __syncthreads();
        }
    }
}
__device__ __forceinline__ void simple_conv(Frame& F, int layer) {
    const int i2 = layer >> 1;
    const bool need_ctx = layer < DEPTH - 1;
    const int nrows = need_ctx ? MT : NLAT;
    const bf16* Z = (const bf16*)(F.ws + WS_Z); bf16* OS = (bf16*)(F.ws + WS_H);
    const float* cw = inp(F, IN_ODCONV) + i2 * 3 * 512;
    for (size_t i = (size_t)F.vcu * NT + F.tid; i < (size_t)nrows * 64; i += (size_t)F.G * NT) {
        const int row = (int)(i >> 6), c0 = (int)(i & 63) * 8;
        const int seqpos = row < NLAT ? (row & 4095) : ((row - NLAT) & 255), seqlen = row < NLAT ? 4096 : 256;
        float cv[8];
#pragma unroll
        for (int j = 0; j < 8; ++j) cv[j] = 0.f;
#pragma unroll
        for (int t = 0; t < 3; ++t) { const int sp = seqpos + t - 1; if (sp < 0 || sp >= seqlen) continue;
            const bf16* zr = Z + (size_t)(row + t - 1) * ZO;
            const v4u cw_ = *(const v4u*)(zr + 672 + 512 + c0), hw = *(const v4u*)(zr + 672 + 1024 + c0);
            const float u[8] = {bflo(cw_.x) * bflo(hw.x), bfhi(cw_.x) * bfhi(hw.x), bflo(cw_.y) * bflo(hw.y), bfhi(cw_.y) * bfhi(hw.y), bflo(cw_.z) * bflo(hw.z), bfhi(cw_.z) * bfhi(hw.z), bflo(cw_.w) * bflo(hw.w), bfhi(cw_.w) * bfhi(hw.w)};
#pragma unroll
            for (int j = 0; j < 8; ++j) cv[j] += u[j] * cw[t * 512 + c0 + j]; }
        const v4u bw = *(const v4u*)(Z + (size_t)row * ZO + 672 + c0);
        float o[8] = {bflo(bw.x) * cv[0], bfhi(bw.x) * cv[1], bflo(bw.y) * cv[2], bfhi(bw.y) * cv[3], bflo(bw.z) * cv[4], bfhi(bw.z) * cv[5], bflo(bw.w) * cv[6], bfhi(bw.w) * cv[7]};
        store_bf16<8>(OS + (size_t)row * 1024 + 512 + c0, o);
    }
}

struct Args { const float* in[26]; float* out; unsigned char* ws; int ph_lo, ph_hi; };
constexpr int NPHASE = 2 + DEPTH * 9;

__global__ void __launch_bounds__(NT, 2) mk_fwd(Args args) {
    extern __shared__ __attribute__((aligned(16))) unsigned char lds[];
    Frame F;
    F.lds = (LAS unsigned char*)lds;
    F.tid = threadIdx.x; F.lane = F.tid & 63; F.wave = __builtin_amdgcn_readfirstlane(F.tid >> 6);
    F.G = gridDim.x; { const int bx = blockIdx.x; F.vcu = (F.G % 8 == 0) ? (bx % 8) * (F.G / 8) + bx / 8 : bx; }
    F.out = args.out; F.ws = args.ws;
    for (int u = F.tid; u < (LDS_BYTES - LDSCTL_OFF) / 4; u += NT) ((LAS unsigned*)(F.lds + LDSCTL_OFF))[u] = 0u;
    __syncthreads();
    if (F.tid < 26) ((LAS unsigned long long*)(F.lds + LDSCTL_OFF))[F.tid] = (unsigned long long)args.in[F.tid];
    __syncthreads();
    volatile LAS unsigned* MISC = (volatile LAS unsigned*)(F.lds + MISC_OFF);
    XcdBarrier bar; bar.bar = (unsigned*)(F.ws + WS_CTL) + CW_BAR; bar.x = 0; bar.st = nullptr;
    if (!MK_PER_PHASE) bar = xcd_barrier_post((unsigned*)(F.ws + WS_CTL) + CW_BAR, MISC + 8);
    const int lo = args.ph_lo, hi = args.ph_hi;
#ifndef PH_MASK
#define PH_MASK 0x3ff
#endif
#define EN(b) ((PH_MASK >> (b)) & 1)
#define LAUNDER() do { int w_ = F.wave, c_ = F.vcu; asm volatile("" : "+v"(F.tid), "+v"(F.lane), "+v"(w_), "+v"(c_)); F.wave = __builtin_amdgcn_readfirstlane(w_); F.vcu = __builtin_amdgcn_readfirstlane(c_); } while (0)
#define REP(k) for (int rep_ = 0; rep_ < (((REPEAT_MASK >> (k)) & 1) ? 2 : 1); ++rep_, __syncthreads())
#define IN(k) (lo <= (k) && (k) < hi)
#define SEAM(k) do { if (IN(k) && IN((k) + 1)) { if (!MK_PER_PHASE) { xcd_barrier(bar); if ((REPEAT_MASK >> 14) & 1) xcd_barrier(bar); } } } while (0)

    if (EN(0) && IN(0)) { REP(0) { LAUNDER(); p0_prologue(F); } SEAM(0); }
#pragma unroll 1
    for (int layer = 0; layer < DEPTH; ++layer) {
        const int pb = 1 + 9 * layer, i2 = layer >> 1; const bool odd = layer & 1;
        const bool need_ctx = layer < DEPTH - 1;
        const int MR = need_ctx ? MT : NLAT;
        unsigned char* wsm = F.ws + WS_WSMALL;
        if (((REPEAT_MASK >> 15) & 1) && layer > 0 && EN(1) && IN(pb + 0)) { LAUNDER(); n1_phase(F, layer, true); __syncthreads(); }
        if (EN(1) && IN(pb + 0)) { for (int rep_ = 0; rep_ < ((((REPEAT_MASK >> 1) & 1) && layer == 0) ? 9 : 1); ++rep_, __syncthreads()) { LAUNDER(); n1_phase(F, layer); } SEAM(pb + 0); }
        if (EN(2) && IN(pb + 1)) {
            REP(2) {
            LAUNDER();
            if (!odd) { EpiInEven E{(bf16*)(F.ws + WS_Z), (const float*)(F.ws + WS_TAB), (const float*)(F.ws + WS_TAB) + 4096 * 32};
                if constexpr (MFMA_MASK & 1) { pg8::Gemm g{(const bf16*)(F.ws + WS_H), (const bf16*)(wsm + OFF_WINE + i2 * SZ_WINE), D, D, D, nullptr}; pg8::StaticOrder S; S.init(MT, ZE, F.G, (int)blockIdx.x, 0);
                    if (((REPEAT_MASK >> 17) & 1) && rep_ == 0) { EpiNull EN_; pg8::gemm_phase<false, 0, false, false>(F.lds, g, S, EN_, F.tid); }
                    else pg8::gemm_phase<false, 0, false, false>(F.lds, g, S, E, F.tid); }
                else simple_gemm<false, 0>(F, MT, ZE, D, ARowsPlain{(const bf16*)(F.ws + WS_H), D}, (const bf16*)(wsm + OFF_WINE + i2 * SZ_WINE), D, 0, E); }
            else { EpiInOdd E{(bf16*)(F.ws + WS_Z), (const float*)(F.ws + WS_TAB) + 2 * 4096 * 32, (const float*)(F.ws + WS_TAB) + 2 * 4096 * 32 + 4096 * 16, (unsigned long long*)(F.ws + WS_RS + (rep_ ? MiB : 0))};
                if constexpr (MFMA_MASK & 2) { pg8::Gemm g{(const bf16*)(F.ws + WS_H), (const bf16*)(wsm + OFF_WINO + i2 * SZ_WINO), D, D, D, nullptr}; pg8::StaticOrder S; S.init(MT, ZO, F.G, (int)blockIdx.x, 0);
                    pg8::gemm_phase<false, 1, false, false>(F.lds, g, S, E, F.tid); }
                else simple_gemm<false, 1>(F, MT, ZO, D, ARowsPlain{(const bf16*)(F.ws + WS_H), D}, (const bf16*)(wsm + OFF_WINO + i2 * SZ_WINO), D, 0, E); }
            }
            SEAM(pb + 1);
        }
        if (EN(3) && IN(pb + 2) && odd) {
            REP(3) {
            LAUNDER();
            EpiUpQ Eq{(bf16*)(F.ws + WS_Q), (const float*)(F.ws + WS_TAB) + 2 * 4096 * 32, (const float*)(F.ws + WS_TAB) + 2 * 4096 * 32 + 4096 * 16, (const unsigned long long*)(F.ws + WS_RS)};
            EpiUpKV Ek{(bf16*)(F.ws + WS_KV), (const unsigned long long*)(F.ws + WS_RS)};
            if constexpr (MFMA_MASK & 4) {
                { pg8::Gemm g{(const bf16*)(F.ws + WS_Z) + 256, (const bf16*)(wsm + OFF_WUQ + i2 * SZ_WUQ), ZO, 384, 384, nullptr}; pg8::StaticOrder S; S.init(MR, 768, F.G, (int)blockIdx.x, 0);
                  pg8::gemm_phase<false, 0, false, false>(F.lds, g, S, Eq, F.tid); }
                LAUNDER();
                { pg8::Gemm g{(const bf16*)(F.ws + WS_Z), (const bf16*)(wsm + OFF_WUKV + i2 * SZ_WUKV), ZO, 256, 256, nullptr}; pg8::StaticOrder S; S.init(MT, 1024, F.G, (int)blockIdx.x, 0);
                  pg8::gemm_phase<false, 0, false, false>(F.lds, g, S, Ek, F.tid); }
            } else {
                simple_gemm<false, 0>(F, MR, 768, 384, ARowsPlain{(const bf16*)(F.ws + WS_Z) + 256, ZO}, (const bf16*)(wsm + OFF_WUQ + i2 * SZ_WUQ), 384, 0, Eq);
                simple_gemm<false, 0>(F, MT, 1024, 256, ARowsPlain{(const bf16*)(F.ws + WS_Z), ZO}, (const bf16*)(wsm + OFF_WUKV + i2 * SZ_WUKV), 256, 0, Ek);
            }
            }
            SEAM(pb + 2);
        }
        if (EN(4) && IN(pb + 3)) {
            REP(4) {
            LAUNDER();
            if (!odd) { REP(10) { if constexpr (MFMA_ATT & 1) mfma_attn_even(F, layer); else simple_attn<false>(F, layer); } __syncthreads(); REP(11) { LAUNDER(); if constexpr (MFMA_SGU) mfma_sgu(F, layer); else simple_sgu(F, layer); } }
            else { REP(12) { if constexpr (MFMA_ATT & 2) mfma_attn_odd(F, layer); else simple_attn<true>(F, layer); } REP(13) { LAUNDER(); simple_conv(F, layer); } }
            }
            SEAM(pb + 3);
        }
        if (EN(5) && IN(pb + 4)) {
            LAUNDER();
            EpiOut E{(bf16*)(F.ws + WS_X), (const float*)(F.ws + WS_MODV) + (size_t)layer * 9 * 6144};
            if constexpr (MFMA_MASK & 8) { pg8::Gemm g{(const bf16*)(F.ws + WS_H), (const bf16*)(wsm + (odd ? OFF_WOUTO : OFF_WOUTE) + i2 * SZ_WOUT), D, D, D, nullptr}; pg8::StaticOrder S; S.init(MR, D, F.G, (int)blockIdx.x, 0);
                if constexpr ((REPEAT_MASK >> 5) & 1) { EpiOut E2{(bf16*)(F.ws + WS_X + 68 * MiB), E.mod}; pg8::gemm_phase<false, 0, false, false>(F.lds, g, S, E2, F.tid); __syncthreads(); LAUNDER(); }
                pg8::gemm_phase<false, 0, false, false>(F.lds, g, S, E, F.tid); CONV_TAIL(S, layer, 0, 36); if constexpr ((REPEAT_MASK >> 16) & 1) { __syncthreads(); CONV_TAIL(S, layer, 0, 36); }
}
            else simple_gemm<false, 0>(F, MR, D, D, ARowsPlain{(const bf16*)(F.ws + WS_H), D}, (const bf16*)(wsm + (odd ? OFF_WOUTO : OFF_WOUTE) + i2 * SZ_WOUT), D, 0, E);
            SEAM(pb + 4);
        }
        if (EN(6) && IN(pb + 5)) { REP(6) { LAUNDER(); if constexpr (FP8_F1 && N2_MFMA) n2_phase_mfma(F, layer); else n2_phase(F, layer); } SEAM(pb + 5); }
        if (EN(7) && IN(pb + 6)) { REP(7) { LAUNDER(); topk_phase(F, layer); } SEAM(pb + 6); }
        if (EN(8) && IN(pb + 7)) {
            REP(8) {
            LAUNDER();
            EpiF1 E{(bf16*)(F.ws + WS_Z)};
            constexpr int KU = FP8_F1 ? D / 2 : D;
            if constexpr (MFMA_MASK & 16) { pg8::Gemm g{(const bf16*)(F.ws + WS_H), (const bf16*)(F.ws + WS_W13 + (size_t)layer * 16 * (FP8_F1 ? SZ_W13 / 2 : SZ_W13)), KU, KU, KU, (const int*)(F.ws + WS_SRC)}; pg8::StaticOrder S; S.init(need_ctx ? GROWS : NE * BATCH * CAP_L, 2048, F.G, (int)blockIdx.x, 2048, need_ctx ? 0 : 1);
                pg8::gemm_phase<true, 0, true, FP8_F1 != 0>(F.lds, g, S, E, F.tid); CONV_TAIL(S, layer, 36, 45); }
            else simple_gemm<true, 0>(F, GROWS, 2048, D, ARowsGather{(const bf16*)(F.ws + WS_H), D, (const int*)(F.ws + WS_SRC)}, (const bf16*)(F.ws + WS_W13 + (size_t)layer * 16 * SZ_W13), D, 2048, E);
            }
            SEAM(pb + 7);
        }
        if (EN(9) && IN(pb + 8)) {
            REP(9) {
            LAUNDER();
            EpiF2 E{(bf16*)(F.ws + WS_Y)};
            constexpr int KU = FP8_F2 ? FF / 2 : FF;
            if constexpr (MFMA_MASK & 32) { pg8::Gemm g{(const bf16*)(F.ws + WS_Z), (const bf16*)(F.ws + WS_W2 + (size_t)layer * 16 * (FP8_F2 ? SZ_W2 / 2 : SZ_W2)), KU, KU, KU, nullptr}; pg8::StaticOrder S; S.init(need_ctx ? GROWS : NE * BATCH * CAP_L, D, F.G, (int)blockIdx.x, 1024, need_ctx ? 0 : 1);
                if (((REPEAT_MASK >> 17) & 1) && rep_ == 0) { EpiNull EN_; pg8::gemm_phase<false, 0, false, FP8_F2 != 0>(F.lds, g, S, EN_, F.tid); }
                else { pg8::gemm_phase<false, 0, false, FP8_F2 != 0>(F.lds, g, S, E, F.tid); CONV_TAIL(S, layer, 45, 64); } }
            else simple_gemm<false, 0>(F, GROWS, D, FF, ARowsPlain{(const bf16*)(F.ws + WS_Z), FF}, (const bf16*)(F.ws + WS_W2 + (size_t)layer * 16 * SZ_W2), FF, 1024, E);
            }
            SEAM(pb + 8);
        }
    }
    if (EN(1) && IN(NPHASE - 1)) { LAUNDER(); n1_phase(F, 4); }
#undef IN
#undef SEAM
}

extern "C" void kernel_launch(void* const* d_in, const int* in_sizes, int n_in, void* d_out, int out_size, void* d_ws, size_t ws_size, hipStream_t stream) {
    static int grid = 0;
    if (grid == 0) {
        if (n_in != 26 || out_size != NLAT * D || ws_size < WS_END) { fprintf(stderr, "kernel_launch: unexpected problem (n_in %d out %d ws %zu)\n", n_in, out_size, ws_size); grid = -1; return; }
        int dev = 0, cus = 0, per_cu = 0;
        if (hipGetDevice(&dev) != hipSuccess || hipDeviceGetAttribute(&cus, hipDeviceAttributeMultiprocessorCount, dev) != hipSuccess) { grid = -1; return; }
        if (hipFuncSetAttribute((const void*)mk_fwd, hipFuncAttributeMaxDynamicSharedMemorySize, LDS_BYTES) != hipSuccess) { grid = -1; return; }
        if (hipOccupancyMaxActiveBlocksPerMultiprocessor(&per_cu, (const void*)mk_fwd, NT, LDS_BYTES) != hipSuccess || per_cu < 1) fprintf(stderr, "kernel_launch: occupancy query says %d\n", per_cu);
        (void)hipGetLastError();
        grid = cus;
    }
    if (grid < 0) return;
    if (hipMemsetAsync((char*)d_ws + WS_CTL, 0, CTL_ZERO_BYTES, stream) != hipSuccess) return;
    Args a{};
    for (int i = 0; i < 26; ++i) a.in[i] = (const float*)d_in[i];
    a.out = (float*)d_out; a.ws = (unsigned char*)d_ws;
#if MK_PER_PHASE
    for (int p = 0; p < NPHASE; ++p) {
        if (p >= 1 && p < NPHASE - 1 && ((p - 1) % 9) == 2 && (((p - 1) / 9) & 1) == 0) continue;
        a.ph_lo = p; a.ph_hi = p + 1;
        hipLaunchKernelGGL(mk_fwd, dim3(grid), dim3(NT), LDS_BYTES, stream, a);
    }
#else
    a.ph_lo = 0; a.ph_hi = NPHASE;
    hipLaunchKernelGGL(mk_fwd, dim3(grid), dim3(NT), LDS_BYTES, stream, a);
#endif
}
```

```cpp
#include <hip/hip_runtime.h>
#include <cstdio>
#include <cstdint>

#ifndef MFMA_MASK
#define MFMA_MASK 0x3f
#endif
#ifndef MFMA_ATT
#define MFMA_ATT 3
#endif
#ifndef REPEAT_MASK
#define REPEAT_MASK 0
#endif
#ifndef MFMA_SGU
#define MFMA_SGU 1
#endif
#ifndef ATT_CREF
#define ATT_CREF 1
#endif
#ifndef N2_MFMA
#define N2_MFMA 1
#endif
#ifndef FP8_FFN
#define FP8_FFN 1
#endif
#ifndef FP8_F1
#define FP8_F1 FP8_FFN
#endif
#ifndef FP8_F2
#define FP8_F2 FP8_FFN
#endif
#ifndef FP8_Y
#define FP8_Y 1
#endif
#ifndef MK_PER_PHASE
#define MK_PER_PHASE 0
#endif

constexpr int D = 1024, BATCH = 8, SEQ = 4096, DEPTH = 4, CTXL = 256;
constexpr int NLAT = BATCH * SEQ, NCTX = BATCH * CTXL, MT = NLAT + NCTX;
constexpr int NE = 16, FF = 1024, CAP_L = 512, CAP_C = 32, EROWS = BATCH * (CAP_L + CAP_C);
constexpr int GROWS = NE * EROWS;
constexpr int ZE = 1792, ZO = 2304;
constexpr float EPS = 1e-6f;
constexpr float RS_SCALE = 16777216.0f, RS_INV = 1.0f / 16777216.0f;
constexpr float F8_SA = 16.f, F8_SW = 64.f, F8_SG = 8.f, F8_SY = 16.f;
constexpr float LOG2E_ = 1.4426950408889634f;
constexpr float QSCALE_E = 0.125f * LOG2E_, QSCALE_O = 0.10206207261596577f * LOG2E_;
constexpr int NWAVES = 8, NT = 512;

constexpr size_t MiB = 1u << 20;
constexpr size_t WS_CTL = 0, CTL_ZERO_BYTES = 1 * MiB;
constexpr size_t WS_MODV = 1 * MiB;
constexpr size_t WS_TAB = 2 * MiB;
constexpr size_t WS_WSB = 2 * MiB + 1536 * 1024;
constexpr size_t WS_AFF = 4 * MiB;
constexpr size_t WS_AFFT = 7 * MiB;
constexpr size_t WS_INV = 10 * MiB;
constexpr size_t WS_SRC = 13 * MiB;
constexpr size_t WS_RS = 14 * MiB;
constexpr size_t WS_WSMALL = 16 * MiB;
constexpr size_t OFF_WINE = 0, SZ_WINE = (size_t)ZE * D * 2;
constexpr size_t OFF_WOUTE = OFF_WINE + 2 * SZ_WINE, SZ_WOUT = (size_t)D * D * 2;
constexpr size_t OFF_WINO = OFF_WOUTE + 2 * SZ_WOUT, SZ_WINO = (size_t)ZO * D * 2;
constexpr size_t OFF_WUQ = OFF_WINO + 2 * SZ_WINO, SZ_WUQ = (size_t)768 * 384 * 2;
constexpr size_t OFF_WUKV = OFF_WUQ + 2 * SZ_WUQ, SZ_WUKV = (size_t)1024 * 256 * 2;
constexpr size_t OFF_WOUTO = OFF_WUKV + 2 * SZ_WUKV;
static_assert(OFF_WOUTO + 2 * SZ_WOUT <= 28 * MiB, "small weights");
constexpr size_t WS_W13 = 44 * MiB, SZ_W13 = (size_t)2048 * 1024 * 2;
constexpr size_t WS_W2 = 300 * MiB, SZ_W2 = (size_t)1024 * 1024 * 2;
constexpr size_t WS_X = 428 * MiB;
constexpr size_t WS_H = 564 * MiB;
constexpr size_t WS_Z = 632 * MiB;
constexpr size_t WS_Y = 785 * MiB;
constexpr size_t WS_Q = WS_Y, WS_KV = WS_Y + 52 * MiB;
constexpr size_t WS_END = 921 * MiB;
static_assert(WS_W13 + 64 * SZ_W13 <= WS_W2 && WS_W2 + 64 * SZ_W2 <= WS_X && WS_X + (size_t)MT * D * 4 <= WS_H && WS_H + (size_t)MT * D * 2 <= WS_Z, "ws map 1");
static_assert(WS_Z + (size_t)MT * ZO * 2 <= WS_Y && WS_Z + (size_t)GROWS * 1024 * 2 <= WS_Y && WS_Y + (size_t)GROWS * 1024 * 2 <= WS_END, "ws map 2");
static_assert(WS_Q + (size_t)MT * 768 * 2 <= WS_KV && WS_KV + (size_t)MT * 1024 * 2 <= WS_END, "ws map 3");
constexpr int CW_BAR = 4096;

constexpr int RING_BYTES = 131072;
constexpr int LDS_BYTES = 163840;
constexpr int LDSCTL_OFF = LDS_BYTES - 1024, MISC_OFF = LDSCTL_OFF + 320;

#define GAS __attribute__((address_space(1)))
#define LAS __attribute__((address_space(3)))
typedef unsigned short bf16;
typedef unsigned v4u __attribute__((ext_vector_type(4)));
typedef unsigned v2u __attribute__((ext_vector_type(2)));
typedef float f32x4 __attribute__((ext_vector_type(4)));
#define LDS_WAIT() asm volatile("s_waitcnt lgkmcnt(0)" ::: "memory")
#define VM_WAIT() asm volatile("s_waitcnt vmcnt(0)" ::: "memory")
__device__ __forceinline__ unsigned f2bf(float f) { unsigned u = __builtin_bit_cast(unsigned, f); return (u + 0x7fffu + ((u >> 16) & 1u)) >> 16; }
typedef float f32x2_ __attribute__((ext_vector_type(2)));
typedef __bf16 bf16x2_ __attribute__((ext_vector_type(2)));
__device__ __forceinline__ unsigned pk2(float lo, float hi) { f32x2_ v = {lo, hi}; bf16x2_ b = __builtin_convertvector(v, bf16x2_); return __builtin_bit_cast(unsigned, b); }
__device__ __forceinline__ float bflo(unsigned w) { return __builtin_bit_cast(float, w << 16); }
__device__ __forceinline__ float bfhi(unsigned w) { return __builtin_bit_cast(float, w & 0xffff0000u); }
__device__ __forceinline__ float bf2f(bf16 h) { return __builtin_bit_cast(float, (unsigned)h << 16); }
__device__ __forceinline__ unsigned pk4_fp8(float a, float b, float c, float d) { int w = 0; w = __builtin_amdgcn_cvt_pk_fp8_f32(a, b, w, false); w = __builtin_amdgcn_cvt_pk_fp8_f32(c, d, w, true); return (unsigned)w; }
__device__ __forceinline__ float clampf_(float x, float m) { return fminf(fmaxf(x, -m), m); }
template <bool W32> __device__ __forceinline__ void lane_swap(float v, float& r0, float& r1) {
    float a = v, b = v;
    if constexpr (W32) asm volatile("s_nop 1\n\tv_permlane32_swap_b32 %0, %1" : "+v"(a), "+v"(b));
    else asm volatile("s_nop 1\n\tv_permlane16_swap_b32 %0, %1" : "+v"(a), "+v"(b));
    r0 = a; r1 = b;
}
template <int CTRL> __device__ __forceinline__ float dpp_(float v) { return __builtin_bit_cast(float, __builtin_amdgcn_update_dpp(0, __builtin_bit_cast(int, v), CTRL, 0xF, 0xF, true)); }
__device__ __forceinline__ float wave_sum(float v) {
    v += dpp_<0xB1>(v); v += dpp_<0x4E>(v); v += dpp_<0x141>(v); v += dpp_<0x140>(v);
    float a, b; lane_swap<false>(v, a, b); v = a + b; lane_swap<true>(v, a, b); return a + b;
}
__device__ __forceinline__ float wave_max(float v) {
    v = fmaxf(v, dpp_<0xB1>(v)); v = fmaxf(v, dpp_<0x4E>(v)); v = fmaxf(v, dpp_<0x141>(v)); v = fmaxf(v, dpp_<0x140>(v));
    float a, b; lane_swap<false>(v, a, b); v = fmaxf(a, b); lane_swap<true>(v, a, b); return fmaxf(a, b);
}
__device__ __forceinline__ float sigmoidf_(float x) { return __builtin_amdgcn_rcpf(1.0f + __builtin_amdgcn_exp2f(-1.4426950408889634f * x)); }
__device__ __forceinline__ float gelu_tanh(float x) { return x * sigmoidf_(1.5957691216057308f * (x + 0.044715f * x * x * x)); }
__device__ __forceinline__ float siluf_(float x) { return x * sigmoidf_(x); }
__device__ __forceinline__ f32x2_ gelu_tanh2(f32x2_ x) {
    constexpr float c2 = -1.5957691216057308f * 1.4426950408889634f, c1 = c2 * 0.044715f;
    const f32x2_ w = (x * x) * c1 + c2, t = x * w;
    const f32x2_ d = (f32x2_){__builtin_amdgcn_exp2f(t.x), __builtin_amdgcn_exp2f(t.y)} + 1.0f;
    return x * (f32x2_){__builtin_amdgcn_rcpf(d.x), __builtin_amdgcn_rcpf(d.y)};
}
template <int SIN_NUM, int SOUT_NUM> __device__ __forceinline__ f32x2_ silu_gate2(f32x2_ a, f32x2_ b) {
    constexpr float inv = 1.0f / (float)SIN_NUM, k1 = -1.4426950408889634f * inv, k2 = inv * inv * (float)SOUT_NUM;
    const f32x2_ t = a * k1;
    const f32x2_ d = (f32x2_){__builtin_amdgcn_exp2f(t.x), __builtin_amdgcn_exp2f(t.y)} + 1.0f;
    return ((a * b) * k2) * (f32x2_){__builtin_amdgcn_rcpf(d.x), __builtin_amdgcn_rcpf(d.y)};
}

#define XB_TMO      128
#define XB_XCNT(j)  (256  + 64 * (j))
#define XB_XSUB(j)  (1280 + 64 * (j))
#define XB_XGEN(j)  (2304 + 64 * (j))
#define XB_TOP      3328
#define XB_TOPGEN   3392
#define XCD_BAR_WORDS 3456
#define XB_SPIN_CAP (1u << 25)
__device__ __forceinline__ unsigned xb_ld(unsigned* p)              { return __hip_atomic_load(p, __ATOMIC_RELAXED, __HIP_MEMORY_SCOPE_AGENT); }
__device__ __forceinline__ unsigned xb_add(unsigned* p, unsigned v) { return __hip_atomic_fetch_add(p, v, __ATOMIC_RELAXED, __HIP_MEMORY_SCOPE_AGENT); }
__device__ __forceinline__ unsigned xb_xcc_id() { return (unsigned)__builtin_amdgcn_s_getreg((3 << 11) | 20) & 0xFu; }
#define XB_SPIN(cond, bar) do { unsigned _sp = 0; while (cond) { __builtin_amdgcn_s_sleep(1); \
    if ((++_sp & 255u) == 0u) { if (xb_ld(&(bar)[XB_TMO])) break; if (_sp > XB_SPIN_CAP) { atomicAdd(&(bar)[XB_TMO], 1u); break; } } } } while (0)
struct XcdBarrier { unsigned* bar; unsigned x; volatile LAS unsigned* st; };
__device__ __forceinline__ XcdBarrier xcd_barrier_post(unsigned* bar, volatile LAS unsigned* st) {
    XcdBarrier b; b.bar = bar; b.x = xb_xcc_id(); b.st = st;
    if (threadIdx.x == 0) (void)xb_add(&bar[XB_XCNT(b.x)], 1u);
    return b;
}
__device__ __forceinline__ void xcd_barrier_complete(unsigned* bar, unsigned x, unsigned& nloc, unsigned& nx) {
    const unsigned G = gridDim.x * gridDim.y * gridDim.z;
    unsigned sum, cnt, mine, sp = 0u;
    for (;;) {
        sum = 0u; cnt = 0u; mine = 0u;
#pragma unroll
        for (unsigned j = 0; j < 16; ++j) { const unsigned c = xb_ld(&bar[XB_XCNT(j)]); sum += c; cnt += (c > 0u) ? 1u : 0u; mine = (j == x) ? c : mine; }
        if (sum == G) break;
        __builtin_amdgcn_s_sleep(1);
        if ((++sp & 255u) == 0u) { if (xb_ld(&bar[XB_TMO])) break; if (sp > XB_SPIN_CAP) { atomicAdd(&bar[XB_TMO], 1u); break; } }
    }
    nloc = mine > 0u ? mine : 1u; nx = cnt > 0u ? cnt : 1u;
}
__device__ __forceinline__ void xcd_barrier(const XcdBarrier& b) {
    asm volatile("s_waitcnt vmcnt(0)" ::: "memory");
    __syncthreads();
    if (threadIdx.x == 0) {
        unsigned* bar = b.bar;
        __builtin_amdgcn_s_waitcnt(0);
        unsigned nloc = b.st[0], nx = b.st[1];
        if (nloc == 0u) { xcd_barrier_complete(bar, b.x, nloc, nx); b.st[0] = nloc; b.st[1] = nx; }
        const unsigned old = xb_add(&bar[XB_XSUB(b.x)], 1u);
        const unsigned gen = old / nloc;
        if (old + 1u == (gen + 1u) * nloc) {
            __builtin_amdgcn_fence(__ATOMIC_RELEASE, "agent");
            asm volatile("s_waitcnt vmcnt(0)" ::: "memory");
            const unsigned og = xb_add(&bar[XB_TOP], 1u);
            const unsigned tg = og / nx;
            if (og + 1u == (tg + 1u) * nx) xb_add(&bar[XB_TOPGEN], 1u);
            else XB_SPIN(xb_ld(&bar[XB_TOPGEN]) == tg, bar);
            __builtin_amdgcn_fence(__ATOMIC_ACQUIRE, "agent");
            xb_add(&bar[XB_XGEN(b.x)], 1u);
            asm volatile("s_waitcnt vmcnt(0)" ::: "memory");
        } else {
            XB_SPIN(xb_ld(&bar[XB_XGEN(b.x)]) == gen, bar);
            __builtin_amdgcn_fence(__ATOMIC_ACQUIRE, "agent");
            asm volatile("s_waitcnt vmcnt(0)" ::: "memory");
        }
    }
    __syncthreads();
}

struct Frame {
    LAS unsigned char* lds;
    int tid, lane, wave, vcu, G;
    float* out;
    unsigned char* ws;
};
#define IN_X 0
#define IN_C 1
#define IN_CTX 2
#define IN_CCTX 3
#define IN_MODW 4
#define IN_MODB 5
#define IN_N1G 6
#define IN_N2G 7
#define IN_EVWIN 8
#define IN_EVSINK 9
#define IN_EVSGUG 10
#define IN_EVSGUW 11
#define IN_EVSGUB 12
#define IN_EVWOUT 13
#define IN_ODWIN 14
#define IN_ODQG 15
#define IN_ODWUQ 16
#define IN_ODKVG 17
#define IN_ODWUKV 18
#define IN_ODCONV 19
#define IN_ODWOUT 20
#define IN_ROUTER 21
#define IN_W1 22
#define IN_W3 23
#define IN_W2 24
#define IN_FING 25

__device__ __forceinline__ const float* inp(const Frame& F, int k) { return (const float*)(const GAS float*)(*(volatile LAS unsigned long long*)(F.lds + LDSCTL_OFF + 8 * k)); }
__device__ __forceinline__ int row_r(int row) { return row < NLAT ? (row >> 12) : 8; }
__device__ __forceinline__ int row_b(int row) { return row < NLAT ? (row >> 12) : ((row - NLAT) >> 8); }
__device__ __forceinline__ const float* modv(const Frame& F, int layer, int r, int which) { return (const float*)(F.ws + WS_MODV) + ((size_t)(layer * 9 + r) * 6 + which) * 1024; }

__device__ __forceinline__ void conv_item(const float* src, const float* src2, int ld_src, int K, bf16* dst, int kb, int nb, int kind, const float* kscale, LAS float* scr, int lane) {
    const int k0 = kb * 64, n0 = nb * 32, np = n0 + (lane & 31);
    const float* sp = src; int oc = np;
    if (kind == 1) {
        if (np < 128) { const int h = np >> 6, w = np & 63; oc = h * 64 + (w >> 1) + 32 * (w & 1); }
        else if (np >= 256 && np < 768) { const int w0 = np - 256, h = w0 >> 6, w = w0 & 63; oc = 256 + h * 64 + (w >> 1) + 32 * (w & 1); }
    } else if (kind == 2) {
        if (np < 256) oc = np; else if (np < 640) oc = np + 32; else if (np < 672) { const int w = np - 640; oc = 256 + (w >> 1) + 16 * (w & 1); } else if (np < 2208) oc = np; else oc = -1;
    } else if (kind == 3) {
        const int h = np / 96, w = np % 96; if (w >= 64) { const int w2 = w - 64; oc = h * 96 + 64 + (w2 >> 1) + 16 * (w2 & 1); }
    } else if (kind == 4) {
        const int half = (np >> 7) & 1; oc = (np >> 8) * 128 + (np & 127); sp = half ? src2 : src;
    }
#pragma unroll 8
    for (int i = 0; i < 32; ++i) { const int kk = 2 * i + (lane >> 5); float v = (oc >= 0) ? sp[(size_t)(k0 + kk) * ld_src + oc] : 0.f; if (kscale) v *= kscale[k0 + kk]; scr[kk * 33 + (lane & 31)] = v; }
    LDS_WAIT(); asm volatile("" ::: "memory");
    const int c = lane & 7;
#pragma unroll
    for (int j = 0; j < 4; ++j) { const int n = (lane >> 3) + 8 * j; const LAS float* s = scr + (8 * c) * 33 + n;
        v4u o; o.x = pk2(s[0 * 33], s[1 * 33]); o.y = pk2(s[2 * 33], s[3 * 33]); o.z = pk2(s[4 * 33], s[5 * 33]); o.w = pk2(s[6 * 33], s[7 * 33]);
        *(v4u*)(dst + (size_t)(n0 + n) * K + k0 + 8 * c) = o; }
    LDS_WAIT(); asm volatile("" ::: "memory");
}

__device__ __forceinline__ void conv_item_fp8(const float* src, const float* src2, int ld_src, int K, unsigned char* dst, int kb, int nb, int kind, LAS float* scr, int lane) {
    const int k0 = kb * 128, n0 = nb * 32, np = n0 + 4 * (lane & 7), kr = lane >> 3;
    const float* sp = src; int oc = np;
    if (kind == 4) { const int half = (np >> 7) & 1; oc = (np >> 8) * 128 + (np & 127); sp = half ? src2 : src; }
    sp += (size_t)(k0 + kr) * ld_src + oc;
#pragma unroll 8
    for (int i = 0; i < 16; ++i) { const f32x4 v = *(const f32x4*)(sp + (size_t)(8 * i) * ld_src); *(LAS f32x4*)(scr + (8 * i + kr) * 36 + 4 * (lane & 7)) = v * F8_SW; }
    LDS_WAIT(); asm volatile("" ::: "memory");
    const int n = lane >> 1, h = lane & 1;
    unsigned char* d = dst + (size_t)(n0 + n) * K + k0 + 64 * h;
#pragma unroll
    for (int q = 0; q < 4; ++q) { const LAS float* sc = scr + (64 * h + 16 * q) * 36 + n; v4u o;
        o.x = pk4_fp8(sc[0 * 36], sc[1 * 36], sc[2 * 36], sc[3 * 36]);   o.y = pk4_fp8(sc[4 * 36], sc[5 * 36], sc[6 * 36], sc[7 * 36]);
        o.z = pk4_fp8(sc[8 * 36], sc[9 * 36], sc[10 * 36], sc[11 * 36]); o.w = pk4_fp8(sc[12 * 36], sc[13 * 36], sc[14 * 36], sc[15 * 36]);
        *(v4u*)(d + 16 * q) = o; }
    LDS_WAIT(); asm volatile("" ::: "memory");
}
constexpr int CI_WINE = 16 * 56, CI_WOUT = 16 * 32, CI_WINO = 16 * 72, CI_WUQ = 6 * 24, CI_WUKV = 4 * 32;
constexpr int CI_SMALL = CI_WINE + CI_WOUT + CI_WINO + CI_WUQ + CI_WUKV + CI_WOUT, CI_SMALL2 = 2 * CI_SMALL;
constexpr int CI_W13 = FP8_F1 ? 8 * 64 : 16 * 64, CI_W2 = FP8_F2 ? 8 * 32 : 16 * 32, CI_PER_LAYER = 16 * (CI_W13 + CI_W2);
__device__ __forceinline__ void conv_items(Frame& F, int lo, int hi, int worker, int nworkers) {
    LAS float* scr = (LAS float*)(F.lds + F.wave * 18432);
    const int gw = worker * NWAVES + F.wave, NGW = nworkers * NWAVES;
    unsigned char* wsm = F.ws + WS_WSMALL;
    for (int it = lo + gw; it < hi; it += NGW) {
        int r = it;
        if (r < CI_SMALL2) {
            const int i = r / CI_SMALL; r %= CI_SMALL;
            if (r < CI_WINE) { conv_item(inp(F, IN_EVWIN) + (size_t)i * D * ZE, nullptr, ZE, D, (bf16*)(wsm + OFF_WINE + i * SZ_WINE), r / 56, r % 56, 1, nullptr, scr, F.lane); continue; } r -= CI_WINE;
            if (r < CI_WOUT) { conv_item(inp(F, IN_EVWOUT) + (size_t)i * D * D, nullptr, D, D, (bf16*)(wsm + OFF_WOUTE + i * SZ_WOUT), r / 32, r % 32, 0, nullptr, scr, F.lane); continue; } r -= CI_WOUT;
            if (r < CI_WINO) { conv_item(inp(F, IN_ODWIN) + (size_t)i * D * 2208, nullptr, 2208, D, (bf16*)(wsm + OFF_WINO + i * SZ_WINO), r / 72, r % 72, 2, nullptr, scr, F.lane); continue; } r -= CI_WINO;
            if (r < CI_WUQ) { conv_item(inp(F, IN_ODWUQ) + (size_t)i * 384 * 768, nullptr, 768, 384, (bf16*)(wsm + OFF_WUQ + i * SZ_WUQ), r / 24, r % 24, 3, inp(F, IN_ODQG) + i * 384, scr, F.lane); continue; } r -= CI_WUQ;
            if (r < CI_WUKV) { conv_item(inp(F, IN_ODWUKV) + (size_t)i * 256 * 1024, nullptr, 1024, 256, (bf16*)(wsm + OFF_WUKV + i * SZ_WUKV), r / 32, r % 32, 0, inp(F, IN_ODKVG) + i * 256, scr, F.lane); continue; } r -= CI_WUKV;
            conv_item(inp(F, IN_ODWOUT) + (size_t)i * D * D, nullptr, D, D, (bf16*)(wsm + OFF_WOUTO + i * SZ_WOUT), r / 32, r % 32, 0, nullptr, scr, F.lane); continue;
        }
        r -= CI_SMALL2;
        const int layer = r / CI_PER_LAYER; r %= CI_PER_LAYER;
        if (r < 16 * CI_W13) { const int le = layer * 16 + r / CI_W13; r %= CI_W13;
            if constexpr (FP8_F1) conv_item_fp8(inp(F, IN_W1) + (size_t)le * D * FF, inp(F, IN_W3) + (size_t)le * D * FF, FF, D, F.ws + WS_W13 + (size_t)le * (SZ_W13 / 2), r / 64, r % 64, 4, scr, F.lane);
            else conv_item(inp(F, IN_W1) + (size_t)le * D * FF, inp(F, IN_W3) + (size_t)le * D * FF, FF, D, (bf16*)(F.ws + WS_W13 + (size_t)le * SZ_W13), r / 64, r % 64, 4, nullptr, scr, F.lane);
            continue; }
        r -= 16 * CI_W13;
        { const int le = layer * 16 + r / CI_W2; r %= CI_W2;
            if constexpr (FP8_F2) conv_item_fp8(inp(F, IN_W2) + (size_t)le * FF * D, nullptr, D, FF, F.ws + WS_W2 + (size_t)le * (SZ_W2 / 2), r / 32, r % 32, 0, scr, F.lane);
            else conv_item(inp(F, IN_W2) + (size_t)le * FF * D, nullptr, D, FF, (bf16*)(F.ws + WS_W2 + (size_t)le * SZ_W2), r / 32, r % 32, 0, nullptr, scr, F.lane); }
    }
}
#define CONV_TAIL(S_, layer_, f0_, f1_) do { const int rem_ = (S_).nwg % F.G; if ((layer_) < DEPTH - 1 && rem_ != 0 && (int)blockIdx.x >= rem_) { LAUNDER(); \
        const int base_ = CI_SMALL2 + ((layer_) + 1) * CI_PER_LAYER; conv_items(F, base_ + CI_PER_LAYER * (f0_) / 64, base_ + CI_PER_LAYER * (f1_) / 64, (int)blockIdx.x - rem_, F.G - rem_); } } while (0)
__device__ __forceinline__ void p0_prologue(Frame& F) {
    {
        LAS float* s = (LAS float*)F.lds;
        LAS float* red = s + 9 * 1024;
        for (int i = F.tid; i < 9 * 1024; i += NT) { const int r = i >> 10, k = i & 1023; const float v = (r < 8) ? inp(F, IN_C)[r * 1024 + k] : inp(F, IN_CCTX)[k]; s[i] = siluf_(v); }
        __syncthreads();
        for (int u = blockIdx.x; u < 4 * 48; u += F.G) {
            const int layer = u / 48, ch = u % 48, col = ch * 128 + (F.tid & 127), kq = F.tid >> 7;
            const float* W = inp(F, IN_MODW) + (size_t)layer * 1024 * 6144;
            float acc[9];
#pragma unroll
            for (int r = 0; r < 9; ++r) acc[r] = 0.f;
            for (int k = kq * 256; k < kq * 256 + 256; k += 16) {
                float w[16];
#pragma unroll
                for (int j = 0; j < 16; ++j) w[j] = W[(size_t)(k + j) * 6144 + col];
#pragma unroll
                for (int j = 0; j < 16; ++j)
#pragma unroll
                    for (int r = 0; r < 9; ++r) acc[r] += s[r * 1024 + k + j] * w[j]; }
#pragma unroll
            for (int r = 0; r < 9; ++r) red[(kq * 9 + r) * 128 + (F.tid & 127)] = acc[r];
            __syncthreads();
            for (int i = F.tid; i < 9 * 128; i += NT) { const int r = i >> 7, cc = i & 127; const float v = red[(0 * 9 + r) * 128 + cc] + red[(1 * 9 + r) * 128 + cc] + red[(2 * 9 + r) * 128 + cc] + red[(3 * 9 + r) * 128 + cc];
                const int c6 = ch * 128 + cc; ((float*)(F.ws + WS_MODV))[(size_t)(layer * 9 + r) * 6144 + c6] = v + inp(F, IN_MODB)[layer * 6144 + c6]; }
            __syncthreads();
        }
        __syncthreads();
    }
    {
        float* ca = (float*)(F.ws + WS_TAB); float* sa = ca + 4096 * 32; float* cc = sa + 4096 * 32; float* sc = cc + 4096 * 16;
        for (int i = blockIdx.x * NT + F.tid; i < 4096 * 32; i += F.G * NT) { const int pos = i >> 5, j = i & 31; const float inv = powf(10000.0f, -(float)(j & 15) / 16.0f);
            const float ang = (float)((j < 16) ? (pos >> 6) : (pos & 63)) * inv; ca[i] = cosf(ang); sa[i] = sinf(ang); }
        for (int i = blockIdx.x * NT + F.tid; i < 4096 * 16; i += F.G * NT) { const int pos = i >> 4, j = i & 15; const float inv = powf(10000.0f, -(float)(j & 7) / 8.0f);
            const float ang = (float)((j < 8) ? (pos >> 6) : (pos & 63)) * inv; cc[i] = cosf(ang); sc[i] = sinf(ang); }
    }
    {
        const float* w = inp(F, IN_EVSGUW); bf16* o = (bf16*)(F.ws + WS_WSB);
        for (int i = blockIdx.x * NT + F.tid; i < 2 * 4 * 128 * 128; i += F.G * NT) o[i] = (bf16)f2bf(w[i]);
    }
    {
        constexpr int TOT = CI_SMALL2 + CI_PER_LAYER, CUT = TOT / 10;
        if (F.G > 192) { if ((int)blockIdx.x >= 192) conv_items(F, TOT - CUT, TOT, (int)blockIdx.x - 192, F.G - 192); conv_items(F, 0, TOT - CUT, F.vcu, F.G); }
        else conv_items(F, 0, TOT, F.vcu, F.G);
    }
}

__device__ __forceinline__ void load_row4(const float* p, int lane, f32x4 (&v)[4]) {
    const f32x4* q = (const f32x4*)p + lane;
#pragma unroll
    for (int j = 0; j < 4; ++j) v[j] = q[64 * j];
}
__device__ __forceinline__ void load_row4b(const bf16* p, int lane, v2u (&v)[4]) {
    const v2u* q = (const v2u*)p + lane;
#pragma unroll
    for (int j = 0; j < 4; ++j) v[j] = q[64 * j];
}
__device__ __forceinline__ f32x4 bf4(v2u w) { return (f32x4){bflo(w.x), bfhi(w.x), bflo(w.y), bfhi(w.y)}; }
__device__ __forceinline__ void n1_phase(Frame& F, int layer, bool dummy = false) {
    const int gw = F.vcu * NWAVES + F.wave, NGW = F.G * NWAVES;
    bf16* X = (bf16*)(F.ws + WS_X);
    bf16* H = (bf16*)(F.ws + WS_H);
    const bf16* Y = (const bf16*)(F.ws + WS_Y);
    const int* INV = (const int*)(F.ws + WS_INV); const float* AFF = (const float*)(F.ws + WS_AFF);
    const float* xin = inp(F, IN_X); const float* cin = inp(F, IN_CTX);
    const int nrows = (layer == 4) ? NLAT : MT, rpw = (nrows + NGW - 1) / NGW, r0 = gw * rpw, r1 = (r0 + rpw < nrows) ? r0 + rpw : nrows;
    if (r0 >= r1) return;
    f32x4 xn[4]; v2u xb[4]; int invn = -1; float affn = 0.f;
#pragma unroll
    for (int j = 0; j < 4; ++j) { xn[j] = (f32x4){0.f, 0.f, 0.f, 0.f}; xb[j] = (v2u){0u, 0u}; }
#define N1_FETCH(row_) do { if (layer == 0) load_row4((row_) < NLAT ? xin + (size_t)(row_) * 1024 : cin + (size_t)((row_) - NLAT) * 1024, F.lane, xn); else load_row4b(X + (size_t)(row_) * 1024, F.lane, xb); \
        if (layer > 0 && F.lane < 16) { invn = ((row_) < NLAT) ? INV[((size_t)((row_) >> 12) * 16 + F.lane) * 4096 + ((row_) & 4095)] : INV[(size_t)NLAT * 16 + ((size_t)(((row_) - NLAT) >> 8) * 16 + F.lane) * 256 + (((row_) - NLAT) & 255)]; \
            affn = AFF[(size_t)(row_) * 16 + F.lane]; } } while (0)
    N1_FETCH(r0);
    int rcur = -1;
    f32x4 cA[4], cB[4], g2[4];
#pragma unroll
    for (int j = 0; j < 4; ++j) { cA[j] = (f32x4){0.f, 0.f, 0.f, 0.f}; cB[j] = cA[j]; g2[j] = cA[j]; }
    for (int row = r0; row < r1; ++row) {
        f32x4 x[4];
#pragma unroll
        for (int j = 0; j < 4; ++j) x[j] = (layer == 0) ? xn[j] : bf4(xb[j]);
        const int inv = invn; const float aff = affn;
        if (row + 1 < r1) N1_FETCH(row + 1);
        const int r = row_r(row);
        if (r != rcur) {
            rcur = r;
            if (layer > 0) load_row4(modv(F, layer - 1, r, 5), F.lane, g2);
            if (layer < 4) { f32x4 g[4], sc[4]; load_row4(inp(F, IN_N1G) + layer * 1024, F.lane, g); load_row4(modv(F, layer, r, 1), F.lane, sc); load_row4(modv(F, layer, r, 0), F.lane, cB);
#pragma unroll
                for (int j = 0; j < 4; ++j) cA[j] = g[j] * (sc[j] + 1.0f); }
            else load_row4(inp(F, IN_FING), F.lane, cA);
        }
        if (layer > 0) {
            unsigned long long mask = __ballot(F.lane < 16 && inv >= 0);
            f32x4 acc[4];
#pragma unroll
            for (int j = 0; j < 4; ++j) acc[j] = (f32x4){0.f, 0.f, 0.f, 0.f};
            while (mask) {
                const int e0 = __builtin_ctzll(mask); mask &= mask - 1;
                const bool two = mask != 0; const int e1 = two ? __builtin_ctzll(mask) : e0; if (two) mask &= mask - 1;
                const int s0 = __builtin_amdgcn_readlane(inv, e0), s1 = __builtin_amdgcn_readlane(inv, e1);
                const float ga = __builtin_bit_cast(float, __builtin_amdgcn_readlane(__builtin_bit_cast(int, aff), e0)), gb = two ? __builtin_bit_cast(float, __builtin_amdgcn_readlane(__builtin_bit_cast(int, aff), e1)) : 0.f;
                if constexpr (FP8_Y) {
                    const unsigned* ya = (const unsigned*)((const unsigned char*)Y + (size_t)(e0 * EROWS + s0) * 1024) + F.lane; const unsigned* yb = (const unsigned*)((const unsigned char*)Y + (size_t)(e1 * EROWS + s1) * 1024) + F.lane;
                    unsigned wa[4], wb[4];
#pragma unroll
                    for (int j = 0; j < 4; ++j) { wa[j] = ya[64 * j]; wb[j] = yb[64 * j]; }
                    const float ga_ = ga * (1.0f / F8_SY), gb_ = gb * (1.0f / F8_SY);
#pragma unroll
                    for (int j = 0; j < 4; ++j) { const f32x2_ a0 = __builtin_amdgcn_cvt_pk_f32_fp8((int)wa[j], false), a1 = __builtin_amdgcn_cvt_pk_f32_fp8((int)wa[j], true), b0 = __builtin_amdgcn_cvt_pk_f32_fp8((int)wb[j], false), b1 = __builtin_amdgcn_cvt_pk_f32_fp8((int)wb[j], true);
                        acc[j].x += ga_ * a0.x + gb_ * b0.x; acc[j].y += ga_ * a0.y + gb_ * b0.y; acc[j].z += ga_ * a1.x + gb_ * b1.x; acc[j].w += ga_ * a1.y + gb_ * b1.y; }
                } else {
                const v2u* ya = (const v2u*)(Y + (size_t)(e0 * EROWS + s0) * 1024) + F.lane; const v2u* yb = (const v2u*)(Y + (size_t)(e1 * EROWS + s1) * 1024) + F.lane;
                v2u wa[4], wb[4];
#pragma unroll
                for (int j = 0; j < 4; ++j) { wa[j] = ya[64 * j]; wb[j] = yb[64 * j]; }
#pragma unroll
                for (int j = 0; j < 4; ++j) { acc[j].x += ga * bflo(wa[j].x) + gb * bflo(wb[j].x); acc[j].y += ga * bfhi(wa[j].x) + gb * bfhi(wb[j].x); acc[j].z += ga * bflo(wa[j].y) + gb * bflo(wb[j].y); acc[j].w += ga * bfhi(wa[j].y) + gb * bfhi(wb[j].y); }
                }
            }
#pragma unroll
            for (int j = 0; j < 4; ++j) x[j] += g2[j] * acc[j];
        }
        float ss = 0.f;
#pragma unroll
        for (int j = 0; j < 4; ++j) ss += (x[j].x * x[j].x + x[j].y * x[j].y) + (x[j].z * x[j].z + x[j].w * x[j].w);
        const float rstd = 1.0f / sqrtf(wave_sum(ss) * (1.0f / 1024.0f) + EPS);
        if (layer == 4) {
            f32x4* o = (f32x4*)(F.out + (size_t)row * 1024) + F.lane;
#pragma unroll
            for (int j = 0; j < 4; ++j) o[64 * j] = x[j] * rstd * cA[j];
        } else {
            v2u* xo = (v2u*)((dummy ? (bf16*)(F.ws + WS_X + 68 * MiB) : X) + (size_t)row * 1024) + F.lane;
#pragma unroll
            for (int j = 0; j < 4; ++j) { v2u w; w.x = pk2(x[j].x, x[j].y); w.y = pk2(x[j].z, x[j].w); xo[64 * j] = w; }
            v2u* ho = (v2u*)((dummy ? (bf16*)(F.ws + WS_Z) : H) + (size_t)row * 1024) + F.lane;
#pragma unroll
            for (int j = 0; j < 4; ++j) { const f32x4 h = x[j] * rstd * cA[j] + cB[j]; v2u w; w.x = pk2(h.x, h.y); w.y = pk2(h.z, h.w); ho[64 * j] = w; }
            if ((layer & 1) && F.lane == 0) { unsigned long long* rs = (unsigned long long*)(F.ws + WS_RS); rs[row] = 0ull; rs[MT + row] = 0ull; }
        }
    }
#undef N1_FETCH
}

__device__ __forceinline__ void n2_phase(Frame& F, int layer) {
    const int gw = F.vcu * NWAVES + F.wave, NGW = F.G * NWAVES;
    const bf16* X = (const bf16*)(F.ws + WS_X);
    bf16* H = (bf16*)(F.ws + WS_H);
    LAS float* wr = (LAS float*)F.lds;
    const float* rw = inp(F, IN_ROUTER) + (size_t)layer * 1024 * 16;
    for (int i = F.tid; i < 16384; i += NT) { const int k = i >> 4, e = i & 15; wr[e * 1024 + k] = rw[i]; }
    __syncthreads();
    float* AFF = (float*)(F.ws + WS_AFF); float* AFFT = (float*)(F.ws + WS_AFFT);
    const bool need_ctx = layer < DEPTH - 1;
    const int nrows = need_ctx ? MT : NLAT, rpw = (nrows + NGW - 1) / NGW, r0 = gw * rpw, r1 = (r0 + rpw < nrows) ? r0 + rpw : nrows;
    const int b5 = (F.lane >> 5) & 1, b4 = (F.lane >> 4) & 1, b3 = (F.lane >> 3) & 1, b2 = (F.lane >> 2) & 1, emine = (F.lane >> 2) & 15;
    if (r0 < r1) {
        v2u xn[4]; load_row4b(X + (size_t)r0 * 1024, F.lane, xn);
        int rcur = -1; f32x4 cA[4], cB[4];
#pragma unroll
        for (int j = 0; j < 4; ++j) { cA[j] = (f32x4){0.f, 0.f, 0.f, 0.f}; cB[j] = cA[j]; }
        for (int row = r0; row < r1; ++row) {
            f32x4 x[4];
#pragma unroll
            for (int j = 0; j < 4; ++j) x[j] = bf4(xn[j]);
            if (row + 1 < r1) load_row4b(X + (size_t)(row + 1) * 1024, F.lane, xn);
            const int r = row_r(row);
            if (r != rcur) { rcur = r; f32x4 g[4], sc[4]; load_row4(inp(F, IN_N2G) + layer * 1024, F.lane, g); load_row4(modv(F, layer, r, 4), F.lane, sc); load_row4(modv(F, layer, r, 3), F.lane, cB);
#pragma unroll
                for (int j = 0; j < 4; ++j) cA[j] = g[j] * (sc[j] + 1.0f); }
            float ss = 0.f;
#pragma unroll
            for (int j = 0; j < 4; ++j) ss += (x[j].x * x[j].x + x[j].y * x[j].y) + (x[j].z * x[j].z + x[j].w * x[j].w);
            const float rstd = 1.0f / sqrtf(wave_sum(ss) * (1.0f / 1024.0f) + EPS);
            f32x4 h[4];
            if constexpr (FP8_F1) {
                unsigned* ho = (unsigned*)((unsigned char*)H + (size_t)row * 1024) + F.lane;
#pragma unroll
                for (int j = 0; j < 4; ++j) { h[j] = x[j] * rstd * cA[j] + cB[j]; ho[64 * j] = pk4_fp8(clampf_(h[j].x * F8_SA, 448.f), clampf_(h[j].y * F8_SA, 448.f), clampf_(h[j].z * F8_SA, 448.f), clampf_(h[j].w * F8_SA, 448.f)); }
            } else {
                v2u* ho = (v2u*)(H + (size_t)row * 1024) + F.lane;
#pragma unroll
                for (int j = 0; j < 4; ++j) { h[j] = x[j] * rstd * cA[j] + cB[j]; v2u w; w.x = pk2(h[j].x, h[j].y); w.y = pk2(h[j].z, h[j].w); ho[64 * j] = w; }
            }
            float a[16];
#pragma unroll
            for (int e = 0; e < 16; ++e) { float t = 0.f;
#pragma unroll
                for (int j = 0; j < 4; ++j) { const f32x4 w = *(const LAS f32x4*)(wr + e * 1024 + 256 * j + 4 * F.lane); t += (h[j].x * w.x + h[j].y * w.y) + (h[j].z * w.z + h[j].w * w.w); }
                a[e] = t; if ((e & 3) == 3) asm volatile("" ::: "memory"); }
            float bq[8], cq[4], dq[2];
#pragma unroll
            for (int j = 0; j < 8; ++j) { const float keep = b5 ? a[j + 8] : a[j], send = b5 ? a[j] : a[j + 8]; bq[j] = keep + __shfl_xor(send, 32); }
#pragma unroll
            for (int j = 0; j < 4; ++j) { const float keep = b4 ? bq[j + 4] : bq[j], send = b4 ? bq[j] : bq[j + 4]; cq[j] = keep + __shfl_xor(send, 16); }
#pragma unroll
            for (int j = 0; j < 2; ++j) { const float keep = b3 ? cq[j + 2] : cq[j], send = b3 ? cq[j] : cq[j + 2]; dq[j] = keep + __shfl_xor(send, 8); }
            float lg = (b2 ? dq[1] : dq[0]) + __shfl_xor(b2 ? dq[0] : dq[1], 4);
            lg += __shfl_xor(lg, 2); lg += __shfl_xor(lg, 1);
            float mx = lg;
#pragma unroll
            for (int o = 4; o < 64; o <<= 1) mx = fmaxf(mx, __shfl_xor(mx, o));
            const float p = expf(lg - mx); float den = p;
#pragma unroll
            for (int o = 4; o < 64; o <<= 1) den += __shfl_xor(den, o);
            const float mine = p / den;
            if ((F.lane & 3) == 0) {
                AFF[(size_t)row * 16 + emine] = mine;
                if (row < NLAT) AFFT[((size_t)(row >> 12) * 16 + emine) * 4096 + (row & 4095)] = mine;
                else { const int rc = row - NLAT; AFFT[(size_t)NLAT * 16 + ((size_t)(rc >> 8) * 16 + emine) * 256 + (rc & 255)] = mine; }
            }
        }
    }
    __syncthreads();
}

__device__ __forceinline__ void n2_row_valu(Frame& F, int layer, int row, const v2u (&xr)[4], const LAS float* wr, const LAS float* ca, const LAS float* cb) {
    unsigned char* H2 = F.ws + WS_H; float* AFF = (float*)(F.ws + WS_AFF); float* AFFT = (float*)(F.ws + WS_AFFT);
    const int b5 = (F.lane >> 5) & 1, b4 = (F.lane >> 4) & 1, b3 = (F.lane >> 3) & 1, b2 = (F.lane >> 2) & 1, emine = (F.lane >> 2) & 15;
    f32x4 x[4];
#pragma unroll
    for (int j = 0; j < 4; ++j) x[j] = bf4(xr[j]);
    float ss = 0.f;
#pragma unroll
    for (int j = 0; j < 4; ++j) ss += (x[j].x * x[j].x + x[j].y * x[j].y) + (x[j].z * x[j].z + x[j].w * x[j].w);
    const float rstd = 1.0f / sqrtf(wave_sum(ss) * (1.0f / 1024.0f) + EPS);
    f32x4 h[4];
    unsigned* ho = (unsigned*)(H2 + (size_t)row * 1024) + F.lane;
#pragma unroll
    for (int j = 0; j < 4; ++j) { const f32x4 cA = *(const LAS f32x4*)(ca + 256 * j + 4 * F.lane), cB = *(const LAS f32x4*)(cb + 256 * j + 4 * F.lane);
        h[j] = x[j] * rstd * cA + cB; ho[64 * j] = pk4_fp8(clampf_(h[j].x * F8_SA, 448.f), clampf_(h[j].y * F8_SA, 448.f), clampf_(h[j].z * F8_SA, 448.f), clampf_(h[j].w * F8_SA, 448.f)); }
    float a[16];
#pragma unroll
    for (int e = 0; e < 16; ++e) { float t = 0.f;
#pragma unroll
        for (int j = 0; j < 4; ++j) { const f32x4 w = *(const LAS f32x4*)(wr + e * 1028 + 256 * j + 4 * F.lane); t += (h[j].x * w.x + h[j].y * w.y) + (h[j].z * w.z + h[j].w * w.w); }
        a[e] = t; if ((e & 3) == 3) asm volatile("" ::: "memory"); }
    float bq[8], cq[4], dq[2];
#pragma unroll
    for (int j = 0; j < 8; ++j) { const float keep = b5 ? a[j + 8] : a[j], send = b5 ? a[j] : a[j + 8]; bq[j] = keep + __shfl_xor(send, 32); }
#pragma unroll
    for (int j = 0; j < 4; ++j) { const float keep = b4 ? bq[j + 4] : bq[j], send = b4 ? bq[j] : bq[j + 4]; cq[j] = keep + __shfl_xor(send, 16); }
#pragma unroll
    for (int j = 0; j < 2; ++j) { const float keep = b3 ? cq[j + 2] : cq[j], send = b3 ? cq[j] : cq[j + 2]; dq[j] = keep + __shfl_xor(send, 8); }
    float lg = (b2 ? dq[1] : dq[0]) + __shfl_xor(b2 ? dq[0] : dq[1], 4);
    lg += __shfl_xor(lg, 2); lg += __shfl_xor(lg, 1);
    float mx = lg;
#pragma unroll
    for (int o = 4; o < 64; o <<= 1) mx = fmaxf(mx, __shfl_xor(mx, o));
    const float p = expf(lg - mx); float den = p;
#pragma unroll
    for (int o = 4; o < 64; o <<= 1) den += __shfl_xor(den, o);
    const float mine = p / den;
    if ((F.lane & 3) == 0) {
        AFF[(size_t)row * 16 + emine] = mine;
        if (row < NLAT) AFFT[((size_t)(row >> 12) * 16 + emine) * 4096 + (row & 4095)] = mine;
        else { const int rc = row - NLAT; AFFT[(size_t)NLAT * 16 + ((size_t)(rc >> 8) * 16 + emine) * 256 + (rc & 255)] = mine; }
    }
}
__device__ __forceinline__ void n2_phase_mfma(Frame& F, int layer) {
    typedef short n2v8 __attribute__((ext_vector_type(8)));
    const bf16* X = (const bf16*)(F.ws + WS_X);
    unsigned char* H2 = F.ws + WS_H;
    LAS unsigned short* AH = (LAS unsigned short*)F.lds;
    LAS unsigned short* AL = AH + 32 * 64 * 8;
    LAS float* CA = (LAS float*)(F.lds + 65536);
    LAS float* CB = CA + 1024;
    LAS float* CP = CB + 1024;
    LAS float* CC = CP + 512;
    LAS float* CA8 = (LAS float*)(F.lds + 77824);
    LAS float* CB8 = CA8 + 1024;
    LAS float* WR = (LAS float*)(F.lds + 86016);
    const float* rw = inp(F, IN_ROUTER) + (size_t)layer * 16384;
    float* AFF = (float*)(F.ws + WS_AFF); float* AFFT = (float*)(F.ws + WS_AFFT);
    const bool need_ctx = layer < DEPTH - 1;
    const int nunits = NLAT / 128;
    const int gwv = F.vcu * NWAVES + F.wave, NGWV = F.G * NWAVES;
    const int q = F.lane >> 4, rl = F.lane & 15;
    int rcur = -1;
    if (need_ctx) {
        v2u xc[4]; const bool has_ctx = NLAT + gwv < MT;
        load_row4b(X + (size_t)(has_ctx ? NLAT + gwv : 0) * 1024, F.lane, xc);
        { for (int i = F.tid; i < 16384; i += NT) { const int k = i >> 4, e = i & 15; WR[e * 1028 + k] = rw[i]; }
          const float* g = inp(F, IN_N2G) + layer * 1024; const float* sc = modv(F, layer, 8, 4); const float* sh = modv(F, layer, 8, 3);
          for (int k = F.tid; k < 1024; k += NT) { CA8[k] = g[k] * (sc[k] + 1.0f); CB8[k] = sh[k]; } }
        __syncthreads();
        if (has_ctx) n2_row_valu(F, layer, NLAT + gwv, xc, WR, CA8, CB8);
        for (int row = NLAT + gwv + NGWV; row < MT; row += NGWV) { v2u xq[4]; load_row4b(X + (size_t)row * 1024, F.lane, xq); n2_row_valu(F, layer, row, xq, WR, CA8, CB8); }
    }
    for (int u = F.vcu; u < nunits; u += F.G) {
        const int row0 = u * 128, r = row_r(row0), row = row0 + F.wave * 16 + rl;
        const v4u* xp = (const v4u*)(X + (size_t)row * 1024) + 2 * q;
        v4u x[32];
#pragma unroll
        for (int s = 0; s < 32; ++s) x[s] = xp[(s >> 1) * 8 + (s & 1)];
        if (r != rcur) {
            rcur = r;
            __syncthreads();
            { const float* g = inp(F, IN_N2G) + layer * 1024; const float* sc = modv(F, layer, r, 4); const float* sh = modv(F, layer, r, 3);
              for (int k = F.tid; k < 1024; k += NT) { CA[k] = g[k] * (sc[k] + 1.0f) * F8_SA; CB[k] = sh[k] * F8_SA; } }
            __syncthreads();
            { const int e = F.tid & 15; float cpart = 0.f;
#pragma unroll 4
              for (int i = 0; i < 32; ++i) { const int idx = F.tid + NT * i, k = idx >> 4; const float w = rw[idx]; const float wf = CA[k] * (1.0f / F8_SA) * w; cpart += CB[k] * (1.0f / F8_SA) * w;
                  const unsigned hi = f2bf(wf); const unsigned lo = f2bf(wf - __builtin_bit_cast(float, hi << 16));
                  const int c = k >> 3, j = k & 7, st = (c >> 3) * 2 + (c & 1), qq = (c & 7) >> 1, off = ((st * 64 + qq * 16 + e) * 8 + j);
                  AH[off] = (unsigned short)hi; AL[off] = (unsigned short)lo; }
              CP[(F.tid >> 4) * 16 + e] = cpart; }
            __syncthreads();
            if (F.tid < 16) { float c = 0.f; for (int gi = 0; gi < 32; ++gi) c += CP[gi * 16 + F.tid]; CC[F.tid] = c; }
            __syncthreads();
        }
        f32x4 acc = {0.f, 0.f, 0.f, 0.f}, acc2 = acc, acc3 = acc;
#pragma unroll
        for (int s = 0; s < 32; ++s) {
            const n2v8 xb = __builtin_bit_cast(n2v8, x[s]);
            const n2v8 ah = *(const LAS n2v8*)(AH + (s * 64 + F.lane) * 8), al = *(const LAS n2v8*)(AL + (s * 64 + F.lane) * 8);
            acc = __builtin_amdgcn_mfma_f32_16x16x32_bf16(ah, xb, acc, 0, 0, 0);
            acc2 = __builtin_amdgcn_mfma_f32_16x16x32_bf16(al, xb, acc2, 0, 0, 0);
            acc3 = __builtin_amdgcn_mfma_f32_16x16x32_bf16(xb, xb, acc3, 0, 0, 0);
        }
        const int i3 = F.lane & 3;
        const float dsel = i3 == 0 ? acc3[0] : i3 == 1 ? acc3[1] : i3 == 2 ? acc3[2] : acc3[3];
        const float ss = __shfl(dsel, ((rl >> 2) << 4) + rl);
        const float rstd = 1.0f / sqrtf(ss * (1.0f / 1024.0f) + EPS);
        {
            const f32x4 cc = *(const LAS f32x4*)(CC + 4 * q);
            float lg[4];
#pragma unroll
            for (int i = 0; i < 4; ++i) lg[i] = rstd * (acc[i] + acc2[i]) + cc[i];
            float mx = fmaxf(fmaxf(lg[0], lg[1]), fmaxf(lg[2], lg[3]));
            { float t0, t1; lane_swap<false>(mx, t0, t1); mx = fmaxf(t0, t1); lane_swap<true>(mx, t0, t1); mx = fmaxf(t0, t1); }
            float pe[4], den = 0.f;
#pragma unroll
            for (int i = 0; i < 4; ++i) { pe[i] = expf(lg[i] - mx); den += pe[i]; }
            { float t0, t1; lane_swap<false>(den, t0, t1); den = t0 + t1; lane_swap<true>(den, t0, t1); den = t0 + t1; }
            const float rden = 1.0f / den;
            f32x4 af; af.x = pe[0] * rden; af.y = pe[1] * rden; af.z = pe[2] * rden; af.w = pe[3] * rden;
            *(f32x4*)(AFF + (size_t)row * 16 + 4 * q) = af;
            float* at = (row < NLAT) ? AFFT + ((size_t)(row >> 12) * 16 + 4 * q) * 4096 + (row & 4095) : AFFT + (size_t)NLAT * 16 + ((size_t)((row - NLAT) >> 8) * 16 + 4 * q) * 256 + ((row - NLAT) & 255);
            const int astr = (row < NLAT) ? 4096 : 256;
            at[0] = af.x; at[astr] = af.y; at[2 * astr] = af.z; at[3 * astr] = af.w;
        }
        unsigned char* hrow = H2 + (size_t)row * 1024 + q * 16;
#pragma unroll
        for (int p = 0; p < 16; ++p) {
            const LAS f32x4* ca = (const LAS f32x4*)(CA + p * 64 + q * 16); const LAS f32x4* cb = (const LAS f32x4*)(CB + p * 64 + q * 16);
            v4u o;
#pragma unroll
            for (int hh = 0; hh < 2; ++hh) {
                const v4u xv = x[2 * p + hh]; const f32x4 a0 = ca[2 * hh], a1 = ca[2 * hh + 1], b0 = cb[2 * hh], b1 = cb[2 * hh + 1];
                const unsigned w0 = pk4_fp8(clampf_(bflo(xv.x) * rstd * a0.x + b0.x, 448.f), clampf_(bfhi(xv.x) * rstd * a0.y + b0.y, 448.f), clampf_(bflo(xv.y) * rstd * a0.z + b0.z, 448.f), clampf_(bfhi(xv.y) * rstd * a0.w + b0.w, 448.f));
                const unsigned w1 = pk4_fp8(clampf_(bflo(xv.z) * rstd * a1.x + b1.x, 448.f), clampf_(bfhi(xv.z) * rstd * a1.y + b1.y, 448.f), clampf_(bflo(xv.w) * rstd * a1.z + b1.z, 448.f), clampf_(bfhi(xv.w) * rstd * a1.w + b1.w, 448.f));
                if (hh == 0) { o.x = w0; o.y = w1; } else { o.z = w0; o.w = w1; }
            }
            *(v4u*)(hrow + p * 64) = o;
        }
    }
    __syncthreads();
}

__device__ __forceinline__ void topk_phase(Frame& F, int layer) {
    LAS unsigned* vals = (LAS unsigned*)F.lds;
    LAS unsigned* hist = vals + 4096;
    LAS unsigned* wsum = hist + 256;
    LAS unsigned* sel = wsum + 16;
    const bool need_ctx = layer < DEPTH - 1;
    const int nunits = need_ctx ? 256 : 128;
    const float* AFFT = (const float*)(F.ws + WS_AFFT);
    int* INV = (int*)(F.ws + WS_INV); int* SRC = (int*)(F.ws + WS_SRC);
    for (int u = blockIdx.x; u < nunits; u += F.G) {
        const bool isctx = u >= 128; const int be = u & 127, b = be >> 4, e = be & 15;
        const int n = isctx ? 256 : 4096, cap = isctx ? CAP_C : CAP_L;
        const float* src = isctx ? AFFT + (size_t)NLAT * 16 + (size_t)be * 256 : AFFT + (size_t)be * 4096;
        const int per = isctx ? 1 : 8; const bool act = isctx ? (F.tid < 256) : true;
        unsigned mv[8];
#pragma unroll
        for (int j = 0; j < 8; ++j) { mv[j] = 0u; if (act && j < per) { mv[j] = __builtin_bit_cast(unsigned, src[F.tid * per + j]); vals[F.tid * per + j] = mv[j]; } }
        __syncthreads();
        unsigned prefix = 0u, pmask = 0u; int need = cap;
        for (int pass = 0; pass < 4; ++pass) {
            const int shift = 24 - 8 * pass;
            if (F.tid < 256) hist[F.tid] = 0u;
            __syncthreads();
            for (int i = F.tid; i < n; i += NT) { const unsigned v = vals[i]; if ((v & pmask) == prefix) __hip_atomic_fetch_add(&hist[(v >> shift) & 255u], 1u, __ATOMIC_RELAXED, __HIP_MEMORY_SCOPE_WORKGROUP); }
            __syncthreads();
            if (F.wave == 0) {
                const unsigned c0 = hist[4 * F.lane], c1 = hist[4 * F.lane + 1], c2 = hist[4 * F.lane + 2], c3 = hist[4 * F.lane + 3];
                const unsigned sl = c0 + c1 + c2 + c3; unsigned incl = sl;
#pragma unroll
                for (int o = 1; o < 64; o <<= 1) { const unsigned t = __shfl_down(incl, o); if (F.lane + o < 64) incl += t; }
                const unsigned ab3 = incl - sl, ab2 = ab3 + c3, ab1 = ab2 + c2, ab0 = ab1 + c1;
                const unsigned nd = (unsigned)need;
                if (ab3 < nd && ab3 + c3 >= nd) { sel[0] = 4u * F.lane + 3u; sel[1] = nd - ab3; }
                if (ab2 < nd && ab2 + c2 >= nd) { sel[0] = 4u * F.lane + 2u; sel[1] = nd - ab2; }
                if (ab1 < nd && ab1 + c1 >= nd) { sel[0] = 4u * F.lane + 1u; sel[1] = nd - ab1; }
                if (ab0 < nd && ab0 + c0 >= nd) { sel[0] = 4u * F.lane; sel[1] = nd - ab0; }
            }
            __syncthreads();
            prefix |= sel[0] << shift; pmask |= 255u << shift; need = (int)sel[1];
            __syncthreads();
        }
        const unsigned T = prefix;
        unsigned cg = 0u, ce = 0u;
#pragma unroll
        for (int j = 0; j < 8; ++j) if (act && j < per) { cg += (mv[j] > T) ? 1u : 0u; ce += (mv[j] == T) ? 1u : 0u; }
        unsigned pk = cg | (ce << 16), incl = pk;
#pragma unroll
        for (int o = 1; o < 64; o <<= 1) { const unsigned t = __shfl_up(incl, o); if (F.lane >= o) incl += t; }
        if (F.lane == 63) wsum[F.wave] = incl;
        __syncthreads();
        unsigned base = 0u;
        for (int w = 0; w < F.wave; ++w) base += wsum[w];
        unsigned excl = base + incl - pk;
        unsigned g0 = excl & 0xffffu, e0 = excl >> 16;
        if (act) {
#pragma unroll
            for (int j = 0; j < 8; ++j) if (j < per) {
                const int t = F.tid * per + j; const bool gt = mv[j] > T, eq = mv[j] == T;
                const bool s = gt || (eq && (int)e0 < need);
                const int slot = (int)g0 + ((int)e0 < need ? (int)e0 : need);
                const int hrow = isctx ? NLAT + b * 256 + t : b * 4096 + t;
                const int gi = isctx ? BATCH * CAP_L + b * CAP_C + slot : b * CAP_L + slot;
                INV[(isctx ? (size_t)NLAT * 16 + (size_t)be * 256 : (size_t)be * 4096) + t] = s ? gi : -1;
                if (s) SRC[e * EROWS + gi] = hrow;
                g0 += gt ? 1u : 0u; e0 += eq ? 1u : 0u;
            }
        }
        __syncthreads();
    }
}

template <int W> __device__ __forceinline__ void store_bf16(bf16* p, const float (&v)[W]) {
    if constexpr (W == 4) { v2u w; w.x = pk2(v[0], v[1]); w.y = pk2(v[2], v[3]); *(v2u*)p = w; }
    else { v4u w; w.x = pk2(v[0], v[1]); w.y = pk2(v[2], v[3]); w.z = pk2(v[4], v[5]); w.w = pk2(v[6], v[7]); *(v4u*)p = w; }
}
struct EpiInEven {
    static constexpr int GROUPS = 1;
    bf16* Z; const float* cosa; const float* sina;
    template <int W> __device__ __forceinline__ void chunk(int row, int col, const float (&v)[W]) const {
        float o[W];
        if (col < 128 || (col >= 256 && col < 768)) {
            const float qs = col >= 256 ? QSCALE_E : 1.0f;
            if (row < NLAT) { const int pos = row & 4095, i0 = (col & 63) >> 1;
                float cc[W / 2], ss[W / 2];
                if constexpr (W == 8) { const f32x4 c4 = *(const f32x4*)(cosa + pos * 32 + i0), s4 = *(const f32x4*)(sina + pos * 32 + i0); cc[0] = c4.x; cc[1] = c4.y; cc[2] = c4.z; cc[3] = c4.w; ss[0] = s4.x; ss[1] = s4.y; ss[2] = s4.z; ss[3] = s4.w; }
                else {
#pragma unroll
                    for (int p = 0; p < W / 2; ++p) { cc[p] = cosa[pos * 32 + i0 + p]; ss[p] = sina[pos * 32 + i0 + p]; } }
#pragma unroll
                for (int p = 0; p < W / 2; ++p) { const float c = cc[p] * qs, s = ss[p] * qs; o[2 * p] = v[2 * p] * c - v[2 * p + 1] * s; o[2 * p + 1] = v[2 * p + 1] * c + v[2 * p] * s; } }
            else {
#pragma unroll
                for (int j = 0; j < W; ++j) o[j] = v[j] * qs; }
        } else if (col >= 768) {
#pragma unroll
            for (int j = 0; j < W; j += 2) { const f32x2_ g = gelu_tanh2((f32x2_){v[j], v[j + 1]}); o[j] = g.x; o[j + 1] = g.y; }
        } else {
#pragma unroll
            for (int j = 0; j < W; ++j) o[j] = v[j];
        }
        store_bf16<W>(Z + (size_t)row * ZE + col, o);
    }
};
struct EpiInOdd {
    static constexpr int GROUPS = 1;
    bf16* Z; const float* cosc; const float* sinc; unsigned long long* rs;
    template <int W> __device__ __forceinline__ float ssq(const float (&v)[W]) const { float s = 0.f;
#pragma unroll
        for (int j = 0; j < W; ++j) s += v[j] * v[j]; return s; }
    __device__ __forceinline__ int stat_kind(int col) const { return col < 256 ? 1 : (col < 640 ? 2 : 0); }
    __device__ __forceinline__ void add_stat(int row, int kind, float s) const { atomicAdd(rs + (kind == 1 ? MT : 0) + row, (unsigned long long)(s * RS_SCALE)); }
    template <int W> __device__ __forceinline__ void chunk(int row, int col, const float (&v)[W]) const {
        float o[W];
        if (col >= 640 && col < 672 && row < NLAT) { const int pos = row & 4095, i0 = (col - 640) >> 1;
#pragma unroll
            for (int p = 0; p < W / 2; ++p) { const float c = cosc[pos * 16 + i0 + p], s = sinc[pos * 16 + i0 + p]; o[2 * p] = v[2 * p] * c - v[2 * p + 1] * s; o[2 * p + 1] = v[2 * p + 1] * c + v[2 * p] * s; }
        } else {
#pragma unroll
            for (int j = 0; j < W; ++j) o[j] = v[j];
        }
        store_bf16<W>(Z + (size_t)row * ZO + col, o);
    }
};
struct EpiUpQ {
    static constexpr int GROUPS = 1;
    bf16* Q; const float* cosc; const float* sinc; const unsigned long long* rs;
    template <int W> __device__ __forceinline__ void chunk(int row, int col, const float (&v)[W]) const {
        const float rstd = QSCALE_O * __builtin_amdgcn_rsqf((float)rs[row] * (RS_INV / 384.0f) + EPS);
        float o[W]; const int w = col % 96;
        if (w >= 64 && row < NLAT) { const int pos = row & 4095, i0 = (w - 64) >> 1;
#pragma unroll
            for (int p = 0; p < W / 2; ++p) { const float c = cosc[pos * 16 + i0 + p], s = sinc[pos * 16 + i0 + p]; o[2 * p] = (v[2 * p] * c - v[2 * p + 1] * s) * rstd; o[2 * p + 1] = (v[2 * p + 1] * c + v[2 * p] * s) * rstd; }
        } else {
#pragma unroll
            for (int j = 0; j < W; ++j) o[j] = v[j] * rstd;
        }
        store_bf16<W>(Q + (size_t)row * 768 + col, o);
    }
};
struct EpiUpKV {
    static constexpr int GROUPS = 1;
    bf16* KV; const unsigned long long* rs;
    template <int W> __device__ __forceinline__ void chunk(int row, int col, const float (&v)[W]) const {
        const float rstd = __builtin_amdgcn_rsqf((float)rs[MT + row] * (RS_INV / 256.0f) + EPS);
        float o[W];
#pragma unroll
        for (int j = 0; j < W; ++j) o[j] = v[j] * rstd;
        store_bf16<W>(KV + (size_t)row * 1024 + col, o);
    }
};
struct EpiOut {
    static constexpr int GROUPS = 2;
    bf16* X; const float* mod;
    static constexpr bool GATES = true;
    __device__ __forceinline__ void gates(int row0, int col, f32x4& g0, f32x4& g1) const { const float* g = mod + ((size_t)row_r(row0) * 6 + 2) * 1024 + col; g0 = *(const f32x4*)g; g1 = *(const f32x4*)(g + 4); }
    __device__ __forceinline__ void chunk_g(int row, int col, const float (&v)[8], const f32x4 g0, const f32x4 g1) const {
        bf16* x = X + (size_t)row * 1024 + col; const v4u xv = *(const v4u*)x; v4u o;
        o.x = pk2(bflo(xv.x) + g0.x * v[0], bfhi(xv.x) + g0.y * v[1]); o.y = pk2(bflo(xv.y) + g0.z * v[2], bfhi(xv.y) + g0.w * v[3]);
        o.z = pk2(bflo(xv.z) + g1.x * v[4], bfhi(xv.z) + g1.y * v[5]); o.w = pk2(bflo(xv.w) + g1.z * v[6], bfhi(xv.w) + g1.w * v[7]);
        *(v4u*)x = o;
    }
    template <int W> __device__ __forceinline__ void chunk(int row, int col, const float (&v)[W]) const {
        const float* g = mod + ((size_t)row_r(row) * 6 + 2) * 1024 + col;
        bf16* x = X + (size_t)row * 1024 + col;
        if constexpr (W == 8) {
            const f32x4 g0 = *(const f32x4*)g, g1 = *(const f32x4*)(g + 4); const v4u xv = *(const v4u*)x; v4u o;
            o.x = pk2(bflo(xv.x) + g0.x * v[0], bfhi(xv.x) + g0.y * v[1]); o.y = pk2(bflo(xv.y) + g0.z * v[2], bfhi(xv.y) + g0.w * v[3]);
            o.z = pk2(bflo(xv.z) + g1.x * v[4], bfhi(xv.z) + g1.y * v[5]); o.w = pk2(bflo(xv.w) + g1.z * v[6], bfhi(xv.w) + g1.w * v[7]);
            *(v4u*)x = o;
        } else {
#pragma unroll
            for (int j = 0; j < W; j += 4) { const f32x4 gv = *(const f32x4*)(g + j); const v2u xv = *(const v2u*)(x + j); v2u o;
                o.x = pk2(bflo(xv.x) + gv.x * v[j], bfhi(xv.x) + gv.y * v[j + 1]); o.y = pk2(bflo(xv.y) + gv.z * v[j + 2], bfhi(xv.y) + gv.w * v[j + 3]); *(v2u*)(x + j) = o; }
        }
    }
};
struct EpiNull {
    static constexpr int GROUPS = 1;
    template <int W> __device__ __forceinline__ void chunk(int, int, const float (&v)[W]) const {
#pragma unroll
        for (int j = 0; j < W; ++j) asm volatile("" :: "v"(v[j])); }
};
struct EpiF1 {
    static constexpr int GROUPS = 1;
    bf16* Gm;
    static constexpr bool PAIR = (FP8_F2 != 0);
    __device__ __forceinline__ v2u pack8(const float (&a)[8], const float (&b)[8]) const {
        float o[8];
#pragma unroll
        for (int j = 0; j < 8; j += 2) { constexpr int SIN = FP8_F1 ? (int)(F8_SA * F8_SW) : 1, SOUT = (int)F8_SG;
            const f32x2_ g = silu_gate2<SIN, SOUT>((f32x2_){a[j], a[j + 1]}, (f32x2_){b[j], b[j + 1]}); o[j] = clampf_(g.x, 448.f); o[j + 1] = clampf_(g.y, 448.f); }
        v2u w; w.x = pk4_fp8(o[0], o[1], o[2], o[3]); w.y = pk4_fp8(o[4], o[5], o[6], o[7]); return w;
    }
    __device__ __forceinline__ void pair_dual(int row, int f, int fq, const float (&a0)[8], const float (&b0)[8], const float (&a1)[8], const float (&b1)[8]) const {
        v2u x = pack8(a0, b0), y = pack8(a1, b1);
        asm volatile("s_nop 1\n\tv_permlane16_swap_b32 %0, %1" : "+v"(x.x), "+v"(y.x));
        asm volatile("s_nop 1\n\tv_permlane16_swap_b32 %0, %1" : "+v"(x.y), "+v"(y.y));
        const bool odd = fq & 1;
        *(v4u*)((unsigned char*)Gm + (size_t)(row + (odd ? 16 : 0)) * 1024 + f - (odd ? 8 : 0)) = (v4u){x.x, x.y, y.x, y.y};
    }
    template <int W> __device__ __forceinline__ void dual(int row, int f, const float (&a)[W], const float (&b)[W]) const {
        float o[W];
        constexpr float inv = FP8_F1 ? 1.0f / (F8_SA * F8_SW) : 1.0f;
#pragma unroll
        for (int j = 0; j < W; j += 2) { constexpr int SIN = FP8_F1 ? (int)(F8_SA * F8_SW) : 1, SOUT = FP8_F2 ? (int)F8_SG : 1;
            const f32x2_ g = silu_gate2<SIN, SOUT>((f32x2_){a[j], a[j + 1]}, (f32x2_){b[j], b[j + 1]}); o[j] = g.x; o[j + 1] = g.y; }
        if constexpr (FP8_F2) {
#pragma unroll
            for (int j = 0; j < W; ++j) o[j] = clampf_(o[j], 448.f);
            unsigned char* gp = (unsigned char*)Gm + (size_t)row * 1024 + f;
            if constexpr (W == 8) { v2u w; w.x = pk4_fp8(o[0], o[1], o[2], o[3]); w.y = pk4_fp8(o[4], o[5], o[6], o[7]); *(v2u*)gp = w; }
            else *(unsigned*)gp = pk4_fp8(o[0], o[1], o[2], o[3]);
        } else store_bf16<W>(Gm + (size_t)row * 1024 + f, o);
    }
};
struct EpiF2 {
    static constexpr int GROUPS = 1;
    bf16* Y;
    static constexpr bool PAIR = (FP8_Y != 0);
    __device__ __forceinline__ v2u pack8(const float (&v)[8]) const {
        constexpr float sc = (FP8_F2 ? 1.0f / (F8_SG * F8_SW) : 1.0f) * F8_SY;
        float o[8];
#pragma unroll
        for (int j = 0; j < 8; j += 2) { const f32x2_ t = (f32x2_){v[j], v[j + 1]} * sc; o[j] = clampf_(t.x, 448.f); o[j + 1] = clampf_(t.y, 448.f); }
        v2u w; w.x = pk4_fp8(o[0], o[1], o[2], o[3]); w.y = pk4_fp8(o[4], o[5], o[6], o[7]); return w;
    }
    __device__ __forceinline__ void pair(int row, int col, int fq, const float (&va)[8], const float (&vb)[8]) const {
        v2u a = pack8(va), b = pack8(vb);
        asm volatile("s_nop 1\n\tv_permlane16_swap_b32 %0, %1" : "+v"(a.x), "+v"(b.x));
        asm volatile("s_nop 1\n\tv_permlane16_swap_b32 %0, %1" : "+v"(a.y), "+v"(b.y));
        const bool odd = fq & 1;
        *(v4u*)((unsigned char*)Y + (size_t)(row + (odd ? 16 : 0)) * 1024 + col - (odd ? 8 : 0)) = (v4u){a.x, a.y, b.x, b.y};
    }
    template <int W> __device__ __forceinline__ void chunk(int row, int col, const float (&v)[W]) const {
        constexpr float sc = (FP8_F2 ? 1.0f / (F8_SG * F8_SW) : 1.0f) * (FP8_Y ? F8_SY : 1.0f);
        float o[W];
#pragma unroll
        for (int j = 0; j < W; j += 2) { const f32x2_ t = (f32x2_){v[j], v[j + 1]} * sc; o[j] = t.x; o[j + 1] = t.y; }
        if constexpr (FP8_Y) {
#pragma unroll
            for (int j = 0; j < W; ++j) o[j] = clampf_(o[j], 448.f);
            unsigned char* yp = (unsigned char*)Y + (size_t)row * 1024 + col;
            if constexpr (W == 8) { v2u w; w.x = pk4_fp8(o[0], o[1], o[2], o[3]); w.y = pk4_fp8(o[4], o[5], o[6], o[7]); *(v2u*)yp = w; }
            else *(unsigned*)yp = pk4_fp8(o[0], o[1], o[2], o[3]);
        } else store_bf16<W>(Y + (size_t)row * 1024 + col, o);
    }
};

namespace pg8 {
#define PG8_LAS __attribute__((address_space(3)))
typedef unsigned short bf16_t;
typedef short bf16x8 __attribute__((ext_vector_type(8)));
typedef float f32x4 __attribute__((ext_vector_type(4)));
typedef int v8i_t __attribute__((ext_vector_type(8)));
typedef int v4i_t __attribute__((ext_vector_type(4)));
constexpr int BM = 256, BK = 64, HALF = 128, HTB = HALF * BK * 2, STAGE_BYTES = 8 * HTB, NXCD = 8, WGM = 8;
template <int SW> __host__ __device__ __forceinline__ int lds_byte(int r, int c) { const int st = (r >> 4) * 2 + (c >> 5), rr = r & 15, cc = c & 31, ob = rr * 64 + cc * 2; return st * 1024 + (ob ^ (((ob >> 9) & 1) << SW)); }
template <int SW> __host__ __device__ __forceinline__ void stage_rc(int b, int& R, int& C) { const int st = b / 1024, sb = b % 1024, swz = sb ^ (((sb >> 9) & 1) << SW); R = (st >> 1) * 16 + swz / 64; C = (st & 1) * 32 + (swz % 64) / 2; }
__host__ __device__ __forceinline__ int perm32(int rho) { const int n = rho >> 4, i = rho & 15; return 8 * (i >> 2) + 4 * n + (i & 3); }
struct Unit { int pm, pn, brow; };
struct Gemm { const bf16_t* A; const bf16_t* Bt; int lda, ldb, K; const int* gather; };
struct StaticOrder {
    int nM, nN, nwg, G, c, bpe, lat_only;
    __device__ void init(int M, int N, int G_, int c_, int bpe_, int lat_only_ = 0) { nM = M / BM; nN = N / BM; nwg = nM * nN; G = G_; c = c_; bpe = bpe_; lat_only = lat_only_; }
    __device__ bool next(int i, Unit& u) const {
        const long L = (long)i * G + c; if (L >= nwg) return false;
        int wgid = (int)L; { const int q = nwg / NXCD, r = nwg % NXCD, xcd = wgid % NXCD, off = wgid / NXCD; wgid = (xcd < r ? xcd * (q + 1) : r * (q + 1) + (xcd - r) * q) + off; }
        const int nig = WGM * nN, gid = wgid / nig, fm = gid * WGM, gsz = (nM - fm) < WGM ? (nM - fm) : WGM;
        u.pm = fm + ((wgid % nig) % gsz); u.pn = (wgid % nig) / gsz; if (lat_only) u.pm = (u.pm >> 4) * 17 + (u.pm & 15); u.brow = u.pn * BM + (bpe ? (u.pm / 17) * bpe : 0); return true;
    }
};
template <class E, class = void> struct EpiGates { static constexpr bool value = false; };
template <class E> struct EpiGates<E, decltype((void)E::GATES, void())> { static constexpr bool value = E::GATES; };
template <class E, class = void> struct EpiPair { static constexpr bool value = false; };
template <class E> struct EpiPair<E, decltype((void)E::PAIR, void())> { static constexpr bool value = E::PAIR; };
template <bool DUAL, int STAT, class E>
__device__ __forceinline__ void run_epi(const E& e, const f32x4 (&acc)[2][2][4][2], const Unit& u, int wr, int wc, int fr, int fq) {
    if constexpr (EpiGates<E>::value && !DUAL && STAT == 0) {
        f32x4 g0[2], g1[2];
#pragma unroll
        for (int bj = 0; bj < 2; ++bj) e.gates(u.pm * BM, u.pn * BM + bj * HALF + wc * 32 + 8 * fq, g0[bj], g1[bj]);
#pragma unroll
        for (int ai = 0; ai < 2; ++ai)
#pragma unroll
            for (int m = 0; m < 4; ++m) {
#pragma unroll
                for (int bj = 0; bj < 2; ++bj) {
                    const float v[8] = {acc[ai][bj][m][0][0], acc[ai][bj][m][0][1], acc[ai][bj][m][0][2], acc[ai][bj][m][0][3], acc[ai][bj][m][1][0], acc[ai][bj][m][1][1], acc[ai][bj][m][1][2], acc[ai][bj][m][1][3]};
                    e.chunk_g(u.pm * BM + ai * HALF + wr * 64 + m * 16 + fr, u.pn * BM + bj * HALF + wc * 32 + 8 * fq, v, g0[bj], g1[bj]);
                }
                if ((m % E::GROUPS) == E::GROUPS - 1) asm volatile("" ::: "memory");
            }
        return;
    }
    if constexpr (EpiPair<E>::value && DUAL) {
#pragma unroll
        for (int ai = 0; ai < 2; ++ai)
#pragma unroll
            for (int m = 0; m < 4; m += 2) {
                const float a0[8] = {acc[ai][0][m][0][0], acc[ai][0][m][0][1], acc[ai][0][m][0][2], acc[ai][0][m][0][3], acc[ai][0][m][1][0], acc[ai][0][m][1][1], acc[ai][0][m][1][2], acc[ai][0][m][1][3]};
                const float b0[8] = {acc[ai][1][m][0][0], acc[ai][1][m][0][1], acc[ai][1][m][0][2], acc[ai][1][m][0][3], acc[ai][1][m][1][0], acc[ai][1][m][1][1], acc[ai][1][m][1][2], acc[ai][1][m][1][3]};
                const float a1[8] = {acc[ai][0][m + 1][0][0], acc[ai][0][m + 1][0][1], acc[ai][0][m + 1][0][2], acc[ai][0][m + 1][0][3], acc[ai][0][m + 1][1][0], acc[ai][0][m + 1][1][1], acc[ai][0][m + 1][1][2], acc[ai][0][m + 1][1][3]};
                const float b1[8] = {acc[ai][1][m + 1][0][0], acc[ai][1][m + 1][0][1], acc[ai][1][m + 1][0][2], acc[ai][1][m + 1][0][3], acc[ai][1][m + 1][1][0], acc[ai][1][m + 1][1][1], acc[ai][1][m + 1][1][2], acc[ai][1][m + 1][1][3]};
                e.pair_dual(u.pm * BM + ai * HALF + wr * 64 + m * 16 + fr, u.pn * HALF + wc * 32 + 8 * fq, fq, a0, b0, a1, b1);
            }
        return;
    }
    if constexpr (EpiPair<E>::value && !DUAL && STAT == 0) {
#pragma unroll
        for (int ai = 0; ai < 2; ++ai)
#pragma unroll
            for (int m = 0; m < 4; m += 2)
#pragma unroll
                for (int bj = 0; bj < 2; ++bj) {
                    const float va[8] = {acc[ai][bj][m][0][0], acc[ai][bj][m][0][1], acc[ai][bj][m][0][2], acc[ai][bj][m][0][3], acc[ai][bj][m][1][0], acc[ai][bj][m][1][1], acc[ai][bj][m][1][2], acc[ai][bj][m][1][3]};
                    const float vb[8] = {acc[ai][bj][m + 1][0][0], acc[ai][bj][m + 1][0][1], acc[ai][bj][m + 1][0][2], acc[ai][bj][m + 1][0][3], acc[ai][bj][m + 1][1][0], acc[ai][bj][m + 1][1][1], acc[ai][bj][m + 1][1][2], acc[ai][bj][m + 1][1][3]};
                    e.pair(u.pm * BM + ai * HALF + wr * 64 + m * 16 + fr, u.pn * BM + bj * HALF + wc * 32 + 8 * fq, fq, va, vb);
                }
        return;
    }
#pragma unroll
    for (int ai = 0; ai < 2; ++ai)
#pragma unroll
        for (int m = 0; m < 4; ++m) {
            const int row = u.pm * BM + ai * HALF + wr * 64 + m * 16 + fr;
            if constexpr (DUAL) {
                const float a[8] = {acc[ai][0][m][0][0], acc[ai][0][m][0][1], acc[ai][0][m][0][2], acc[ai][0][m][0][3], acc[ai][0][m][1][0], acc[ai][0][m][1][1], acc[ai][0][m][1][2], acc[ai][0][m][1][3]};
                const float b[8] = {acc[ai][1][m][0][0], acc[ai][1][m][0][1], acc[ai][1][m][0][2], acc[ai][1][m][0][3], acc[ai][1][m][1][0], acc[ai][1][m][1][1], acc[ai][1][m][1][2], acc[ai][1][m][1][3]};
                e.template dual<8>(row, u.pn * HALF + wc * 32 + 8 * fq, a, b);
            } else {
#pragma unroll
                for (int bj = 0; bj < 2; ++bj) {
                    const int col = u.pn * BM + bj * HALF + wc * 32 + 8 * fq;
                    const float v[8] = {acc[ai][bj][m][0][0], acc[ai][bj][m][0][1], acc[ai][bj][m][0][2], acc[ai][bj][m][0][3], acc[ai][bj][m][1][0], acc[ai][bj][m][1][1], acc[ai][bj][m][1][2], acc[ai][bj][m][1][3]};
                    if constexpr (STAT) { const int kind = e.stat_kind(u.pn * BM + bj * HALF + wc * 32);
                        if (kind) { float s = e.template ssq<8>(v); s += __shfl_xor(s, 16); s += __shfl_xor(s, 32); if (fq == 0) e.add_stat(row, kind, s); } }
                    e.template chunk<8>(row, col, v);
                }
            }
            if ((m % E::GROUPS) == E::GROUPS - 1) asm volatile("" ::: "memory");
        }
}
template <bool DUAL, int STAT, bool GATHER, bool FP8, class Epi, class Sched>
__device__ __forceinline__ void gemm_phase(PG8_LAS unsigned char* lds, const Gemm g, const Sched& S, const Epi& E, const int tid  ) {
    const int wid = __builtin_amdgcn_readfirstlane(tid >> 6), lane = tid & 63, wr = wid >> 2, wc = wid & 3, fr = lane & 15, fq = lane >> 4;
    const int K = g.K, nt = K / BK;
    int RA[2], CA[2]; unsigned voffA[2], voffB[2];
#pragma unroll
    for (int i = 0; i < 2; ++i) { int R, C; stage_rc<FP8 ? 4 : 5>(tid * 16 + i * 8192, R, C); RA[i] = R; CA[i] = C; const int Rb = (R & ~31) + perm32(R & 31); voffA[i] = (unsigned)(R * g.lda + C) * 2u; voffB[i] = (unsigned)(Rb * g.ldb + C) * 2u; }
    const size_t kstep = (size_t)(BK * 2);
    const size_t hstepB = (size_t)HALF * g.ldb * 2, hstepA = (size_t)HALF * g.lda * 2, tstepA = 2 * hstepA;
    const unsigned ldsw = (unsigned)wid * 1024u;
    const int aoff = FP8 ? lds_byte<4>(wr * 64 + fr, fq * 16) : lds_byte<5>(wr * 64 + fr, fq * 8), boff = FP8 ? lds_byte<4>(wc * 32 + fr, fq * 16) : lds_byte<5>(wc * 32 + fr, fq * 8);
#define PG8_SA(b, h) (((b) * 2 + (h)) * HTB)
#define PG8_SB(b, h) ((4 + (b) * 2 + (h)) * HTB)
#define PG8_STAGE(bufoff, gbase, voff) do { _Pragma("unroll") for (int _i = 0; _i < 2; ++_i) \
        __builtin_amdgcn_global_load_lds((const unsigned*)((const char*)(gbase) + (voff)[_i]), (PG8_LAS unsigned*)(lds + (bufoff) + ldsw + _i * 8192), 16, 0, 0); } while (0)
#define PG8_LD16(p_) (*(const PG8_LAS v4i_t*)(p_))
#define PG8_LDA(dst, b, h) do { _Pragma("unroll") for (int m = 0; m < 4; ++m) { \
        if constexpr (FP8) { const v4i_t lo_ = PG8_LD16(lds + PG8_SA(b, h) + aoff + m * 2048), hi_ = PG8_LD16(lds + PG8_SA(b, h) + ((aoff + m * 2048) ^ 16)); dst##8[m] = __builtin_shufflevector(lo_, hi_, 0, 1, 2, 3, 4, 5, 6, 7); } \
        else { _Pragma("unroll") for (int k = 0; k < 2; ++k) dst[m][k] = *(const PG8_LAS bf16x8*)(lds + PG8_SA(b, h) + aoff + m * 2048 + k * 1024); } } } while (0)
#define PG8_LDB(dst, b, h) do { _Pragma("unroll") for (int n = 0; n < 2; ++n) { \
        if constexpr (FP8) { const v4i_t lo_ = PG8_LD16(lds + PG8_SB(b, h) + boff + n * 2048), hi_ = PG8_LD16(lds + PG8_SB(b, h) + ((boff + n * 2048) ^ 16)); dst##8[n] = __builtin_shufflevector(lo_, hi_, 0, 1, 2, 3, 4, 5, 6, 7); } \
        else { _Pragma("unroll") for (int k = 0; k < 2; ++k) dst[n][k] = *(const PG8_LAS bf16x8*)(lds + PG8_SB(b, h) + boff + n * 2048 + k * 1024); } } } while (0)
#define PG8_MMA(ai, bj, At, Bt) do { __builtin_amdgcn_s_setprio(1); _Pragma("unroll") for (int m = 0; m < 4; ++m) _Pragma("unroll") for (int n = 0; n < 2; ++n) { \
        if constexpr (FP8) asm volatile("v_mfma_scale_f32_16x16x128_f8f6f4 %0, %1, %2, %0, %3, %3 op_sel_hi:[0,0,0]" : "+v"(acc[ai][bj][m][n]) : "v"(Bt##8[n]), "v"(At##8[m]), "v"(one_scale));   \
        else { _Pragma("unroll") for (int k = 0; k < 2; ++k) acc[ai][bj][m][n] = __builtin_amdgcn_mfma_f32_16x16x32_bf16(Bt[n][k], At[m][k], acc[ai][bj][m][n], 0, 0, 0); } } __builtin_amdgcn_s_setprio(0); } while (0)
#define PG8_WAIT_V(n) asm volatile("s_waitcnt vmcnt(" #n ")" ::: "memory")
#define PG8_WAIT_L(n) asm volatile("s_waitcnt lgkmcnt(" #n ")" ::: "memory")
#define PG8_BAR __builtin_amdgcn_s_barrier()
#define PG8_SCHED __builtin_amdgcn_sched_barrier(0)
#define PG8_AOFFS(dst, u) do { _Pragma("unroll") for (int _h = 0; _h < 2; ++_h) _Pragma("unroll") for (int _i = 0; _i < 2; ++_i) { const int _m = (u).pm * BM + _h * HALF + RA[_i]; \
        const int _r = g.gather ? g.gather[_m] : _m; dst[_h][_i] = (unsigned)(_r * g.lda + CA[_i]) * 2u; } } while (0)
    Unit cur, nxt; int ui = 0;
    if (!S.next(0, cur)) return;
    f32x4 acc[2][2][4][2];
#pragma unroll
    for (int a = 0; a < 2; ++a)
#pragma unroll
        for (int b = 0; b < 2; ++b)
#pragma unroll
            for (int m = 0; m < 4; ++m)
#pragma unroll
                for (int n = 0; n < 2; ++n) acc[a][b][m][n] = (f32x4){0.f, 0.f, 0.f, 0.f};
    bf16x8 At[FP8 ? 1 : 4][2], B0[FP8 ? 1 : 2][2], B1[FP8 ? 1 : 2][2];
    v8i_t At8[FP8 ? 4 : 1], B08[FP8 ? 2 : 1], B18[FP8 ? 2 : 1];
    int one_scale = 0x7f7f7f7f; asm volatile("" : "+v"(one_scale));
    unsigned curA[GATHER ? 2 : 1][2], nxtA[GATHER ? 2 : 1][2];
    const char* cA = (const char*)g.A; const char* nA = cA;
    if constexpr (GATHER) { PG8_AOFFS(curA, cur); } else { cA += (size_t)cur.pm * tstepA; }
#define PG8_STA(bufoff, base, offs, h, kof) do { if constexpr (GATHER) { PG8_STAGE(bufoff, (base) + (kof), (offs)[h]); } else { PG8_STAGE(bufoff, (base) + (kof) + (h) * hstepA, voffA); } } while (0)
    const char* cB = (const char*)g.Bt + (size_t)cur.brow * g.ldb * 2;
    PG8_STAGE(PG8_SB(0, 0), cB, voffB); PG8_STAGE(PG8_SB(0, 1), cB + hstepB, voffB); PG8_STA(PG8_SA(0, 0), cA, curA, 0, 0); PG8_STA(PG8_SA(0, 1), cA, curA, 1, 0);
    if (wr == 1) PG8_BAR;
    PG8_WAIT_V(2); PG8_BAR;
    PG8_STAGE(PG8_SB(1, 0), cB + kstep, voffB); PG8_STA(PG8_SA(1, 0), cA, curA, 0, kstep); PG8_STAGE(PG8_SB(1, 1), cB + hstepB + kstep, voffB);
    PG8_WAIT_V(6); PG8_BAR;
    for (;;) {
        const bool has_next = S.next(ui + 1, nxt);
        if constexpr (GATHER) {
            if (has_next) { PG8_AOFFS(nxtA, nxt); }
            else {
#pragma unroll
                for (int h = 0; h < 2; ++h)
#pragma unroll
                    for (int i = 0; i < 2; ++i) nxtA[h][i] = curA[h][i]; }
        } else nA = has_next ? (const char*)g.A + (size_t)nxt.pm * tstepA : cA;
        const char* nB = has_next ? (const char*)g.Bt + (size_t)nxt.brow * g.ldb * 2 : cB;
#pragma unroll 1
        for (int t = 0; t < nt; t += 2) {
            const bool last = (t == nt - 2);
            const size_t k1 = (size_t)(t + 1) * kstep, k2 = last ? 0 : (size_t)(t + 2) * kstep, k3 = k2 + kstep;
            const char* b2 = last ? nB : cB + (size_t)(t + 2) * kstep; const char* b3 = b2 + kstep;
            const char* a2 = last ? nA : cA;
            unsigned sA[GATHER ? 2 : 1][2];
            if constexpr (GATHER) {
#pragma unroll
                for (int h = 0; h < 2; ++h)
#pragma unroll
                    for (int i = 0; i < 2; ++i) sA[h][i] = last ? nxtA[h][i] : curA[h][i]; }
            PG8_LDB(B0, 0, 0); PG8_LDB(B1, 0, 1); PG8_SCHED; PG8_LDA(At, 0, 0); PG8_STA(PG8_SA(1, 1), cA, curA, 1, k1);
            PG8_WAIT_V(8); PG8_WAIT_L(0); PG8_BAR; PG8_MMA(0, 0, At, B0); PG8_MMA(0, 1, At, B1); PG8_BAR; PG8_SCHED;
            PG8_LDA(At, 0, 1); PG8_STAGE(PG8_SB(0, 0), b2, voffB); PG8_STAGE(PG8_SB(0, 1), b2 + hstepB, voffB); PG8_STA(PG8_SA(0, 0), a2, sA, 0, k2);
            PG8_WAIT_V(8); PG8_WAIT_L(0); PG8_BAR; PG8_MMA(1, 0, At, B0); PG8_MMA(1, 1, At, B1); PG8_BAR; PG8_SCHED;
            PG8_LDB(B0, 1, 0); PG8_LDB(B1, 1, 1); PG8_SCHED; PG8_LDA(At, 1, 0); PG8_STA(PG8_SA(0, 1), a2, sA, 1, k2);
            PG8_WAIT_V(8); PG8_WAIT_L(0); PG8_BAR; PG8_MMA(0, 0, At, B0); PG8_MMA(0, 1, At, B1); PG8_BAR; PG8_SCHED;
            PG8_LDA(At, 1, 1); PG8_STAGE(PG8_SB(1, 0), b3, voffB); PG8_STAGE(PG8_SB(1, 1), b3 + hstepB, voffB); PG8_STA(PG8_SA(1, 0), a2, sA, 0, k3);
            PG8_WAIT_V(8); PG8_WAIT_L(0); PG8_BAR; PG8_MMA(1, 0, At, B0); PG8_MMA(1, 1, At, B1); PG8_BAR; PG8_SCHED;
        }
        if (wr == 0) PG8_BAR;
        if constexpr (FP8) asm volatile("s_nop 15\n\ts_nop 15" ::: "memory");
        run_epi<DUAL, STAT>(E, acc, cur, wr, wc, fr, fq);
        if (!has_next) break;
#pragma unroll
        for (int a = 0; a < 2; ++a)
#pragma unroll
            for (int b = 0; b < 2; ++b)
#pragma unroll
                for (int m = 0; m < 4; ++m)
#pragma unroll
                    for (int n = 0; n < 2; ++n) acc[a][b][m][n] = (f32x4){0.f, 0.f, 0.f, 0.f};
        cur = nxt; cB = nB; cA = nA; ++ui;
        if constexpr (GATHER) {
#pragma unroll
            for (int h = 0; h < 2; ++h)
#pragma unroll
                for (int i = 0; i < 2; ++i) curA[h][i] = nxtA[h][i]; }
        if (wr == 1) PG8_BAR;
    }
    PG8_WAIT_V(0);
    PG8_BAR;
#undef PG8_SA
#undef PG8_SB
#undef PG8_STAGE
#undef PG8_LDA
#undef PG8_LDB
#undef PG8_MMA
#undef PG8_LD16
#undef PG8_WAIT_V
#undef PG8_WAIT_L
#undef PG8_BAR
#undef PG8_SCHED
#undef PG8_AOFFS
#undef PG8_STA
}
}

struct ARowsPlain { const bf16* A; int lda; __device__ __forceinline__ const bf16* operator()(int m) const { return A + (size_t)m * lda; } };
struct ARowsGather { const bf16* A; int lda; const int* src; __device__ __forceinline__ const bf16* operator()(int m) const { return A + (size_t)src[m] * lda; } };
template <bool DUAL, int STAT, class AF, class Epi>
__device__ __forceinline__ void simple_gemm(Frame& F, int M, int N, int K, const AF& af, const bf16* Bt, int ldb, int brow_per_expert  , const Epi& E) {
    LAS float* As = (LAS float*)F.lds;
    LAS float* Bs = As + 16 * 132;
    const int nM = M / 128, nN = N / 256, ntile = nM * nN;
    const int ty = F.tid >> 5, tx = F.tid & 31;
    for (int t = F.vcu; t < ntile; t += F.G) {
        const int pm = t / nN, pn = t % nN, m0 = pm * 128, n0 = pn * 256;
        const bf16* Bb = Bt + (size_t)(brow_per_expert ? (m0 / EROWS) * brow_per_expert : 0) * ldb + (size_t)n0 * ldb;
        float lo[8][4], hi[8][4];
#pragma unroll
        for (int r = 0; r < 8; ++r)
#pragma unroll
            for (int j = 0; j < 4; ++j) { lo[r][j] = 0.f; hi[r][j] = 0.f; }
        const bf16* arow = af(m0 + (F.tid >> 2));
        for (int k0 = 0; k0 < K; k0 += 16) {
            { const v2u w = *(const v2u*)(arow + k0 + (F.tid & 3) * 4); const int kk = (F.tid & 3) * 4, m = F.tid >> 2;
              As[(kk + 0) * 132 + m] = bflo(w.x); As[(kk + 1) * 132 + m] = bfhi(w.x); As[(kk + 2) * 132 + m] = bflo(w.y); As[(kk + 3) * 132 + m] = bfhi(w.y); }
            { const v4u w = *(const v4u*)(Bb + (size_t)(F.tid >> 1) * ldb + k0 + (F.tid & 1) * 8); const int kk = (F.tid & 1) * 8, n = F.tid >> 1;
              Bs[(kk + 0) * 260 + n] = bflo(w.x); Bs[(kk + 1) * 260 + n] = bfhi(w.x); Bs[(kk + 2) * 260 + n] = bflo(w.y); Bs[(kk + 3) * 260 + n] = bfhi(w.y);
              Bs[(kk + 4) * 260 + n] = bflo(w.z); Bs[(kk + 5) * 260 + n] = bfhi(w.z); Bs[(kk + 6) * 260 + n] = bflo(w.w); Bs[(kk + 7) * 260 + n] = bfhi(w.w); }
            __syncthreads();
#pragma unroll 2
            for (int kk = 0; kk < 16; ++kk) {
                const f32x4 a0 = *(const LAS f32x4*)(As + kk * 132 + ty * 8), a1 = *(const LAS f32x4*)(As + kk * 132 + ty * 8 + 4);
                const f32x4 b0 = *(const LAS f32x4*)(Bs + kk * 260 + tx * 4), b1 = *(const LAS f32x4*)(Bs + kk * 260 + 128 + tx * 4);
                const float a[8] = {a0.x, a0.y, a0.z, a0.w, a1.x, a1.y, a1.z, a1.w};
#pragma unroll
                for (int r = 0; r < 8; ++r) { lo[r][0] += a[r] * b0.x; lo[r][1] += a[r] * b0.y; lo[r][2] += a[r] * b0.z; lo[r][3] += a[r] * b0.w;
                                              hi[r][0] += a[r] * b1.x; hi[r][1] += a[r] * b1.y; hi[r][2] += a[r] * b1.z; hi[r][3] += a[r] * b1.w; }
            }
            __syncthreads();
        }
#pragma unroll
        for (int r = 0; r < 8; ++r) { const int row = m0 + ty * 8 + r;
            if constexpr (DUAL) E.template dual<4>(row, (n0 >> 1) + tx * 4, lo[r], hi[r]);
            else {
                if constexpr (STAT) { const int c0 = n0 + tx * 4, c1 = c0 + 128; const int k0 = E.stat_kind(c0), k1 = E.stat_kind(c1);
                    if (k0) E.add_stat(row, k0, E.template ssq<4>(lo[r])); if (k1) E.add_stat(row, k1, E.template ssq<4>(hi[r])); }
                E.template chunk<4>(row, n0 + tx * 4, lo[r]); E.template chunk<4>(row, n0 + 128 + tx * 4, hi[r]); }
        }
    }
}

template <int NCH> __device__ __forceinline__ float dot_chunks(const v4u* qp, const bf16* k, float acc) {
#pragma unroll
    for (int c = 0; c < NCH; ++c) { const v4u kv = *(const v4u*)(k + 8 * c); const v4u qv = qp[c];
        acc += bflo(qv.x) * bflo(kv.x) + bfhi(qv.x) * bfhi(kv.x) + bflo(qv.y) * bflo(kv.y) + bfhi(qv.y) * bfhi(kv.y)
             + bflo(qv.z) * bflo(kv.z) + bfhi(qv.z) * bfhi(kv.z) + bflo(qv.w) * bflo(kv.w) + bfhi(qv.w) * bfhi(kv.w); }
    return acc;
}
template <bool ODD>
__device__ __forceinline__ void simple_attn(Frame& F, int layer) {
    const int gw = F.vcu * NWAVES + F.wave, NGW = F.G * NWAVES;
    const bool need_ctx = layer < DEPTH - 1;
    const int nrows = need_ctx ? MT : NLAT;
    const bf16* Z = (const bf16*)(F.ws + WS_Z); const bf16* Q = (const bf16*)(F.ws + WS_Q); const bf16* KV = (const bf16*)(F.ws + WS_KV);
    bf16* OS = (bf16*)(F.ws + WS_H);
    for (int task = gw; task < nrows * 8; task += NGW) {
        const int row = task >> 3, h = task & 7, b = row_b(row);
        const bool lat = row < NLAT; const int pos = row & 4095;
        v4u qp[ODD ? 12 : 8];
        { const bf16* q = ODD ? Q + (size_t)row * 768 + h * 96 : Z + (size_t)row * ZE + 256 + h * 64;
#pragma unroll
          for (int c = 0; c < (ODD ? 12 : 8); ++c) qp[c] = *(const v4u*)(q + 8 * c); }
        int nlatk, lat0;
        if (!lat) { nlatk = 0; lat0 = 0; }
        else if (ODD) { nlatk = 4096; lat0 = 0; }
        else { lat0 = pos - 128 < 0 ? 0 : pos - 128; const int hi_ = pos + 128 > 4095 ? 4095 : pos + 128; nlatk = hi_ - lat0 + 1; }
        const int nk = nlatk + 256;
        const int kvh = h >> 2;
        float m_l = -INFINITY, l_l = 0.f;
        for (int j = F.lane; j < nk; j += 64) {
            const int krow = j < nlatk ? b * 4096 + lat0 + j : NLAT + b * 256 + (j - nlatk);
            float s;
            if (ODD) { s = dot_chunks<8>(qp, KV + (size_t)krow * 1024 + h * 128, 0.f); s = dot_chunks<4>(qp + 8, Z + (size_t)krow * ZO + 640, s); }
            else s = dot_chunks<8>(qp, Z + (size_t)krow * ZE + kvh * 64, 0.f);
            if (s > m_l) { l_l = l_l * exp2f(m_l - s) + 1.0f; m_l = s; } else l_l += exp2f(s - m_l);
        }
        float mx = wave_max(m_l);
        float l = wave_sum(l_l * exp2f(m_l - mx));
        if (!ODD) { const float sk = inp(F, IN_EVSINK)[(layer >> 1) * 8 + h] * LOG2E_; const float m2 = fmaxf(mx, sk); l = l * exp2f(mx - m2) + exp2f(sk - m2); mx = m2; }
        const float rl = 1.0f / l;
        float acc[64];
#pragma unroll
        for (int d = 0; d < 64; ++d) acc[d] = 0.f;
        for (int j = F.lane; j < nk; j += 64) {
            const int krow = j < nlatk ? b * 4096 + lat0 + j : NLAT + b * 256 + (j - nlatk);
            float s; const bf16* vp;
            if (ODD) { s = dot_chunks<8>(qp, KV + (size_t)krow * 1024 + h * 128, 0.f); s = dot_chunks<4>(qp + 8, Z + (size_t)krow * ZO + 640, s); vp = KV + (size_t)krow * 1024 + h * 128 + 64; }
            else { s = dot_chunks<8>(qp, Z + (size_t)krow * ZE + kvh * 64, 0.f); vp = Z + (size_t)krow * ZE + 128 + kvh * 64; }
            const float p = exp2f(s - mx) * rl;
#pragma unroll
            for (int c = 0; c < 8; ++c) { const v4u vv = *(const v4u*)(vp + 8 * c);
                acc[8 * c + 0] += p * bflo(vv.x); acc[8 * c + 1] += p * bfhi(vv.x); acc[8 * c + 2] += p * bflo(vv.y); acc[8 * c + 3] += p * bfhi(vv.y);
                acc[8 * c + 4] += p * bflo(vv.z); acc[8 * c + 5] += p * bfhi(vv.z); acc[8 * c + 6] += p * bflo(vv.w); acc[8 * c + 7] += p * bfhi(vv.w); }
        }
        LAS float* red = (LAS float*)(F.lds + F.wave * 16640) + F.lane * 65;
#pragma unroll
        for (int d = 0; d < 64; ++d) red[d] = acc[d];
        LDS_WAIT(); asm volatile("" ::: "memory");
        const LAS float* rd = (const LAS float*)(F.lds + F.wave * 16640) + F.lane;
        float mine = 0.f;
#pragma unroll 8
        for (int l = 0; l < 64; ++l) mine += rd[l * 65];
        LDS_WAIT(); asm volatile("" ::: "memory");
        OS[(size_t)row * 1024 + h * 64 + F.lane] = (bf16)f2bf(mine);
    }
}


namespace att {
#define ATT_LAS __attribute__((address_space(3)))
typedef short bf16x8 __attribute__((ext_vector_type(8)));
typedef short s16x4 __attribute__((ext_vector_type(4)));
typedef float f32x16 __attribute__((ext_vector_type(16)));
typedef float f32x2_t __attribute__((ext_vector_type(2)));
typedef __bf16 bf16x2_t __attribute__((ext_vector_type(2)));
__device__ __forceinline__ int crow(int r, int hi) { return (r & 3) + 8 * (r >> 2) + 4 * hi; }
__device__ __forceinline__ unsigned cvtpk(float lo, float hi) { f32x2_t v = {lo, hi}; bf16x2_t b = __builtin_convertvector(v, bf16x2_t); return __builtin_bit_cast(unsigned, b); }
__device__ __forceinline__ s16x4 vtr(const ATT_LAS char* p) { return __builtin_bit_cast(s16x4, __builtin_amdgcn_ds_read_tr16_b64_v4i16((ATT_LAS s16x4*)p)); }
__device__ __forceinline__ void glds16(const void* sbase, unsigned voff, unsigned lds_dst) { unsigned keep;
    asm volatile("s_mov_b32 %0, m0\n\ts_mov_b32 m0, %3\n\ts_nop 0\n\tglobal_load_lds_dwordx4 %1, %2\n\ts_mov_b32 m0, %0" : "=&s"(keep) : "v"(voff), "s"(sbase), "s"(lds_dst) : "memory"); }
template <int DK, int TK> struct Geo {
    static constexpr int NCH = DK / 8, KB = NCH * TK * 16, VB = TK * 128, SLOT = KB + VB, NKP = NCH * (TK / 64), NVP = TK / 8, NPW = (NKP + NVP) / 8;
    static_assert((NKP + NVP) % 8 == 0, "pieces must divide over 8 waves");
};
struct Piece { const char* base; unsigned pitch, loff, voff; };
template <int DK, int TK> using PieceArr = Piece[Geo<DK, TK>::NPW];
struct Src { const char* kb0; unsigned kp0; const char* kb1; unsigned kp1; const char* vb; unsigned vp; };
template <int DK, int TK> __device__ __forceinline__ void make_pieces(PieceArr<DK, TK>& pc, const Src& s, int wave, int lane) {
    typedef Geo<DK, TK> G;
#pragma unroll
    for (int i = 0; i < G::NPW; ++i) {
        const int p = wave * G::NPW + i;
        if (p < G::NKP) { const int ch = p % G::NCH, kh = p / G::NCH; const bool a = ch < 8;
            pc[i].base = a ? s.kb0 + 16 * ch : s.kb1 + 16 * (ch - 8); pc[i].pitch = a ? s.kp0 : s.kp1; pc[i].loff = (unsigned)(ch * TK * 16 + kh * 1024);
            pc[i].voff = (unsigned)(kh * 64 + lane) * pc[i].pitch; }
        else { const int v = p - G::NKP, dh = v / (TK / 16), kg = v % (TK / 16);
            pc[i].base = s.vb + dh * 64; pc[i].pitch = s.vp; pc[i].loff = (unsigned)(G::KB + dh * TK * 64 + kg * 1024);
            pc[i].voff = (unsigned)(kg * 16 + (lane >> 2)) * s.vp + (unsigned)(lane & 3) * 16u; }
    }
}
__device__ __forceinline__ float rowmax32(const f32x16& p0, const f32x16& p1) {
    float ta = __builtin_fmaxf(__builtin_fmaxf(p0[0], p0[1]), p1[0]), tb = __builtin_fmaxf(__builtin_fmaxf(p0[2], p0[3]), p1[1]);
    ta = __builtin_fmaxf(__builtin_fmaxf(ta, p1[2]), p1[3]);
#pragma unroll
    for (int r = 4; r < 16; r += 4) { ta = __builtin_fmaxf(__builtin_fmaxf(ta, p0[r]), p0[r + 1]); tb = __builtin_fmaxf(__builtin_fmaxf(tb, p0[r + 2]), p0[r + 3]);
                                       ta = __builtin_fmaxf(__builtin_fmaxf(ta, p1[r]), p1[r + 1]); tb = __builtin_fmaxf(__builtin_fmaxf(tb, p1[r + 2]), p1[r + 3]); }
    const float m = __builtin_fmaxf(ta, tb);
    auto rr = __builtin_amdgcn_permlane32_swap(__builtin_bit_cast(unsigned, m), __builtin_bit_cast(unsigned, m), false, false);
    return __builtin_bit_cast(float, rr[0]);
}
__host__ __device__ constexpr int att_cum(int ngrp, int gi) {
    if (ngrp == 12) { int c = 0; for (int i = 0; i < gi; ++i) c += (i >= 8 || (i & 1)) ? 3 : 2; return c; }
    return gi * 32 / ngrp;
}
template <int DK, int TK, bool MASKED, class TileFn>
__device__ __forceinline__ void attn_unit(ATT_LAS unsigned char* lds, int tid, const bf16* qrow, int ntiles, const TileFn& tf, int qi, bool has_sink, float sink_l2, bf16* orow, const PieceArr<DK, TK>& pc) {
    typedef Geo<DK, TK> G;
    constexpr int SPT = TK / 64, NQ = DK / 16, NS = ATT_CREF ? NQ : NQ + 1, NGRP = 2 * NS;
    constexpr float THR = 8.0f;
    const int lane = tid & 63, r32 = lane & 31, hi = lane >> 5;
    bf16x8 qr[NQ];
#pragma unroll
    for (int d0 = 0; d0 < NQ; ++d0) qr[d0] = *(const bf16x8*)(qrow + d0 * 16 + hi * 8);
#pragma unroll
    for (int d0 = 0; d0 < NQ; ++d0) asm volatile("" : "+v"(qr[d0]));
    f32x16 o[2];
#pragma unroll
    for (int r = 0; r < 16; ++r) { o[0][r] = 0.f; o[1][r] = 0.f; }
    const f32x16 zero16 = {0.f, 0.f, 0.f, 0.f, 0.f, 0.f, 0.f, 0.f, 0.f, 0.f, 0.f, 0.f, 0.f, 0.f, 0.f, 0.f};
    const bf16x8 kone = {(short)(hi ? 0 : 0x3F80), 0, 0, 0, 0, 0, 0, 0};
#define ATT_QEXT(mr_) ((bf16x8){(short)(hi ? 0u : (cvtpk(-(mr_), 0.f) & 0xffffu)), 0, 0, 0, 0, 0, 0, 0})
    float mref = has_sink ? ceilf(sink_l2) : 0.f, l = (has_sink && hi == 0) ? __builtin_amdgcn_exp2f(sink_l2 - mref) : 0.f, alpha = 1.0f;
    bf16x8 qext = ATT_QEXT(mref);
    f32x16 mneg;
#pragma unroll
    for (int r = 0; r < 16; ++r) mneg[r] = ATT_CREF ? -mref : 0.f;
    const unsigned lds0 = (unsigned)(size_t)lds;
#define ATT_ISSUE(T, slotb) do { const int kr_ = tf.krow0(T); _Pragma("unroll") for (int i_ = 0; i_ < G::NPW; ++i_) \
        glds16(pc[i_].base + (size_t)kr_ * pc[i_].pitch, pc[i_].voff, (unsigned)__builtin_amdgcn_readfirstlane(lds0 + (unsigned)(slotb) + pc[i_].loff)); } while (0)
    const ATT_LAS char* kb0 = (const ATT_LAS char*)lds + hi * TK * 16 + r32 * 16;
    const ATT_LAS char* vb0 = (const ATT_LAS char*)lds + G::KB + ((lane >> 4) & 1) * 32 + (lane & 3) * 8 + (4 * hi + ((lane & 15) >> 2)) * 64;
#define ATT_SB() __builtin_amdgcn_sched_barrier(0)
#define ATT_MF(A_, B_, C_) __builtin_amdgcn_mfma_f32_32x32x16_bf16(A_, B_, C_, 0, 0, 0)
#define ATT_KLD(d_, A_, C_) do { A_ = *(const ATT_LAS bf16x8*)(kb_ + (d_) * 2 * TK * 16); C_ = *(const ATT_LAS bf16x8*)(kb_ + (d_) * 2 * TK * 16 + 512); } while (0)
#define ATT_VLD(j_, L_, H_) do { L_ = vtr(vb + ((j_) & 1) * TK * 64 + ((j_) >> 1) * 1024); H_ = vtr(vb + ((j_) & 1) * TK * 64 + ((j_) >> 1) * 1024 + 512); } while (0)
    if (__builtin_amdgcn_readfirstlane(tid) >= 256) __builtin_amdgcn_s_setprio(1);
    ATT_ISSUE(0, 0);
    asm volatile("s_waitcnt vmcnt(0) lgkmcnt(0)\n\ts_barrier" ::: "memory");
    if (ntiles > 1) ATT_ISSUE(1, G::SLOT);
    f32x16 pA0, pA1, pB0, pB1;
    { const ATT_LAS char* kb_ = kb0;
#pragma unroll
      for (int d0 = 0; d0 < NQ; ++d0) { bf16x8 ka, kc; ATT_KLD(d0, ka, kc); if (d0 == 0) { pA0 = ATT_MF(ka, qr[0], mneg); pA1 = ATT_MF(kc, qr[0], mneg); } else { pA0 = ATT_MF(ka, qr[d0], pA0); pA1 = ATT_MF(kc, qr[d0], pA1); } }
      if constexpr (!ATT_CREF) { pA0 = ATT_MF(kone, qext, pA0); pA1 = ATT_MF(kone, qext, pA1); } }
    if (!has_sink) {
        const float dl = ceilf(rowmax32(pA0, pA1));
#pragma unroll
        for (int r = 0; r < 16; ++r) { pA0[r] -= dl; pA1[r] -= dl; }
        mref = dl; qext = ATT_QEXT(mref);
        if constexpr (ATT_CREF) {
#pragma unroll
            for (int r = 0; r < 16; ++r) mneg[r] = -dl; }
    }
    int sl_cur = 0;
    const int ng = ntiles * SPT;
#define ATT_PCE(X0_, X1_, e) ((e) < 16 ? X0_[(e) & 15] : X1_[(e) & 15])
#define ATT_EXP1(X0_, X1_, e) do { if ((e) < 16) X0_[(e) & 15] = __builtin_amdgcn_exp2f(X0_[(e) & 15]); else X1_[(e) & 15] = __builtin_amdgcn_exp2f(X1_[(e) & 15]); } while (0)
#define ATT_EXP2(X0_, X1_, e) do { if ((e) < 16) { X0_[(e) & 15] = __builtin_amdgcn_exp2f(X0_[(e) & 15]); X0_[((e) & 15) + 1] = __builtin_amdgcn_exp2f(X0_[((e) & 15) + 1]); } \
        else { X1_[(e) & 15] = __builtin_amdgcn_exp2f(X1_[(e) & 15]); X1_[((e) & 15) + 1] = __builtin_amdgcn_exp2f(X1_[((e) & 15) + 1]); } } while (0)
#define ATT_VADD(acc_, x_) asm volatile("v_add_f32 %0, %0, %1" : "+v"(acc_) : "v"(x_))
#define ATT_VMUL(x_, y_) asm volatile("v_mul_f32 %0, %0, %1" : "+v"(x_) : "v"(y_))
#define ATT_STEP(C0_, C1_, N0_, N1_, G_) do { \
        const int g_ = (G_), T_ = g_ / SPT, sb_ = g_ % SPT; \
        int sl_next = sl_cur; \
        if (sb_ == SPT - 1 && g_ + 1 < ng) {        \
            sl_next = (sl_cur == 2 * G::SLOT) ? 0 : sl_cur + G::SLOT; \
            asm volatile("s_waitcnt vmcnt(0) lgkmcnt(0)\n\ts_barrier" ::: "memory"); \
            if (T_ + 2 < ntiles) { const int sl2 = (sl_next == 2 * G::SLOT) ? 0 : sl_next + G::SLOT; ATT_ISSUE(T_ + 2, sl2); } \
        } \
        if constexpr (MASKED) { const int kind = tf.kind(T_, sb_); \
            if (kind == 1) { _Pragma("unroll") for (int r = 0; r < 16; ++r) { const int kj = crow(r, hi); if (kj < qi) C0_[r] = -INFINITY; if (kj + 32 < qi) C1_[r] = -INFINITY; } } \
            else if (kind == 2) { _Pragma("unroll") for (int r = 0; r < 16; ++r) { const int kj = crow(r, hi); if (kj > qi) C0_[r] = -INFINITY; if (kj + 32 > qi) C1_[r] = -INFINITY; } } } \
        const float tm_ = rowmax32(C0_, C1_); \
        const float dl_ = tm_ > THR ? ceilf(tm_) : 0.f; \
        const float alpha_old = alpha; alpha = __builtin_amdgcn_exp2f(-dl_); mref += dl_; qext = ATT_QEXT(mref); \
        if (__builtin_amdgcn_ballot_w64(alpha_old != 1.0f) != 0ull) { _Pragma("unroll") for (int r = 0; r < 16; ++r) { ATT_VMUL(o[0][r], alpha_old); ATT_VMUL(o[1][r], alpha_old); } }        \
        if (ATT_CREF && __builtin_amdgcn_ballot_w64(dl_ != 0.f) != 0ull) { _Pragma("unroll") for (int r = 0; r < 16; ++r) mneg[r] -= dl_; }        \
        float ls0 = 0.f, ls1 = 0.f, ls2 = 0.f, ls3 = 0.f; unsigned pw[4][4];        \
        { const ATT_LAS char* kb_ = kb0 + sl_next + ((g_ + 1 < ng) ? (sb_ + 1) % SPT : sb_) * 1024; \
          const ATT_LAS char* vb = vb0 + sl_cur + sb_ * 4096; \
          bf16x8 ka[3], kc[3]; s16x4 vl[4], vh[4]; \
          ATT_KLD(0, ka[0], kc[0]); ATT_KLD(1, ka[1], kc[1]); \
          ATT_SB(); \
          _Pragma("unroll") for (int d0 = 0; d0 < NS; ++d0) {         \
              if (d0 + 2 < NQ) ATT_KLD(d0 + 2, ka[(d0 + 2) % 3], kc[(d0 + 2) % 3]); \
              if (d0 == NS - 2) { ATT_VLD(0, vl[0], vh[0]); ATT_VLD(1, vl[1], vh[1]); } \
              if (d0 == NS - 1) { ATT_VLD(2, vl[2], vh[2]); } \
              if (d0 == 0) N0_ = ATT_MF(ka[0], qr[0], mneg); else if (d0 < NQ) N0_ = ATT_MF(ka[d0 % 3], qr[d0 < NQ ? d0 : 0], N0_); else N0_ = ATT_MF(kone, qext, N0_); \
              ATT_SB(); \
              _Pragma("unroll") for (int e_ = att_cum(NGRP, 2 * d0); e_ < att_cum(NGRP, 2 * d0 + 1); ++e_) { ATT_EXP1(C0_, C1_, e_); } \
              ATT_SB(); \
              if (d0 == 0) N1_ = ATT_MF(kc[0], qr[0], mneg); else if (d0 < NQ) N1_ = ATT_MF(kc[d0 % 3], qr[d0 < NQ ? d0 : 0], N1_); else N1_ = ATT_MF(kone, qext, N1_); \
              ATT_SB(); \
              _Pragma("unroll") for (int e_ = att_cum(NGRP, 2 * d0 + 1); e_ < att_cum(NGRP, 2 * d0 + 2); ++e_) { ATT_EXP1(C0_, C1_, e_); } \
              if (d0 >= NS - 4) { const int k_ = d0 - (NS - 4); pw[0][k_] = cvtpk(C0_[2 * k_], C0_[2 * k_ + 1]); }        \
              ATT_SB(); \
          } \
          _Pragma("unroll") for (int j = 0; j < 8; ++j) {              \
              const bf16x8 vf = {vl[j & 3][0], vl[j & 3][1], vl[j & 3][2], vl[j & 3][3], vh[j & 3][0], vh[j & 3][1], vh[j & 3][2], vh[j & 3][3]}; \
              if (j + 3 < 8) ATT_VLD(j + 3, vl[(j + 3) & 3], vh[(j + 3) & 3]); \
              o[j & 1] = ATT_MF(vf, __builtin_bit_cast(bf16x8, (v4u){pw[j >> 1][0], pw[j >> 1][1], pw[j >> 1][2], pw[j >> 1][3]}), o[j & 1]); \
              ATT_SB(); \
              if (j < 6) { const int q_ = 1 + (j >> 1), h_ = 2 * (j & 1);         \
                  pw[q_][h_] = cvtpk(ATT_PCE(C0_, C1_, 8 * q_ + 2 * h_), ATT_PCE(C0_, C1_, 8 * q_ + 2 * h_ + 1)); pw[q_][h_ + 1] = cvtpk(ATT_PCE(C0_, C1_, 8 * q_ + 2 * h_ + 2), ATT_PCE(C0_, C1_, 8 * q_ + 2 * h_ + 3)); } \
              ATT_VADD(ls0, ATT_PCE(C0_, C1_, 4 * j)); ATT_VADD(ls1, ATT_PCE(C0_, C1_, 4 * j + 1)); ATT_VADD(ls2, ATT_PCE(C0_, C1_, 4 * j + 2)); ATT_VADD(ls3, ATT_PCE(C0_, C1_, 4 * j + 3)); \
              ATT_SB(); \
          } \
        } \
        l = l * alpha_old + ((ls0 + ls1) + (ls2 + ls3)); sl_cur = sl_next; \
    } while (0)
    int g = 0;
#pragma unroll 1
    for (; g + 1 < ng; g += 2) { ATT_STEP(pA0, pA1, pB0, pB1, g); ATT_STEP(pB0, pB1, pA0, pA1, g + 1); }
    if (g < ng) ATT_STEP(pA0, pA1, pB0, pB1, g);
#undef ATT_STEP
#undef ATT_PCE
#undef ATT_EXP2
#undef ATT_EXP1
#undef ATT_VADD
#undef ATT_VMUL
#undef ATT_ISSUE
#undef ATT_SB
#undef ATT_MF
#undef ATT_KLD
#undef ATT_VLD
#undef ATT_QEXT
    l += __shfl_xor(l, 32);
    const float rl = __builtin_amdgcn_rcpf(l);
#pragma unroll
    for (int d0 = 0; d0 < 2; ++d0)
#pragma unroll
        for (int g4 = 0; g4 < 4; g4 += 2) {
            v2u a, b2;
            a.x = cvtpk(o[d0][4 * g4] * rl, o[d0][4 * g4 + 1] * rl); a.y = cvtpk(o[d0][4 * g4 + 2] * rl, o[d0][4 * g4 + 3] * rl);
            b2.x = cvtpk(o[d0][4 * g4 + 4] * rl, o[d0][4 * g4 + 5] * rl); b2.y = cvtpk(o[d0][4 * g4 + 6] * rl, o[d0][4 * g4 + 7] * rl);
            asm volatile("s_nop 1\n\tv_permlane32_swap_b32 %0, %1" : "+v"(a.x), "+v"(b2.x));
            asm volatile("s_nop 1\n\tv_permlane32_swap_b32 %0, %1" : "+v"(a.y), "+v"(b2.y));
            *(v4u*)(orow + 32 * d0 + 8 * g4 + 8 * hi) = (v4u){a.x, a.y, b2.x, b2.y}; }
    __builtin_amdgcn_s_setprio(0);
    asm volatile("s_waitcnt lgkmcnt(0)\n\ts_barrier" ::: "memory");
}
}

struct OddTiles {
    int b, t0;
    __device__ __forceinline__ int krow0(int T) const { const int t = T + t0; return t < 32 ? b * 4096 + t * 128 : NLAT + b * 256 + (t - 32) * 128; }
    __device__ __forceinline__ int kind(int, int) const { return 0; }
};
struct EvenTiles {
    int b, qb, jlo, nlat;
    __device__ __forceinline__ int krow0(int T) const { return T < nlat ? b * 4096 + qb * 64 - 128 + 64 * (jlo + T) : NLAT + b * 256 + 64 * (T - nlat); }
    __device__ __forceinline__ int kind(int T, int) const { if (T >= nlat) return 0; const int j = jlo + T; return j == 0 ? 1 : (j == 4 ? 2 : 0); }
};
constexpr float LOG2E = 1.4426950408889634f;
constexpr float QSC_E = 0.125f * LOG2E, QSC_O = 0.10206207261596577f * LOG2E;

__device__ __forceinline__ void mfma_attn_odd(Frame& F, int layer) {
    const bool need_ctx = layer < DEPTH - 1;
    const bf16* Z = (const bf16*)(F.ws + WS_Z); const bf16* Q = (const bf16*)(F.ws + WS_Q); const bf16* KV = (const bf16*)(F.ws + WS_KV);
    bf16* OS = (bf16*)(F.ws + WS_H);
    const int nunits = 1024 + (need_ctx ? 64 : 0);
    const int r32 = F.lane & 31;
    for (int u = F.vcu; u < nunits; u += F.G) {
        int b, h, row0, t0, nt;
        if (u < 1024) { b = u >> 7; h = (u >> 4) & 7; row0 = b * 4096 + (u & 15) * 256; t0 = 0; nt = 34; }
        else { const int c = u - 1024; b = c >> 3; h = c & 7; row0 = NLAT + b * 256; t0 = 32; nt = 2; }
        att::Src s{(const char*)(KV + h * 128), 2048u, (const char*)(Z + 640), (unsigned)(ZO * 2), (const char*)(KV + h * 128 + 64), 2048u};
        att::Piece pc[att::Geo<96, 128>::NPW]; att::make_pieces<96, 128>(pc, s, F.wave, F.lane);
        const int row = row0 + F.wave * 32 + r32;
        att::attn_unit<96, 128, false>(F.lds, F.tid, Q + (size_t)row * 768 + h * 96, nt, OddTiles{b, t0}, 0, false, 0.f, OS + (size_t)row * 1024 + h * 64, pc);
    }
}
__device__ __forceinline__ void mfma_attn_even(Frame& F, int layer) {
    const bool need_ctx = layer < DEPTH - 1;
    const bf16* Z = (const bf16*)(F.ws + WS_Z);
    bf16* OS = (bf16*)(F.ws + WS_H);
    const int nunits = 1024 + (need_ctx ? 64 : 0);
    const int r32 = F.lane & 31;
    for (int u = F.vcu; u < nunits; u += F.G) {
        int b, kvh, row0; EvenTiles tf;
        if (u < 1024) { b = u >> 7; kvh = (u >> 6) & 1; const int qb = u & 63; row0 = b * 4096 + qb * 64; const int jlo = qb < 2 ? 2 - qb : 0, jhi = qb > 61 ? 65 - qb : 4; tf = EvenTiles{b, qb, jlo, jhi - jlo + 1}; }
        else { const int c = u - 1024; b = c >> 3; kvh = (c >> 2) & 1; row0 = NLAT + b * 256 + (c & 3) * 64; tf = EvenTiles{b, 0, 0, 0}; }
        att::Src s{(const char*)(Z + kvh * 64), (unsigned)(ZE * 2), nullptr, 0u, (const char*)(Z + 128 + kvh * 64), (unsigned)(ZE * 2)};
        att::Piece pc[att::Geo<64, 64>::NPW]; att::make_pieces<64, 64>(pc, s, F.wave, F.lane);
        const int head = kvh * 4 + (F.wave >> 1), qi = (F.wave & 1) * 32 + r32, row = row0 + qi;
        const float sink = inp(F, IN_EVSINK)[(layer >> 1) * 8 + head] * LOG2E;
        att::attn_unit<64, 64, true>(F.lds, F.tid, Z + (size_t)row * ZE + 256 + head * 64, tf.nlat + 4, tf, qi, true, sink, OS + (size_t)row * 1024 + head * 64, pc);
    }
}


__device__ __forceinline__ void mfma_sgu(Frame& F, int layer) {
    const int i2 = layer >> 1;
    const bool need_ctx = layer < DEPTH - 1;
    const int nunits = need_ctx ? 272 : 256;
    const bf16* Z = (const bf16*)(F.ws + WS_Z); bf16* OS = (bf16*)(F.ws + WS_H);
    LAS unsigned char* vn = F.lds;
    LAS float* st = (LAS float*)(F.lds + 131072);
    LAS float* ngl = st + 256;
    const bf16* WsB = (const bf16*)(F.ws + WS_WSB) + (size_t)i2 * 4 * 128 * 128;
    const float* bs = inp(F, IN_EVSGUB) + i2 * 4 * 128;
    { const float* ng = inp(F, IN_EVSGUG) + i2 * 512; for (int i = F.tid; i < 512; i += NT) ngl[i] = ng[i]; }
    const int r32 = F.lane & 31, hi = F.lane >> 5;
    const bool remap = F.G == 256;
    for (int it = 0; ; ++it) {
        int u;
        if (remap) { if (it == 0) u = F.vcu; else if (it == 1 && need_ctx && F.vcu >= 64 && F.vcu < 80) u = 256 + F.vcu - 64; else break; }
        else { u = F.vcu + it * F.G; if (u >= nunits) break; }
        const int row0 = u < 256 ? u * 128 : NLAT + (u - 256) * 128;
        __syncthreads();
        {
            v4u w[16];
#pragma unroll
            for (int i = 0; i < 16; ++i) w[i] = *(const v4u*)(Z + (size_t)(row0 + F.wave * 16 + i) * ZE + 1280 + 8 * F.lane);
#pragma unroll
            for (int i = 0; i < 16; ++i) {
                const float x[8] = {bflo(w[i].x), bfhi(w[i].x), bflo(w[i].y), bfhi(w[i].y), bflo(w[i].z), bfhi(w[i].z), bflo(w[i].w), bfhi(w[i].w)};
                float s = 0.f;
#pragma unroll
                for (int j = 0; j < 8; ++j) s += x[j];
                const float mean = wave_sum(s) * (1.0f / 512.0f); float q = 0.f;
#pragma unroll
                for (int j = 0; j < 8; ++j) q += (x[j] - mean) * (x[j] - mean);
                const float var = wave_sum(q) * (1.0f / 512.0f);
                if (F.lane == 0) { st[2 * (F.wave * 16 + i)] = mean; st[2 * (F.wave * 16 + i) + 1] = 1.0f / sqrtf(var + EPS); }
            }
        }
        __syncthreads();
#pragma unroll
        for (int k = 0; k < 4; ++k) {
            const int it = F.tid + NT * k, q = it & 127, blk = it >> 7;
            const float mean = st[2 * q], rstd = st[2 * q + 1];
            const bf16* zp = Z + (size_t)(row0 + q) * ZE + 1280 + blk * 32;
            LAS unsigned char* dst = vn + blk * 8192 + (q >> 4) * 1024 + (q & 15) * 64;
#pragma unroll
            for (int c = 0; c < 4; ++c) { const v4u w = *(const v4u*)(zp + 8 * c);
                const f32x4 g0 = *(const LAS f32x4*)(ngl + blk * 32 + 8 * c), g1 = *(const LAS f32x4*)(ngl + blk * 32 + 8 * c + 4);
                v4u o; o.x = pk2((bflo(w.x) - mean) * rstd * g0.x, (bfhi(w.x) - mean) * rstd * g0.y); o.y = pk2((bflo(w.y) - mean) * rstd * g0.z, (bfhi(w.y) - mean) * rstd * g0.w);
                o.z = pk2((bflo(w.z) - mean) * rstd * g1.x, (bfhi(w.z) - mean) * rstd * g1.y); o.w = pk2((bflo(w.w) - mean) * rstd * g1.z, (bfhi(w.w) - mean) * rstd * g1.w);
                *(LAS v4u*)(dst + 16 * c) = o; }
        }
        __syncthreads();
        const int pt = F.wave & 3, p = pt * 32 + r32;
        const LAS char* ab = (const LAS char*)vn + (8 * hi + ((F.lane & 15) >> 2)) * 64 + ((F.lane >> 4) & 1) * 32 + (F.lane & 3) * 8;
#pragma unroll 1
        for (int gg = 0; gg < 2; ++gg) {
            const int g = (F.wave >> 2) * 2 + gg;
            att::bf16x8 bw[8];
#pragma unroll
            for (int ks = 0; ks < 8; ++ks) bw[ks] = *(const att::bf16x8*)(WsB + ((size_t)g * 128 + p) * 128 + 16 * ks + 8 * hi);
            const float bias = bs[g * 128 + p];
#pragma unroll 1
            for (int dd = 0; dd < 4; ++dd) {
                const int dt = g * 4 + dd;
                att::f32x16 acc;
#pragma unroll
                for (int r = 0; r < 16; ++r) acc[r] = 0.f;
#pragma unroll
                for (int ks = 0; ks < 8; ++ks) {
                    const att::s16x4 lo = att::vtr(ab + dt * 8192 + ks * 1024), hh = att::vtr(ab + dt * 8192 + ks * 1024 + 256);
                    const att::bf16x8 af = {lo[0], lo[1], lo[2], lo[3], hh[0], hh[1], hh[2], hh[3]};
                    acc = __builtin_amdgcn_mfma_f32_32x32x16_bf16(af, bw[ks], acc, 0, 0, 0);
                }
                const bf16* up = Z + (size_t)(row0 + p) * ZE + 768 + dt * 32 + 4 * hi;
                bf16* op = OS + (size_t)(row0 + p) * 1024 + 512 + dt * 32 + 4 * hi;
#pragma unroll
                for (int g4 = 0; g4 < 4; ++g4) { const v2u uw = *(const v2u*)(up + 8 * g4);
                    v2u o; o.x = pk2(bflo(uw.x) * (acc[4 * g4] + bias), bfhi(uw.x) * (acc[4 * g4 + 1] + bias)); o.y = pk2(bflo(uw.y) * (acc[4 * g4 + 2] + bias), bfhi(uw.y) * (acc[4 * g4 + 3] + bias));
                    *(v2u*)(op + 8 * g4) = o; }
            }
        }
    }
    __syncthreads();
}

__device__ __forceinline__ void simple_sgu(Frame& F, int layer) {
    const int i2 = layer >> 1;
    const bool need_ctx = layer < DEPTH - 1;
    const int nunits = need_ctx ? 272 : 256;
    const bf16* Z = (const bf16*)(F.ws + WS_Z); bf16* OS = (bf16*)(F.ws + WS_H);
    LAS float* vn = (LAS float*)F.lds;
    LAS float* st = vn + 128 * 128;
    const float* ng = inp(F, IN_EVSGUG) + i2 * 512;
    const float* Ws = inp(F, IN_EVSGUW) + (size_t)i2 * 4 * 128 * 128;
    const float* bs = inp(F, IN_EVSGUB) + i2 * 4 * 128;
    for (int u = F.vcu; u < nunits; u += F.G) {
        const int row0 = u < 256 ? u * 128 : NLAT + (u - 256) * 128;
        for (int r = F.wave; r < 128; r += NWAVES) {
            const v4u w = *(const v4u*)(Z + (size_t)(row0 + r) * ZE + 1280 + 8 * F.lane);
            const float x[8] = {bflo(w.x), bfhi(w.x), bflo(w.y), bfhi(w.y), bflo(w.z), bfhi(w.z), bflo(w.w), bfhi(w.w)};
            float s = 0.f;
#pragma unroll
            for (int j = 0; j < 8; ++j) s += x[j];
            const float mean = wave_sum(s) * (1.0f / 512.0f); float q = 0.f;
#pragma unroll
            for (int j = 0; j < 8; ++j) q += (x[j] - mean) * (x[j] - mean);
            const float var = wave_sum(q) * (1.0f / 512.0f);
            if (F.lane == 0) { st[2 * r] = mean; st[2 * r + 1] = 1.0f / sqrtf(var + EPS); }
        }
        __syncthreads();
        for (int g = 0; g < 4; ++g) {
            for (int i = F.tid; i < 128 * 128; i += NT) { const int q = i >> 7, d = i & 127; const float x = bf2f(Z[(size_t)(row0 + q) * ZE + 1280 + g * 128 + d]); vn[i] = (x - st[2 * q]) * st[2 * q + 1] * ng[g * 128 + d]; }
            __syncthreads();
            const int p = F.tid >> 2, d0 = (F.tid & 3) * 32;
            float acc[32];
#pragma unroll
            for (int j = 0; j < 32; ++j) acc[j] = 0.f;
            const float* wrow = Ws + ((size_t)g * 128 + p) * 128;
            for (int q = 0; q < 128; ++q) { const float w = wrow[q];
#pragma unroll
                for (int j = 0; j < 32; j += 4) { const f32x4 v = *(const LAS f32x4*)(vn + q * 128 + d0 + j); acc[j] += w * v.x; acc[j + 1] += w * v.y; acc[j + 2] += w * v.z; acc[j + 3] += w * v.w; } }
            const float bias = bs[g * 128 + p];
            const bf16* up = Z + (size_t)(row0 + p) * ZE + 768 + g * 128 + d0;
            bf16* op = OS + (size_t)(row0 + p) * 1024 + 512 + g * 128 + d0;
#pragma unroll
            for (int j = 0; j < 32; j += 8) { const v4u uw = *(const v4u*)(up + j);
                float o[8] = {bflo(uw.x) * (acc[j] + bias), bfhi(uw.x) * (acc[j + 1] + bias), bflo(uw.y) * (acc[j + 2] + bias), bfhi(uw.y) * (acc[j + 3] + bias),
                              bflo(uw.z) * (acc[j + 4] + bias), bfhi(uw.z) * (acc[j + 5] + bias), bflo(uw.w) * (acc[j + 6] + bias), bfhi(uw.w) * (acc[j + 7] + bias)};
                store_bf16<8>(op + j, o); }
            __syncthreads();
        }
    }
}
__device__ __forceinline__ void simple_conv(Frame& F, int layer) {
    const int i2 = layer >> 1;
    const bool need_ctx = layer < DEPTH - 1;
    const int nrows = need_ctx ? MT : NLAT;
    const bf16* Z = (const bf16*)(F.ws + WS_Z); bf16* OS = (bf16*)(F.ws + WS_H);
    const float* cw = inp(F, IN_ODCONV) + i2 * 3 * 512;
    const int nthr = F.G * NT, nruns_cap = nthr >> 6, R = (nrows + nruns_cap - 1) / nruns_cap, nruns = (nrows + R - 1) / R;
    for (int it = F.vcu * NT + F.tid; it < nruns * 64; it += nthr) {
        const int run = it >> 6, c0 = (it & 63) * 8, ra = run * R, rb = (ra + R < nrows) ? ra + R : nrows;
        float w0[8], w1[8], w2[8];
#pragma unroll
        for (int j = 0; j < 8; j += 4) { const f32x4 a = *(const f32x4*)(cw + c0 + j), b = *(const f32x4*)(cw + 512 + c0 + j), c = *(const f32x4*)(cw + 1024 + c0 + j);
            w0[j] = a.x; w0[j + 1] = a.y; w0[j + 2] = a.z; w0[j + 3] = a.w; w1[j] = b.x; w1[j + 1] = b.y; w1[j + 2] = b.z; w1[j + 3] = b.w; w2[j] = c.x; w2[j + 1] = c.y; w2[j + 2] = c.z; w2[j + 3] = c.w; }
#define CONV_U(dst_, row_) do { const bf16* zr_ = Z + (size_t)(row_) * ZO; const v4u cw_ = *(const v4u*)(zr_ + 672 + 512 + c0), hw_ = *(const v4u*)(zr_ + 672 + 1024 + c0); \
            dst_[0] = bflo(cw_.x) * bflo(hw_.x); dst_[1] = bfhi(cw_.x) * bfhi(hw_.x); dst_[2] = bflo(cw_.y) * bflo(hw_.y); dst_[3] = bfhi(cw_.y) * bfhi(hw_.y); \
            dst_[4] = bflo(cw_.z) * bflo(hw_.z); dst_[5] = bfhi(cw_.z) * bfhi(hw_.z); dst_[6] = bflo(cw_.w) * bflo(hw_.w); dst_[7] = bfhi(cw_.w) * bfhi(hw_.w); } while (0)
        float up[8], uc[8], un[8];
#pragma unroll
        for (int j = 0; j < 8; ++j) { up[j] = 0.f; uc[j] = 0.f; un[j] = 0.f; }
        if (ra > 0) CONV_U(up, ra - 1);
        CONV_U(uc, ra);
        for (int row = ra; row < rb; ++row) {
            const int seqpos = row < NLAT ? (row & 4095) : ((row - NLAT) & 255), seqlen = row < NLAT ? 4096 : 256;
            const bool hasn = seqpos + 1 < seqlen, hasp = seqpos > 0;
            if (row + 1 < nrows) CONV_U(un, row + 1);
            const v4u bw = *(const v4u*)(Z + (size_t)row * ZO + 672 + c0);
            float cv[8];
#pragma unroll
            for (int j = 0; j < 8; ++j) cv[j] = (hasp ? up[j] * w0[j] : 0.f) + uc[j] * w1[j] + (hasn ? un[j] * w2[j] : 0.f);
            float o[8] = {bflo(bw.x) * cv[0], bfhi(bw.x) * cv[1], bflo(bw.y) * cv[2], bfhi(bw.y) * cv[3], bflo(bw.z) * cv[4], bfhi(bw.z) * cv[5], bflo(bw.w) * cv[6], bfhi(bw.w) * cv[7]};
            store_bf16<8>(OS + (size_t)row * 1024 + 512 + c0, o);
#pragma unroll
            for (int j = 0; j < 8; ++j) { up[j] = uc[j]; uc[j] = un[j]; }
        }
#undef CONV_U
    }
}

struct Args { const float* in[26]; float* out; unsigned char* ws; int ph_lo, ph_hi; };
constexpr int NPHASE = 2 + DEPTH * 9;

__global__ void __launch_bounds__(NT, 2) mk_fwd(Args args) {
    extern __shared__ __attribute__((aligned(16))) unsigned char lds[];
    Frame F;
    F.lds = (LAS unsigned char*)lds;
    F.tid = threadIdx.x; F.lane = F.tid & 63; F.wave = __builtin_amdgcn_readfirstlane(F.tid >> 6);
    F.G = gridDim.x; { const int bx = blockIdx.x; F.vcu = (F.G % 8 == 0) ? (bx % 8) * (F.G / 8) + bx / 8 : bx; }
    F.out = args.out; F.ws = args.ws;
    for (int u = F.tid; u < (LDS_BYTES - LDSCTL_OFF) / 4; u += NT) ((LAS unsigned*)(F.lds + LDSCTL_OFF))[u] = 0u;
    __syncthreads();
    if (F.tid < 26) ((LAS unsigned long long*)(F.lds + LDSCTL_OFF))[F.tid] = (unsigned long long)args.in[F.tid];
    __syncthreads();
    volatile LAS unsigned* MISC = (volatile LAS unsigned*)(F.lds + MISC_OFF);
    XcdBarrier bar; bar.bar = (unsigned*)(F.ws + WS_CTL) + CW_BAR; bar.x = 0; bar.st = nullptr;
    if (!MK_PER_PHASE) bar = xcd_barrier_post((unsigned*)(F.ws + WS_CTL) + CW_BAR, MISC + 8);
    const int lo = args.ph_lo, hi = args.ph_hi;
#ifndef PH_MASK
#define PH_MASK 0x3ff
#endif
#define EN(b) ((PH_MASK >> (b)) & 1)
#define LAUNDER() do { int w_ = F.wave, c_ = F.vcu; asm volatile("" : "+v"(F.tid), "+v"(F.lane), "+v"(w_), "+v"(c_)); F.wave = __builtin_amdgcn_readfirstlane(w_); F.vcu = __builtin_amdgcn_readfirstlane(c_); } while (0)
#define REP(k) for (int rep_ = 0; rep_ < (((REPEAT_MASK >> (k)) & 1) ? 2 : 1); ++rep_, __syncthreads())
#define IN(k) (lo <= (k) && (k) < hi)
#define SEAM(k) do { if (IN(k) && IN((k) + 1)) { if (!MK_PER_PHASE) { xcd_barrier(bar); if ((REPEAT_MASK >> 14) & 1) xcd_barrier(bar); } } } while (0)

    if (EN(0) && IN(0)) { REP(0) { LAUNDER(); p0_prologue(F); } SEAM(0); }
#pragma unroll 1
    for (int layer = 0; layer < DEPTH; ++layer) {
        const int pb = 1 + 9 * layer, i2 = layer >> 1; const bool odd = layer & 1;
        const bool need_ctx = layer < DEPTH - 1;
        const int MR = need_ctx ? MT : NLAT;
        unsigned char* wsm = F.ws + WS_WSMALL;
        if (((REPEAT_MASK >> 15) & 1) && layer > 0 && EN(1) && IN(pb + 0)) { LAUNDER(); n1_phase(F, layer, true); __syncthreads(); }
        if (EN(1) && IN(pb + 0)) { for (int rep_ = 0; rep_ < ((((REPEAT_MASK >> 1) & 1) && layer == 0) ? 9 : 1); ++rep_, __syncthreads()) { LAUNDER(); n1_phase(F, layer); } SEAM(pb + 0); }
        if (EN(2) && IN(pb + 1)) {
            REP(2) {
            LAUNDER();
            if (!odd) { EpiInEven E{(bf16*)(F.ws + WS_Z), (const float*)(F.ws + WS_TAB), (const float*)(F.ws + WS_TAB) + 4096 * 32};
                if constexpr (MFMA_MASK & 1) { pg8::Gemm g{(const bf16*)(F.ws + WS_H), (const bf16*)(wsm + OFF_WINE + i2 * SZ_WINE), D, D, D, nullptr}; pg8::StaticOrder S; S.init(MT, ZE, F.G, (int)blockIdx.x, 0);
                    if (((REPEAT_MASK >> 17) & 1) && rep_ == 0) { EpiNull EN_; pg8::gemm_phase<false, 0, false, false>(F.lds, g, S, EN_, F.tid); }
                    else pg8::gemm_phase<false, 0, false, false>(F.lds, g, S, E, F.tid); }
                else simple_gemm<false, 0>(F, MT, ZE, D, ARowsPlain{(const bf16*)(F.ws + WS_H), D}, (const bf16*)(wsm + OFF_WINE + i2 * SZ_WINE), D, 0, E); }
            else { EpiInOdd E{(bf16*)(F.ws + WS_Z), (const float*)(F.ws + WS_TAB) + 2 * 4096 * 32, (const float*)(F.ws + WS_TAB) + 2 * 4096 * 32 + 4096 * 16, (unsigned long long*)(F.ws + WS_RS + (rep_ ? MiB : 0))};
                if constexpr (MFMA_MASK & 2) { pg8::Gemm g{(const bf16*)(F.ws + WS_H), (const bf16*)(wsm + OFF_WINO + i2 * SZ_WINO), D, D, D, nullptr}; pg8::StaticOrder S; S.init(MT, ZO, F.G, (int)blockIdx.x, 0);
                    pg8::gemm_phase<false, 1, false, false>(F.lds, g, S, E, F.tid); }
                else simple_gemm<false, 1>(F, MT, ZO, D, ARowsPlain{(const bf16*)(F.ws + WS_H), D}, (const bf16*)(wsm + OFF_WINO + i2 * SZ_WINO), D, 0, E); }
            }
            SEAM(pb + 1);
        }
        if (EN(3) && IN(pb + 2) && odd) {
            REP(3) {
            LAUNDER();
            EpiUpQ Eq{(bf16*)(F.ws + WS_Q), (const float*)(F.ws + WS_TAB) + 2 * 4096 * 32, (const float*)(F.ws + WS_TAB) + 2 * 4096 * 32 + 4096 * 16, (const unsigned long long*)(F.ws + WS_RS)};
            EpiUpKV Ek{(bf16*)(F.ws + WS_KV), (const unsigned long long*)(F.ws + WS_RS)};
            if constexpr (MFMA_MASK & 4) {
                { pg8::Gemm g{(const bf16*)(F.ws + WS_Z) + 256, (const bf16*)(wsm + OFF_WUQ + i2 * SZ_WUQ), ZO, 384, 384, nullptr}; pg8::StaticOrder S; S.init(MR, 768, F.G, (int)blockIdx.x, 0);
                  pg8::gemm_phase<false, 0, false, false>(F.lds, g, S, Eq, F.tid); }
                LAUNDER();
                { pg8::Gemm g{(const bf16*)(F.ws + WS_Z), (const bf16*)(wsm + OFF_WUKV + i2 * SZ_WUKV), ZO, 256, 256, nullptr}; pg8::StaticOrder S; S.init(MT, 1024, F.G, (int)blockIdx.x, 0);
                  pg8::gemm_phase<false, 0, false, false>(F.lds, g, S, Ek, F.tid); }
            } else {
                simple_gemm<false, 0>(F, MR, 768, 384, ARowsPlain{(const bf16*)(F.ws + WS_Z) + 256, ZO}, (const bf16*)(wsm + OFF_WUQ + i2 * SZ_WUQ), 384, 0, Eq);
                simple_gemm<false, 0>(F, MT, 1024, 256, ARowsPlain{(const bf16*)(F.ws + WS_Z), ZO}, (const bf16*)(wsm + OFF_WUKV + i2 * SZ_WUKV), 256, 0, Ek);
            }
            }
            SEAM(pb + 2);
        }
        if (EN(4) && IN(pb + 3)) {
            REP(4) {
            LAUNDER();
            if (!odd) { REP(10) { if constexpr (MFMA_ATT & 1) mfma_attn_even(F, layer); else simple_attn<false>(F, layer); } __syncthreads(); REP(11) { LAUNDER(); if constexpr (MFMA_SGU) mfma_sgu(F, layer); else simple_sgu(F, layer); } }
            else { REP(12) { if constexpr (MFMA_ATT & 2) mfma_attn_odd(F, layer); else simple_attn<true>(F, layer); } REP(13) { LAUNDER(); simple_conv(F, layer); } }
            }
            SEAM(pb + 3);
        }
        if (EN(5) && IN(pb + 4)) {
            LAUNDER();
            EpiOut E{(bf16*)(F.ws + WS_X), (const float*)(F.ws + WS_MODV) + (size_t)layer * 9 * 6144};
            if constexpr (MFMA_MASK & 8) { pg8::Gemm g{(const bf16*)(F.ws + WS_H), (const bf16*)(wsm + (odd ? OFF_WOUTO : OFF_WOUTE) + i2 * SZ_WOUT), D, D, D, nullptr}; pg8::StaticOrder S; S.init(MR, D, F.G, (int)blockIdx.x, 0);
                if constexpr ((REPEAT_MASK >> 5) & 1) { EpiOut E2{(bf16*)(F.ws + WS_X + 68 * MiB), E.mod}; pg8::gemm_phase<false, 0, false, false>(F.lds, g, S, E2, F.tid); __syncthreads(); LAUNDER(); }
                pg8::gemm_phase<false, 0, false, false>(F.lds, g, S, E, F.tid); CONV_TAIL(S, layer, 0, 36); if constexpr ((REPEAT_MASK >> 16) & 1) { __syncthreads(); CONV_TAIL(S, layer, 0, 36); }
}
            else simple_gemm<false, 0>(F, MR, D, D, ARowsPlain{(const bf16*)(F.ws + WS_H), D}, (const bf16*)(wsm + (odd ? OFF_WOUTO : OFF_WOUTE) + i2 * SZ_WOUT), D, 0, E);
            SEAM(pb + 4);
        }
        if (EN(6) && IN(pb + 5)) { REP(6) { LAUNDER(); if constexpr (FP8_F1 && N2_MFMA) n2_phase_mfma(F, layer); else n2_phase(F, layer); } SEAM(pb + 5); }
        if (EN(7) && IN(pb + 6)) { REP(7) { LAUNDER(); topk_phase(F, layer); } SEAM(pb + 6); }
        if (EN(8) && IN(pb + 7)) {
            REP(8) {
            LAUNDER();
            EpiF1 E{(bf16*)(F.ws + WS_Z)};
            constexpr int KU = FP8_F1 ? D / 2 : D;
            if constexpr (MFMA_MASK & 16) { pg8::Gemm g{(const bf16*)(F.ws + WS_H), (const bf16*)(F.ws + WS_W13 + (size_t)layer * 16 * (FP8_F1 ? SZ_W13 / 2 : SZ_W13)), KU, KU, KU, (const int*)(F.ws + WS_SRC)}; pg8::StaticOrder S; S.init(need_ctx ? GROWS : NE * BATCH * CAP_L, 2048, F.G, (int)blockIdx.x, 2048, need_ctx ? 0 : 1);
                pg8::gemm_phase<true, 0, true, FP8_F1 != 0>(F.lds, g, S, E, F.tid); CONV_TAIL(S, layer, 36, 45); }
            else simple_gemm<true, 0>(F, GROWS, 2048, D, ARowsGather{(const bf16*)(F.ws + WS_H), D, (const int*)(F.ws + WS_SRC)}, (const bf16*)(F.ws + WS_W13 + (size_t)layer * 16 * SZ_W13), D, 2048, E);
            }
            SEAM(pb + 7);
        }
        if (EN(9) && IN(pb + 8)) {
            REP(9) {
            LAUNDER();
            EpiF2 E{(bf16*)(F.ws + WS_Y)};
            constexpr int KU = FP8_F2 ? FF / 2 : FF;
            if constexpr (MFMA_MASK & 32) { pg8::Gemm g{(const bf16*)(F.ws + WS_Z), (const bf16*)(F.ws + WS_W2 + (size_t)layer * 16 * (FP8_F2 ? SZ_W2 / 2 : SZ_W2)), KU, KU, KU, nullptr}; pg8::StaticOrder S; S.init(need_ctx ? GROWS : NE * BATCH * CAP_L, D, F.G, (int)blockIdx.x, 1024, need_ctx ? 0 : 1);
                if (((REPEAT_MASK >> 17) & 1) && rep_ == 0) { EpiNull EN_; pg8::gemm_phase<false, 0, false, FP8_F2 != 0>(F.lds, g, S, EN_, F.tid); }
                else { pg8::gemm_phase<false, 0, false, FP8_F2 != 0>(F.lds, g, S, E, F.tid); CONV_TAIL(S, layer, 45, 64); } }
            else simple_gemm<false, 0>(F, GROWS, D, FF, ARowsPlain{(const bf16*)(F.ws + WS_Z), FF}, (const bf16*)(F.ws + WS_W2 + (size_t)layer * 16 * SZ_W2), FF, 1024, E);
            }
            SEAM(pb + 8);
        }
    }
    if (EN(1) && IN(NPHASE - 1)) { LAUNDER(); n1_phase(F, 4); }
#undef IN
#undef SEAM
}

extern "C" void kernel_launch(void* const* d_in, const int* in_sizes, int n_in, void* d_out, int out_size, void* d_ws, size_t ws_size, hipStream_t stream) {
    static int grid = 0;
    if (grid == 0) {
        if (n_in != 26 || out_size != NLAT * D || ws_size < WS_END) { fprintf(stderr, "kernel_launch: unexpected problem (n_in %d out %d ws %zu)\n", n_in, out_size, ws_size); grid = -1; return; }
        int dev = 0, cus = 0, per_cu = 0;
        if (hipGetDevice(&dev) != hipSuccess || hipDeviceGetAttribute(&cus, hipDeviceAttributeMultiprocessorCount, dev) != hipSuccess) { grid = -1; return; }
        if (hipFuncSetAttribute((const void*)mk_fwd, hipFuncAttributeMaxDynamicSharedMemorySize, LDS_BYTES) != hipSuccess) { grid = -1; return; }
        if (hipOccupancyMaxActiveBlocksPerMultiprocessor(&per_cu, (const void*)mk_fwd, NT, LDS_BYTES) != hipSuccess || per_cu < 1) fprintf(stderr, "kernel_launch: occupancy query says %d\n", per_cu);
        (void)hipGetLastError();
        grid = cus;
    }
    if (grid < 0) return;
    if (hipMemsetAsync((char*)d_ws + WS_CTL, 0, CTL_ZERO_BYTES, stream) != hipSuccess) return;
    Args a{};
    for (int i = 0; i < 26; ++i) a.in[i] = (const float*)d_in[i];
    a.out = (float*)d_out; a.ws = (unsigned char*)d_ws;
#if MK_PER_PHASE
    for (int p = 0; p < NPHASE; ++p) {
        if (p >= 1 && p < NPHASE - 1 && ((p - 1) % 9) == 2 && (((p - 1) / 9) & 1) == 0) continue;
        a.ph_lo = p; a.ph_hi = p + 1;
        hipLaunchKernelGGL(mk_fwd, dim3(grid), dim3(NT), LDS_BYTES, stream, a);
    }
#else
    a.ph_lo = 0; a.ph_hi = NPHASE;
    hipLaunchKernelGGL(mk_fwd, dim3(grid), dim3(NT), LDS_BYTES, stream, a);
#endif
}
```

```cpp
#include <hip/hip_runtime.h>
#include <cstdio>
#include <cstdint>

#ifndef MFMA_MASK
#define MFMA_MASK 0x3f
#endif
#ifndef MFMA_ATT
#define MFMA_ATT 3
#endif
#ifndef REPEAT_MASK
#define REPEAT_MASK 0
#endif
#ifndef MFMA_SGU
#define MFMA_SGU 1
#endif
#ifndef ATT_CREF
#define ATT_CREF 1
#endif
#ifndef N2_MFMA
#define N2_MFMA 1
#endif
#ifndef FP8_FFN
#define FP8_FFN 1
#endif
#ifndef FP8_F1
#define FP8_F1 FP8_FFN
#endif
#ifndef FP8_F2
#define FP8_F2 FP8_FFN
#endif
#ifndef FP8_Y
#define FP8_Y 1
#endif
#ifndef MK_PER_PHASE
#define MK_PER_PHASE 0
#endif

constexpr int D = 1024, BATCH = 8, SEQ = 4096, DEPTH = 4, CTXL = 256;
constexpr int NLAT = BATCH * SEQ, NCTX = BATCH * CTXL, MT = NLAT + NCTX;
constexpr int NE = 16, FF = 1024, CAP_L = 512, CAP_C = 32, EROWS = BATCH * (CAP_L + CAP_C);
constexpr int GROWS = NE * EROWS;
constexpr int ZE = 1792, ZO = 2304;
constexpr float EPS = 1e-6f;
constexpr float RS_SCALE = 16777216.0f, RS_INV = 1.0f / 16777216.0f;
constexpr float F8_SA = 16.f, F8_SW = 64.f, F8_SG = 8.f, F8_SY = 16.f;
constexpr float LOG2E_ = 1.4426950408889634f;
constexpr float QSCALE_E = 0.125f * LOG2E_, QSCALE_O = 0.10206207261596577f * LOG2E_;
constexpr int NWAVES = 8, NT = 512;

constexpr size_t MiB = 1u << 20;
constexpr size_t WS_CTL = 0, CTL_ZERO_BYTES = 1 * MiB;
constexpr size_t WS_MODV = 1 * MiB;
constexpr size_t WS_TAB = 2 * MiB;
constexpr size_t WS_WSB = 2 * MiB + 1536 * 1024;
constexpr size_t WS_AFF = 4 * MiB;
constexpr size_t WS_AFFT = 7 * MiB;
constexpr size_t WS_INV = 10 * MiB;
constexpr size_t WS_SRC = 13 * MiB;
constexpr size_t WS_RS = 14 * MiB;
constexpr size_t WS_WSMALL = 16 * MiB;
constexpr size_t OFF_WINE = 0, SZ_WINE = (size_t)ZE * D * 2;
constexpr size_t OFF_WOUTE = OFF_WINE + 2 * SZ_WINE, SZ_WOUT = (size_t)D * D * 2;
constexpr size_t OFF_WINO = OFF_WOUTE + 2 * SZ_WOUT, SZ_WINO = (size_t)ZO * D * 2;
constexpr size_t OFF_WUQ = OFF_WINO + 2 * SZ_WINO, SZ_WUQ = (size_t)768 * 384 * 2;
constexpr size_t OFF_WUKV = OFF_WUQ + 2 * SZ_WUQ, SZ_WUKV = (size_t)1024 * 256 * 2;
constexpr size_t OFF_WOUTO = OFF_WUKV + 2 * SZ_WUKV;
static_assert(OFF_WOUTO + 2 * SZ_WOUT <= 28 * MiB, "small weights");
constexpr size_t WS_W13 = 44 * MiB, SZ_W13 = (size_t)2048 * 1024 * 2;
constexpr size_t WS_W2 = 300 * MiB, SZ_W2 = (size_t)1024 * 1024 * 2;
constexpr size_t WS_X = 428 * MiB;
constexpr size_t WS_H = 564 * MiB;
constexpr size_t WS_Z = 632 * MiB;
constexpr size_t WS_Y = 785 * MiB;
constexpr size_t WS_Q = WS_Y, WS_KV = WS_Y + 52 * MiB;
constexpr size_t WS_END = 921 * MiB;
static_assert(WS_W13 + 64 * SZ_W13 <= WS_W2 && WS_W2 + 64 * SZ_W2 <= WS_X && WS_X + (size_t)MT * D * 4 <= WS_H && WS_H + (size_t)MT * D * 2 <= WS_Z, "ws map 1");
static_assert(WS_Z + (size_t)MT * ZO * 2 <= WS_Y && WS_Z + (size_t)GROWS * 1024 * 2 <= WS_Y && WS_Y + (size_t)GROWS * 1024 * 2 <= WS_END, "ws map 2");
static_assert(WS_Q + (size_t)MT * 768 * 2 <= WS_KV && WS_KV + (size_t)MT * 1024 * 2 <= WS_END, "ws map 3");
constexpr int CW_BAR = 4096;

constexpr int RING_BYTES = 131072;
constexpr int LDS_BYTES = 163840;
constexpr int LDSCTL_OFF = LDS_BYTES - 1024, MISC_OFF = LDSCTL_OFF + 320;

#define GAS __attribute__((address_space(1)))
#define LAS __attribute__((address_space(3)))
typedef unsigned short bf16;
typedef unsigned v4u __attribute__((ext_vector_type(4)));
typedef unsigned v2u __attribute__((ext_vector_type(2)));
typedef float f32x4 __attribute__((ext_vector_type(4)));
#define LDS_WAIT() asm volatile("s_waitcnt lgkmcnt(0)" ::: "memory")
#define VM_WAIT() asm volatile("s_waitcnt vmcnt(0)" ::: "memory")
__device__ __forceinline__ unsigned f2bf(float f) { unsigned u = __builtin_bit_cast(unsigned, f); return (u + 0x7fffu + ((u >> 16) & 1u)) >> 16; }
typedef float f32x2_ __attribute__((ext_vector_type(2)));
typedef __bf16 bf16x2_ __attribute__((ext_vector_type(2)));
__device__ __forceinline__ unsigned pk2(float lo, float hi) { f32x2_ v = {lo, hi}; bf16x2_ b = __builtin_convertvector(v, bf16x2_); return __builtin_bit_cast(unsigned, b); }
__device__ __forceinline__ float bflo(unsigned w) { return __builtin_bit_cast(float, w << 16); }
__device__ __forceinline__ float bfhi(unsigned w) { return __builtin_bit_cast(float, w & 0xffff0000u); }
__device__ __forceinline__ float bf2f(bf16 h) { return __builtin_bit_cast(float, (unsigned)h << 16); }
__device__ __forceinline__ unsigned pk4_fp8(float a, float b, float c, float d) { int w = 0; w = __builtin_amdgcn_cvt_pk_fp8_f32(a, b, w, false); w = __builtin_amdgcn_cvt_pk_fp8_f32(c, d, w, true); return (unsigned)w; }
__device__ __forceinline__ float clampf_(float x, float m) { return fminf(fmaxf(x, -m), m); }
template <bool W32> __device__ __forceinline__ void lane_swap(float v, float& r0, float& r1) {
    float a = v, b = v;
    if constexpr (W32) asm volatile("s_nop 1\n\tv_permlane32_swap_b32 %0, %1" : "+v"(a), "+v"(b));
    else asm volatile("s_nop 1\n\tv_permlane16_swap_b32 %0, %1" : "+v"(a), "+v"(b));
    r0 = a; r1 = b;
}
template <int CTRL> __device__ __forceinline__ float dpp_(float v) { return __builtin_bit_cast(float, __builtin_amdgcn_update_dpp(0, __builtin_bit_cast(int, v), CTRL, 0xF, 0xF, true)); }
__device__ __forceinline__ float wave_sum(float v) {
    v += dpp_<0xB1>(v); v += dpp_<0x4E>(v); v += dpp_<0x141>(v); v += dpp_<0x140>(v);
    float a, b; lane_swap<false>(v, a, b); v = a + b; lane_swap<true>(v, a, b); return a + b;
}
__device__ __forceinline__ float wave_max(float v) {
    v = fmaxf(v, dpp_<0xB1>(v)); v = fmaxf(v, dpp_<0x4E>(v)); v = fmaxf(v, dpp_<0x141>(v)); v = fmaxf(v, dpp_<0x140>(v));
    float a, b; lane_swap<false>(v, a, b); v = fmaxf(a, b); lane_swap<true>(v, a, b); return fmaxf(a, b);
}
__device__ __forceinline__ float sigmoidf_(float x) { return __builtin_amdgcn_rcpf(1.0f + __builtin_amdgcn_exp2f(-1.4426950408889634f * x)); }
__device__ __forceinline__ float gelu_tanh(float x) { return x * sigmoidf_(1.5957691216057308f * (x + 0.044715f * x * x * x)); }
__device__ __forceinline__ float siluf_(float x) { return x * sigmoidf_(x); }
__device__ __forceinline__ f32x2_ gelu_tanh2(f32x2_ x) {
    constexpr float c2 = -1.5957691216057308f * 1.4426950408889634f, c1 = c2 * 0.044715f;
    const f32x2_ w = (x * x) * c1 + c2, t = x * w;
    const f32x2_ d = (f32x2_){__builtin_amdgcn_exp2f(t.x), __builtin_amdgcn_exp2f(t.y)} + 1.0f;
    return x * (f32x2_){__builtin_amdgcn_rcpf(d.x), __builtin_amdgcn_rcpf(d.y)};
}
template <int SIN_NUM, int SOUT_NUM> __device__ __forceinline__ f32x2_ silu_gate2(f32x2_ a, f32x2_ b) {
    constexpr float inv = 1.0f / (float)SIN_NUM, k1 = -1.4426950408889634f * inv, k2 = inv * inv * (float)SOUT_NUM;
    const f32x2_ t = a * k1;
    const f32x2_ d = (f32x2_){__builtin_amdgcn_exp2f(t.x), __builtin_amdgcn_exp2f(t.y)} + 1.0f;
    return ((a * b) * k2) * (f32x2_){__builtin_amdgcn_rcpf(d.x), __builtin_amdgcn_rcpf(d.y)};
}

#define XB_TMO      128
#define XB_XCNT(j)  (256  + 64 * (j))
#define XB_XSUB(j)  (1280 + 64 * (j))
#define XB_XGEN(j)  (2304 + 64 * (j))
#define XB_TOP      3328
#define XB_TOPGEN   3392
#define XCD_BAR_WORDS 3456
#define XB_SPIN_CAP (1u << 25)
__device__ __forceinline__ unsigned xb_ld(unsigned* p)              { return __hip_atomic_load(p, __ATOMIC_RELAXED, __HIP_MEMORY_SCOPE_AGENT); }
__device__ __forceinline__ unsigned xb_add(unsigned* p, unsigned v) { return __hip_atomic_fetch_add(p, v, __ATOMIC_RELAXED, __HIP_MEMORY_SCOPE_AGENT); }
__device__ __forceinline__ unsigned xb_xcc_id() { return (unsigned)__builtin_amdgcn_s_getreg((3 << 11) | 20) & 0xFu; }
#define XB_SPIN(cond, bar) do { unsigned _sp = 0; while (cond) { __builtin_amdgcn_s_sleep(1); \
    if ((++_sp & 255u) == 0u) { if (xb_ld(&(bar)[XB_TMO])) break; if (_sp > XB_SPIN_CAP) { atomicAdd(&(bar)[XB_TMO], 1u); break; } } } } while (0)
struct XcdBarrier { unsigned* bar; unsigned x; volatile LAS unsigned* st; };
__device__ __forceinline__ XcdBarrier xcd_barrier_post(unsigned* bar, volatile LAS unsigned* st) {
    XcdBarrier b; b.bar = bar; b.x = xb_xcc_id(); b.st = st;
    if (threadIdx.x == 0) (void)xb_add(&bar[XB_XCNT(b.x)], 1u);
    return b;
}
__device__ __forceinline__ void xcd_barrier_complete(unsigned* bar, unsigned x, unsigned& nloc, unsigned& nx) {
    const unsigned G = gridDim.x * gridDim.y * gridDim.z;
    unsigned sum, cnt, mine, sp = 0u;
    for (;;) {
        sum = 0u; cnt = 0u; mine = 0u;
#pragma unroll
        for (unsigned j = 0; j < 16; ++j) { const unsigned c = xb_ld(&bar[XB_XCNT(j)]); sum += c; cnt += (c > 0u) ? 1u : 0u; mine = (j == x) ? c : mine; }
        if (sum == G) break;
        __builtin_amdgcn_s_sleep(1);
        if ((++sp & 255u) == 0u) { if (xb_ld(&bar[XB_TMO])) break; if (sp > XB_SPIN_CAP) { atomicAdd(&bar[XB_TMO], 1u); break; } }
    }
    nloc = mine > 0u ? mine : 1u; nx = cnt > 0u ? cnt : 1u;
}
__device__ __forceinline__ void xcd_barrier(const XcdBarrier& b) {
    asm volatile("s_waitcnt vmcnt(0)" ::: "memory");
    __syncthreads();
    if (threadIdx.x == 0) {
        unsigned* bar = b.bar;
        __builtin_amdgcn_s_waitcnt(0);
        unsigned nloc = b.st[0], nx = b.st[1];
        if (nloc == 0u) { xcd_barrier_complete(bar, b.x, nloc, nx); b.st[0] = nloc; b.st[1] = nx; }
        const unsigned old = xb_add(&bar[XB_XSUB(b.x)], 1u);
        const unsigned gen = old / nloc;
        if (old + 1u == (gen + 1u) * nloc) {
            __builtin_amdgcn_fence(__ATOMIC_RELEASE, "agent");
            asm volatile("s_waitcnt vmcnt(0)" ::: "memory");
            const unsigned og = xb_add(&bar[XB_TOP], 1u);
            const unsigned tg = og / nx;
            if (og + 1u == (tg + 1u) * nx) xb_add(&bar[XB_TOPGEN], 1u);
            else XB_SPIN(xb_ld(&bar[XB_TOPGEN]) == tg, bar);
            __builtin_amdgcn_fence(__ATOMIC_ACQUIRE, "agent");
            xb_add(&bar[XB_XGEN(b.x)], 1u);
            asm volatile("s_waitcnt vmcnt(0)" ::: "memory");
        } else {
            XB_SPIN(xb_ld(&bar[XB_XGEN(b.x)]) == gen, bar);
            __builtin_amdgcn_fence(__ATOMIC_ACQUIRE, "agent");
            asm volatile("s_waitcnt vmcnt(0)" ::: "memory");
        }
    }
    __syncthreads();
}

struct Frame {
    LAS unsigned char* lds;
    int tid, lane, wave, vcu, G;
    float* out;
    unsigned char* ws;
};
#define IN_X 0
#define IN_C 1
#define IN_CTX 2
#define IN_CCTX 3
#define IN_MODW 4
#define IN_MODB 5
#define IN_N1G 6
#define IN_N2G 7
#define IN_EVWIN 8
#define IN_EVSINK 9
#define IN_EVSGUG 10
#define IN_EVSGUW 11
#define IN_EVSGUB 12
#define IN_EVWOUT 13
#define IN_ODWIN 14
#define IN_ODQG 15
#define IN_ODWUQ 16
#define IN_ODKVG 17
#define IN_ODWUKV 18
#define IN_ODCONV 19
#define IN_ODWOUT 20
#define IN_ROUTER 21
#define IN_W1 22
#define IN_W3 23
#define IN_W2 24
#define IN_FING 25

__device__ __forceinline__ const float* inp(const Frame& F, int k) { return (const float*)(const GAS float*)(*(volatile LAS unsigned long long*)(F.lds + LDSCTL_OFF + 8 * k)); }
__device__ __forceinline__ int row_r(int row) { return row < NLAT ? (row >> 12) : 8; }
__device__ __forceinline__ int row_b(int row) { return row < NLAT ? (row >> 12) : ((row - NLAT) >> 8); }
__device__ __forceinline__ const float* modv(const Frame& F, int layer, int r, int which) { return (const float*)(F.ws + WS_MODV) + ((size_t)(layer * 9 + r) * 6 + which) * 1024; }

__device__ __forceinline__ void conv_item(const float* src, const float* src2, int ld_src, int K, bf16* dst, int kb, int nb, int kind, const float* kscale, LAS float* scr, int lane) {
    const int k0 = kb * 64, n0 = nb * 32, np = n0 + (lane & 31);
    const float* sp = src; int oc = np;
    if (kind == 1) {
        if (np < 128) { const int h = np >> 6, w = np & 63; oc = h * 64 + (w >> 1) + 32 * (w & 1); }
        else if (np >= 256 && np < 768) { const int w0 = np - 256, h = w0 >> 6, w = w0 & 63; oc = 256 + h * 64 + (w >> 1) + 32 * (w & 1); }
    } else if (kind == 2) {
        if (np < 256) oc = np; else if (np < 640) oc = np + 32; else if (np < 672) { const int w = np - 640; oc = 256 + (w >> 1) + 16 * (w & 1); } else if (np < 2208) oc = np; else oc = -1;
    } else if (kind == 3) {
        const int h = np / 96, w = np % 96; if (w >= 64) { const int w2 = w - 64; oc = h * 96 + 64 + (w2 >> 1) + 16 * (w2 & 1); }
    } else if (kind == 4) {
        const int half = (np >> 7) & 1; oc = (np >> 8) * 128 + (np & 127); sp = half ? src2 : src;
    }
#pragma unroll 8
    for (int i = 0; i < 32; ++i) { const int kk = 2 * i + (lane >> 5); float v = (oc >= 0) ? sp[(size_t)(k0 + kk) * ld_src + oc] : 0.f; if (kscale) v *= kscale[k0 + kk]; scr[kk * 33 + (lane & 31)] = v; }
    LDS_WAIT(); asm volatile("" ::: "memory");
    const int c = lane & 7;
#pragma unroll
    for (int j = 0; j < 4; ++j) { const int n = (lane >> 3) + 8 * j; const LAS float* s = scr + (8 * c) * 33 + n;
        v4u o; o.x = pk2(s[0 * 33], s[1 * 33]); o.y = pk2(s[2 * 33], s[3 * 33]); o.z = pk2(s[4 * 33], s[5 * 33]); o.w = pk2(s[6 * 33], s[7 * 33]);
        *(v4u*)(dst + (size_t)(n0 + n) * K + k0 + 8 * c) = o; }
    LDS_WAIT(); asm volatile("" ::: "memory");
}

__device__ __forceinline__ void conv_item_fp8(const float* src, const float* src2, int ld_src, int K, unsigned char* dst, int kb, int nb, int kind, LAS float* scr, int lane) {
    const int k0 = kb * 128, n0 = nb * 32, np = n0 + 4 * (lane & 7), kr = lane >> 3;
    const float* sp = src; int oc = np;
    if (kind == 4) { const int half = (np >> 7) & 1; oc = (np >> 8) * 128 + (np & 127); sp = half ? src2 : src; }
    sp += (size_t)(k0 + kr) * ld_src + oc;
#pragma unroll 8
    for (int i = 0; i < 16; ++i) { const f32x4 v = *(const f32x4*)(sp + (size_t)(8 * i) * ld_src); *(LAS f32x4*)(scr + (8 * i + kr) * 36 + 4 * (lane & 7)) = v * F8_SW; }
    LDS_WAIT(); asm volatile("" ::: "memory");
    const int n = lane >> 1, h = lane & 1;
    unsigned char* d = dst + (size_t)(n0 + n) * K + k0 + 64 * h;
#pragma unroll
    for (int q = 0; q < 4; ++q) { const LAS float* sc = scr + (64 * h + 16 * q) * 36 + n; v4u o;
        o.x = pk4_fp8(sc[0 * 36], sc[1 * 36], sc[2 * 36], sc[3 * 36]);   o.y = pk4_fp8(sc[4 * 36], sc[5 * 36], sc[6 * 36], sc[7 * 36]);
        o.z = pk4_fp8(sc[8 * 36], sc[9 * 36], sc[10 * 36], sc[11 * 36]); o.w = pk4_fp8(sc[12 * 36], sc[13 * 36], sc[14 * 36], sc[15 * 36]);
        *(v4u*)(d + 16 * q) = o; }
    LDS_WAIT(); asm volatile("" ::: "memory");
}
constexpr int CI_WINE = 16 * 56, CI_WOUT = 16 * 32, CI_WINO = 16 * 72, CI_WUQ = 6 * 24, CI_WUKV = 4 * 32;
constexpr int CI_SMALL = CI_WINE + CI_WOUT + CI_WINO + CI_WUQ + CI_WUKV + CI_WOUT, CI_SMALL2 = 2 * CI_SMALL;
constexpr int CI_W13 = FP8_F1 ? 8 * 64 : 16 * 64, CI_W2 = FP8_F2 ? 8 * 32 : 16 * 32, CI_PER_LAYER = 16 * (CI_W13 + CI_W2);
__device__ __forceinline__ void conv_items(Frame& F, int lo, int hi, int worker, int nworkers) {
    LAS float* scr = (LAS float*)(F.lds + F.wave * 18432);
    const int gw = worker * NWAVES + F.wave, NGW = nworkers * NWAVES;
    unsigned char* wsm = F.ws + WS_WSMALL;
    for (int it = lo + gw; it < hi; it += NGW) {
        int r = it;
        if (r < CI_SMALL2) {
            const int i = r / CI_SMALL; r %= CI_SMALL;
            if (r < CI_WINE) { conv_item(inp(F, IN_EVWIN) + (size_t)i * D * ZE, nullptr, ZE, D, (bf16*)(wsm + OFF_WINE + i * SZ_WINE), r / 56, r % 56, 1, nullptr, scr, F.lane); continue; } r -= CI_WINE;
            if (r < CI_WOUT) { conv_item(inp(F, IN_EVWOUT) + (size_t)i * D * D, nullptr, D, D, (bf16*)(wsm + OFF_WOUTE + i * SZ_WOUT), r / 32, r % 32, 0, nullptr, scr, F.lane); continue; } r -= CI_WOUT;
            if (r < CI_WINO) { conv_item(inp(F, IN_ODWIN) + (size_t)i * D * 2208, nullptr, 2208, D, (bf16*)(wsm + OFF_WINO + i * SZ_WINO), r / 72, r % 72, 2, nullptr, scr, F.lane); continue; } r -= CI_WINO;
            if (r < CI_WUQ) { conv_item(inp(F, IN_ODWUQ) + (size_t)i * 384 * 768, nullptr, 768, 384, (bf16*)(wsm + OFF_WUQ + i * SZ_WUQ), r / 24, r % 24, 3, inp(F, IN_ODQG) + i * 384, scr, F.lane); continue; } r -= CI_WUQ;
            if (r < CI_WUKV) { conv_item(inp(F, IN_ODWUKV) + (size_t)i * 256 * 1024, nullptr, 1024, 256, (bf16*)(wsm + OFF_WUKV + i * SZ_WUKV), r / 32, r % 32, 0, inp(F, IN_ODKVG) + i * 256, scr, F.lane); continue; } r -= CI_WUKV;
            conv_item(inp(F, IN_ODWOUT) + (size_t)i * D * D, nullptr, D, D, (bf16*)(wsm + OFF_WOUTO + i * SZ_WOUT), r / 32, r % 32, 0, nullptr, scr, F.lane); continue;
        }
        r -= CI_SMALL2;
        const int layer = r / CI_PER_LAYER; r %= CI_PER_LAYER;
        if (r < 16 * CI_W13) { const int le = layer * 16 + r / CI_W13; r %= CI_W13;
            if constexpr (FP8_F1) conv_item_fp8(inp(F, IN_W1) + (size_t)le * D * FF, inp(F, IN_W3) + (size_t)le * D * FF, FF, D, F.ws + WS_W13 + (size_t)le * (SZ_W13 / 2), r / 64, r % 64, 4, scr, F.lane);
            else conv_item(inp(F, IN_W1) + (size_t)le * D * FF, inp(F, IN_W3) + (size_t)le * D * FF, FF, D, (bf16*)(F.ws + WS_W13 + (size_t)le * SZ_W13), r / 64, r % 64, 4, nullptr, scr, F.lane);
            continue; }
        r -= 16 * CI_W13;
        { const int le = layer * 16 + r / CI_W2; r %= CI_W2;
            if constexpr (FP8_F2) conv_item_fp8(inp(F, IN_W2) + (size_t)le * FF * D, nullptr, D, FF, F.ws + WS_W2 + (size_t)le * (SZ_W2 / 2), r / 32, r % 32, 0, scr, F.lane);
            else conv_item(inp(F, IN_W2) + (size_t)le * FF * D, nullptr, D, FF, (bf16*)(F.ws + WS_W2 + (size_t)le * SZ_W2), r / 32, r % 32, 0, nullptr, scr, F.lane); }
    }
}
#define CONV_TAIL(S_, layer_, f0_, f1_) do { const int rem_ = (S_).nwg % F.G; if ((layer_) < DEPTH - 1 && rem_ != 0 && (int)blockIdx.x >= rem_) { LAUNDER(); \
        const int base_ = CI_SMALL2 + ((layer_) + 1) * CI_PER_LAYER; conv_items(F, base_ + CI_PER_LAYER * (f0_) / 64, base_ + CI_PER_LAYER * (f1_) / 64, (int)blockIdx.x - rem_, F.G - rem_); } } while (0)
__device__ __forceinline__ void p0_prologue(Frame& F) {
    {
        LAS float* s = (LAS float*)F.lds;
        LAS float* red = s + 9 * 1024;
        for (int i = F.tid; i < 9 * 1024; i += NT) { const int r = i >> 10, k = i & 1023; const float v = (r < 8) ? inp(F, IN_C)[r * 1024 + k] : inp(F, IN_CCTX)[k]; s[i] = siluf_(v); }
        __syncthreads();
        for (int u = blockIdx.x; u < 4 * 48; u += F.G) {
            const int layer = u / 48, ch = u % 48, col = ch * 128 + (F.tid & 127), kq = F.tid >> 7;
            const float* W = inp(F, IN_MODW) + (size_t)layer * 1024 * 6144;
            float acc[9];
#pragma unroll
            for (int r = 0; r < 9; ++r) acc[r] = 0.f;
            for (int k = kq * 256; k < kq * 256 + 256; k += 16) {
                float w[16];
#pragma unroll
                for (int j = 0; j < 16; ++j) w[j] = W[(size_t)(k + j) * 6144 + col];
#pragma unroll
                for (int j = 0; j < 16; ++j)
#pragma unroll
                    for (int r = 0; r < 9; ++r) acc[r] += s[r * 1024 + k + j] * w[j]; }
#pragma unroll
            for (int r = 0; r < 9; ++r) red[(kq * 9 + r) * 128 + (F.tid & 127)] = acc[r];
            __syncthreads();
            for (int i = F.tid; i < 9 * 128; i += NT) { const int r = i >> 7, cc = i & 127; const float v = red[(0 * 9 + r) * 128 + cc] + red[(1 * 9 + r) * 128 + cc] + red[(2 * 9 + r) * 128 + cc] + red[(3 * 9 + r) * 128 + cc];
                const int c6 = ch * 128 + cc; ((float*)(F.ws + WS_MODV))[(size_t)(layer * 9 + r) * 6144 + c6] = v + inp(F, IN_MODB)[layer * 6144 + c6]; }
            __syncthreads();
        }
        __syncthreads();
    }
    {
        float* ca = (float*)(F.ws + WS_TAB); float* sa = ca + 4096 * 32; float* cc = sa + 4096 * 32; float* sc = cc + 4096 * 16;
        for (int i = blockIdx.x * NT + F.tid; i < 4096 * 32; i += F.G * NT) { const int pos = i >> 5, j = i & 31; const float inv = powf(10000.0f, -(float)(j & 15) / 16.0f);
            const float ang = (float)((j < 16) ? (pos >> 6) : (pos & 63)) * inv; ca[i] = cosf(ang); sa[i] = sinf(ang); }
        for (int i = blockIdx.x * NT + F.tid; i < 4096 * 16; i += F.G * NT) { const int pos = i >> 4, j = i & 15; const float inv = powf(10000.0f, -(float)(j & 7) / 8.0f);
            const float ang = (float)((j < 8) ? (pos >> 6) : (pos & 63)) * inv; cc[i] = cosf(ang); sc[i] = sinf(ang); }
    }
    {
        const float* w = inp(F, IN_EVSGUW); bf16* o = (bf16*)(F.ws + WS_WSB);
        for (int i = blockIdx.x * NT + F.tid; i < 2 * 4 * 128 * 128; i += F.G * NT) o[i] = (bf16)f2bf(w[i]);
    }
    {
        constexpr int TOT = CI_SMALL2 + CI_PER_LAYER, CUT = TOT / 10;
        if (F.G > 192) { if ((int)blockIdx.x >= 192) conv_items(F, TOT - CUT, TOT, (int)blockIdx.x - 192, F.G - 192); conv_items(F, 0, TOT - CUT, F.vcu, F.G); }
        else conv_items(F, 0, TOT, F.vcu, F.G);
    }
}

__device__ __forceinline__ void load_row4(const float* p, int lane, f32x4 (&v)[4]) {
    const f32x4* q = (const f32x4*)p + lane;
#pragma unroll
    for (int j = 0; j < 4; ++j) v[j] = q[64 * j];
}
__device__ __forceinline__ void load_row4b(const bf16* p, int lane, v2u (&v)[4]) {
    const v2u* q = (const v2u*)p + lane;
#pragma unroll
    for (int j = 0; j < 4; ++j) v[j] = q[64 * j];
}
__device__ __forceinline__ f32x4 bf4(v2u w) { return (f32x4){bflo(w.x), bfhi(w.x), bflo(w.y), bfhi(w.y)}; }
__device__ __forceinline__ void n1_phase(Frame& F, int layer, bool dummy = false) {
    const int gw = F.vcu * NWAVES + F.wave, NGW = F.G * NWAVES;
    bf16* X = (bf16*)(F.ws + WS_X);
    bf16* H = (bf16*)(F.ws + WS_H);
    const bf16* Y = (const bf16*)(F.ws + WS_Y);
    const int* INV = (const int*)(F.ws + WS_INV); const float* AFF = (const float*)(F.ws + WS_AFF);
    const float* xin = inp(F, IN_X); const float* cin = inp(F, IN_CTX);
    const int nrows = (layer == 4) ? NLAT : MT, rpw = (nrows + NGW - 1) / NGW, r0 = gw * rpw, r1 = (r0 + rpw < nrows) ? r0 + rpw : nrows;
    if (r0 >= r1) return;
    f32x4 xn[4]; v2u xb[4]; int invn = -1; float affn = 0.f;
#pragma unroll
    for (int j = 0; j < 4; ++j) { xn[j] = (f32x4){0.f, 0.f, 0.f, 0.f}; xb[j] = (v2u){0u, 0u}; }
#define N1_FETCH(row_) do { if (layer == 0) load_row4((row_) < NLAT ? xin + (size_t)(row_) * 1024 : cin + (size_t)((row_) - NLAT) * 1024, F.lane, xn); else load_row4b(X + (size_t)(row_) * 1024, F.lane, xb); \
        if (layer > 0 && F.lane < 16) { invn = ((row_) < NLAT) ? INV[((size_t)((row_) >> 12) * 16 + F.lane) * 4096 + ((row_) & 4095)] : INV[(size_t)NLAT * 16 + ((size_t)(((row_) - NLAT) >> 8) * 16 + F.lane) * 256 + (((row_) - NLAT) & 255)]; \
            affn = AFF[(size_t)(row_) * 16 + F.lane]; } } while (0)
    N1_FETCH(r0);
    int rcur = -1;
    f32x4 cA[4], cB[4], g2[4];
#pragma unroll
    for (int j = 0; j < 4; ++j) { cA[j] = (f32x4){0.f, 0.f, 0.f, 0.f}; cB[j] = cA[j]; g2[j] = cA[j]; }
    for (int row = r0; row < r1; ++row) {
        f32x4 x[4];
#pragma unroll
        for (int j = 0; j < 4; ++j) x[j] = (layer == 0) ? xn[j] : bf4(xb[j]);
        const int inv = invn; const float aff = affn;
        if (row + 1 < r1) N1_FETCH(row + 1);
        const int r = row_r(row);
        if (r != rcur) {
            rcur = r;
            if (layer > 0) load_row4(modv(F, layer - 1, r, 5), F.lane, g2);
            if (layer < 4) { f32x4 g[4], sc[4]; load_row4(inp(F, IN_N1G) + layer * 1024, F.lane, g); load_row4(modv(F, layer, r, 1), F.lane, sc); load_row4(modv(F, layer, r, 0), F.lane, cB);
#pragma unroll
                for (int j = 0; j < 4; ++j) cA[j] = g[j] * (sc[j] + 1.0f); }
            else load_row4(inp(F, IN_FING), F.lane, cA);
        }
        if (layer > 0) {
            unsigned long long mask = __ballot(F.lane < 16 && inv >= 0);
            f32x4 acc[4];
#pragma unroll
            for (int j = 0; j < 4; ++j) acc[j] = (f32x4){0.f, 0.f, 0.f, 0.f};
            while (mask) {
                const int e0 = __builtin_ctzll(mask); mask &= mask - 1;
                const bool two = mask != 0; const int e1 = two ? __builtin_ctzll(mask) : e0; if (two) mask &= mask - 1;
                const int s0 = __builtin_amdgcn_readlane(inv, e0), s1 = __builtin_amdgcn_readlane(inv, e1);
                const float ga = __builtin_bit_cast(float, __builtin_amdgcn_readlane(__builtin_bit_cast(int, aff), e0)), gb = two ? __builtin_bit_cast(float, __builtin_amdgcn_readlane(__builtin_bit_cast(int, aff), e1)) : 0.f;
                if constexpr (FP8_Y) {
                    const unsigned* ya = (const unsigned*)((const unsigned char*)Y + (size_t)(e0 * EROWS + s0) * 1024) + F.lane; const unsigned* yb = (const unsigned*)((const unsigned char*)Y + (size_t)(e1 * EROWS + s1) * 1024) + F.lane;
                    unsigned wa[4], wb[4];
#pragma unroll
                    for (int j = 0; j < 4; ++j) { wa[j] = ya[64 * j]; wb[j] = yb[64 * j]; }
                    const float ga_ = ga * (1.0f / F8_SY), gb_ = gb * (1.0f / F8_SY);
#pragma unroll
                    for (int j = 0; j < 4; ++j) { const f32x2_ a0 = __builtin_amdgcn_cvt_pk_f32_fp8((int)wa[j], false), a1 = __builtin_amdgcn_cvt_pk_f32_fp8((int)wa[j], true), b0 = __builtin_amdgcn_cvt_pk_f32_fp8((int)wb[j], false), b1 = __builtin_amdgcn_cvt_pk_f32_fp8((int)wb[j], true);
                        acc[j].x += ga_ * a0.x + gb_ * b0.x; acc[j].y += ga_ * a0.y + gb_ * b0.y; acc[j].z += ga_ * a1.x + gb_ * b1.x; acc[j].w += ga_ * a1.y + gb_ * b1.y; }
                } else {
                const v2u* ya = (const v2u*)(Y + (size_t)(e0 * EROWS + s0) * 1024) + F.lane; const v2u* yb = (const v2u*)(Y + (size_t)(e1 * EROWS + s1) * 1024) + F.lane;
                v2u wa[4], wb[4];
#pragma unroll
                for (int j = 0; j < 4; ++j) { wa[j] = ya[64 * j]; wb[j] = yb[64 * j]; }
#pragma unroll
                for (int j = 0; j < 4; ++j) { acc[j].x += ga * bflo(wa[j].x) + gb * bflo(wb[j].x); acc[j].y += ga * bfhi(wa[j].x) + gb * bfhi(wb[j].x); acc[j].z += ga * bflo(wa[j].y) + gb * bflo(wb[j].y); acc[j].w += ga * bfhi(wa[j].y) + gb * bfhi(wb[j].y); }
                }
            }
#pragma unroll
            for (int j = 0; j < 4; ++j) x[j] += g2[j] * acc[j];
        }
        float ss = 0.f;
#pragma unroll
        for (int j = 0; j < 4; ++j) ss += (x[j].x * x[j].x + x[j].y * x[j].y) + (x[j].z * x[j].z + x[j].w * x[j].w);
        const float rstd = 1.0f / sqrtf(wave_sum(ss) * (1.0f / 1024.0f) + EPS);
        if (layer == 4) {
            f32x4* o = (f32x4*)(F.out + (size_t)row * 1024) + F.lane;
#pragma unroll
            for (int j = 0; j < 4; ++j) o[64 * j] = x[j] * rstd * cA[j];
        } else {
            v2u* xo = (v2u*)((dummy ? (bf16*)(F.ws + WS_X + 68 * MiB) : X) + (size_t)row * 1024) + F.lane;
#pragma unroll
            for (int j = 0; j < 4; ++j) { v2u w; w.x = pk2(x[j].x, x[j].y); w.y = pk2(x[j].z, x[j].w); xo[64 * j] = w; }
            v2u* ho = (v2u*)((dummy ? (bf16*)(F.ws + WS_Z) : H) + (size_t)row * 1024) + F.lane;
#pragma unroll
            for (int j = 0; j < 4; ++j) { const f32x4 h = x[j] * rstd * cA[j] + cB[j]; v2u w; w.x = pk2(h.x, h.y); w.y = pk2(h.z, h.w); ho[64 * j] = w; }
            if ((layer & 1) && F.lane == 0) { unsigned long long* rs = (unsigned long long*)(F.ws + WS_RS); rs[row] = 0ull; rs[MT + row] = 0ull; }
        }
    }
#undef N1_FETCH
}

__device__ __forceinline__ void n2_phase(Frame& F, int layer) {
    const int gw = F.vcu * NWAVES + F.wave, NGW = F.G * NWAVES;
    const bf16* X = (const bf16*)(F.ws + WS_X);
    bf16* H = (bf16*)(F.ws + WS_H);
    LAS float* wr = (LAS float*)F.lds;
    const float* rw = inp(F, IN_ROUTER) + (size_t)layer * 1024 * 16;
    for (int i = F.tid; i < 16384; i += NT) { const int k = i >> 4, e = i & 15; wr[e * 1024 + k] = rw[i]; }
    __syncthreads();
    float* AFF = (float*)(F.ws + WS_AFF); float* AFFT = (float*)(F.ws + WS_AFFT);
    const bool need_ctx = layer < DEPTH - 1;
    const int nrows = need_ctx ? MT : NLAT, rpw = (nrows + NGW - 1) / NGW, r0 = gw * rpw, r1 = (r0 + rpw < nrows) ? r0 + rpw : nrows;
    const int b5 = (F.lane >> 5) & 1, b4 = (F.lane >> 4) & 1, b3 = (F.lane >> 3) & 1, b2 = (F.lane >> 2) & 1, emine = (F.lane >> 2) & 15;
    if (r0 < r1) {
        v2u xn[4]; load_row4b(X + (size_t)r0 * 1024, F.lane, xn);
        int rcur = -1; f32x4 cA[4], cB[4];
#pragma unroll
        for (int j = 0; j < 4; ++j) { cA[j] = (f32x4){0.f, 0.f, 0.f, 0.f}; cB[j] = cA[j]; }
        for (int row = r0; row < r1; ++row) {
            f32x4 x[4];
#pragma unroll
            for (int j = 0; j < 4; ++j) x[j] = bf4(xn[j]);
            if (row + 1 < r1) load_row4b(X + (size_t)(row + 1) * 1024, F.lane, xn);
            const int r = row_r(row);
            if (r != rcur) { rcur = r; f32x4 g[4], sc[4]; load_row4(inp(F, IN_N2G) + layer * 1024, F.lane, g); load_row4(modv(F, layer, r, 4), F.lane, sc); load_row4(modv(F, layer, r, 3), F.lane, cB);
#pragma unroll
                for (int j = 0; j < 4; ++j) cA[j] = g[j] * (sc[j] + 1.0f); }
            float ss = 0.f;
#pragma unroll
            for (int j = 0; j < 4; ++j) ss += (x[j].x * x[j].x + x[j].y * x[j].y) + (x[j].z * x[j].z + x[j].w * x[j].w);
            const float rstd = 1.0f / sqrtf(wave_sum(ss) * (1.0f / 1024.0f) + EPS);
            f32x4 h[4];
            if constexpr (FP8_F1) {
                unsigned* ho = (unsigned*)((unsigned char*)H + (size_t)row * 1024) + F.lane;
#pragma unroll
                for (int j = 0; j < 4; ++j) { h[j] = x[j] * rstd * cA[j] + cB[j]; ho[64 * j] = pk4_fp8(clampf_(h[j].x * F8_SA, 448.f), clampf_(h[j].y * F8_SA, 448.f), clampf_(h[j].z * F8_SA, 448.f), clampf_(h[j].w * F8_SA, 448.f)); }
            } else {
                v2u* ho = (v2u*)(H + (size_t)row * 1024) + F.lane;
#pragma unroll
                for (int j = 0; j < 4; ++j) { h[j] = x[j] * rstd * cA[j] + cB[j]; v2u w; w.x = pk2(h[j].x, h[j].y); w.y = pk2(h[j].z, h[j].w); ho[64 * j] = w; }
            }
            float a[16];
#pragma unroll
            for (int e = 0; e < 16; ++e) { float t = 0.f;
#pragma unroll
                for (int j = 0; j < 4; ++j) { const f32x4 w = *(const LAS f32x4*)(wr + e * 1024 + 256 * j + 4 * F.lane); t += (h[j].x * w.x + h[j].y * w.y) + (h[j].z * w.z + h[j].w * w.w); }
                a[e] = t; if ((e & 3) == 3) asm volatile("" ::: "memory"); }
            float bq[8], cq[4], dq[2];
#pragma unroll
            for (int j = 0; j < 8; ++j) { const float keep = b5 ? a[j + 8] : a[j], send = b5 ? a[j] : a[j + 8]; bq[j] = keep + __shfl_xor(send, 32); }
#pragma unroll
            for (int j = 0; j < 4; ++j) { const float keep = b4 ? bq[j + 4] : bq[j], send = b4 ? bq[j] : bq[j + 4]; cq[j] = keep + __shfl_xor(send, 16); }
#pragma unroll
            for (int j = 0; j < 2; ++j) { const float keep = b3 ? cq[j + 2] : cq[j], send = b3 ? cq[j] : cq[j + 2]; dq[j] = keep + __shfl_xor(send, 8); }
            float lg = (b2 ? dq[1] : dq[0]) + __shfl_xor(b2 ? dq[0] : dq[1], 4);
            lg += __shfl_xor(lg, 2); lg += __shfl_xor(lg, 1);
            float mx = lg;
#pragma unroll
            for (int o = 4; o < 64; o <<= 1) mx = fmaxf(mx, __shfl_xor(mx, o));
            const float p = expf(lg - mx); float den = p;
#pragma unroll
            for (int o = 4; o < 64; o <<= 1) den += __shfl_xor(den, o);
            const float mine = p / den;
            if ((F.lane & 3) == 0) {
                AFF[(size_t)row * 16 + emine] = mine;
                if (row < NLAT) AFFT[((size_t)(row >> 12) * 16 + emine) * 4096 + (row & 4095)] = mine;
                else { const int rc = row - NLAT; AFFT[(size_t)NLAT * 16 + ((size_t)(rc >> 8) * 16 + emine) * 256 + (rc & 255)] = mine; }
            }
        }
    }
    __syncthreads();
}

__device__ __forceinline__ void n2_row_valu(Frame& F, int layer, int row, const v2u (&xr)[4], const LAS float* wr, const LAS float* ca, const LAS float* cb) {
    unsigned char* H2 = F.ws + WS_H; float* AFF = (float*)(F.ws + WS_AFF); float* AFFT = (float*)(F.ws + WS_AFFT);
    const int b5 = (F.lane >> 5) & 1, b4 = (F.lane >> 4) & 1, b3 = (F.lane >> 3) & 1, b2 = (F.lane >> 2) & 1, emine = (F.lane >> 2) & 15;
    f32x4 x[4];
#pragma unroll
    for (int j = 0; j < 4; ++j) x[j] = bf4(xr[j]);
    float ss = 0.f;
#pragma unroll
    for (int j = 0; j < 4; ++j) ss += (x[j].x * x[j].x + x[j].y * x[j].y) + (x[j].z * x[j].z + x[j].w * x[j].w);
    const float rstd = 1.0f / sqrtf(wave_sum(ss) * (1.0f / 1024.0f) + EPS);
    f32x4 h[4];
    unsigned* ho = (unsigned*)(H2 + (size_t)row * 1024) + F.lane;
#pragma unroll
    for (int j = 0; j < 4; ++j) { const f32x4 cA = *(const LAS f32x4*)(ca + 256 * j + 4 * F.lane), cB = *(const LAS f32x4*)(cb + 256 * j + 4 * F.lane);
        h[j] = x[j] * rstd * cA + cB; ho[64 * j] = pk4_fp8(clampf_(h[j].x * F8_SA, 448.f), clampf_(h[j].y * F8_SA, 448.f), clampf_(h[j].z * F8_SA, 448.f), clampf_(h[j].w * F8_SA, 448.f)); }
    float a[16];
#pragma unroll
    for (int e = 0; e < 16; ++e) { float t = 0.f;
#pragma unroll
        for (int j = 0; j < 4; ++j) { const f32x4 w = *(const LAS f32x4*)(wr + e * 1028 + 256 * j + 4 * F.lane); t += (h[j].x * w.x + h[j].y * w.y) + (h[j].z * w.z + h[j].w * w.w); }
        a[e] = t; if ((e & 3) == 3) asm volatile("" ::: "memory"); }
    float bq[8], cq[4], dq[2];
#pragma unroll
    for (int j = 0; j < 8; ++j) { const float keep = b5 ? a[j + 8] : a[j], send = b5 ? a[j] : a[j + 8]; bq[j] = keep + __shfl_xor(send, 32); }
#pragma unroll
    for (int j = 0; j < 4; ++j) { const float keep = b4 ? bq[j + 4] : bq[j], send = b4 ? bq[j] : bq[j + 4]; cq[j] = keep + __shfl_xor(send, 16); }
#pragma unroll
    for (int j = 0; j < 2; ++j) { const float keep = b3 ? cq[j + 2] : cq[j], send = b3 ? cq[j] : cq[j + 2]; dq[j] = keep + __shfl_xor(send, 8); }
    float lg = (b2 ? dq[1] : dq[0]) + __shfl_xor(b2 ? dq[0] : dq[1], 4);
    lg += __shfl_xor(lg, 2); lg += __shfl_xor(lg, 1);
    float mx = lg;
#pragma unroll
    for (int o = 4; o < 64; o <<= 1) mx = fmaxf(mx, __shfl_xor(mx, o));
    const float p = expf(lg - mx); float den = p;
#pragma unroll
    for (int o = 4; o < 64; o <<= 1) den += __shfl_xor(den, o);
    const float mine = p / den;
    if ((F.lane & 3) == 0) {
        AFF[(size_t)row * 16 + emine] = mine;
        if (row < NLAT) AFFT[((size_t)(row >> 12) * 16 + emine) * 4096 + (row & 4095)] = mine;
        else { const int rc = row - NLAT; AFFT[(size_t)NLAT * 16 + ((size_t)(rc >> 8) * 16 + emine) * 256 + (rc & 255)] = mine; }
    }
}
__device__ __forceinline__ void n2_phase_mfma(Frame& F, int layer) {
    typedef short n2v8 __attribute__((ext_vector_type(8)));
    const bf16* X = (const bf16*)(F.ws + WS_X);
    unsigned char* H2 = F.ws + WS_H;
    LAS unsigned short* AH = (LAS unsigned short*)F.lds;
    LAS unsigned short* AL = AH + 32 * 64 * 8;
    LAS float* CA = (LAS float*)(F.lds + 65536);
    LAS float* CB = CA + 1024;
    LAS float* CP = CB + 1024;
    LAS float* CC = CP + 512;
    LAS float* CA8 = (LAS float*)(F.lds + 77824);
    LAS float* CB8 = CA8 + 1024;
    LAS float* WR = (LAS float*)(F.lds + 86016);
    const float* rw = inp(F, IN_ROUTER) + (size_t)layer * 16384;
    float* AFF = (float*)(F.ws + WS_AFF); float* AFFT = (float*)(F.ws + WS_AFFT);
    const bool need_ctx = layer < DEPTH - 1;
    const int nunits = NLAT / 128;
    const int gwv = F.vcu * NWAVES + F.wave, NGWV = F.G * NWAVES;
    const int q = F.lane >> 4, rl = F.lane & 15;
    int rcur = -1;
    if (need_ctx) {
        v2u xc[4]; const bool has_ctx = NLAT + gwv < MT;
        load_row4b(X + (size_t)(has_ctx ? NLAT + gwv : 0) * 1024, F.lane, xc);
        { for (int i = F.tid; i < 16384; i += NT) { const int k = i >> 4, e = i & 15; WR[e * 1028 + k] = rw[i]; }
          const float* g = inp(F, IN_N2G) + layer * 1024; const float* sc = modv(F, layer, 8, 4); const float* sh = modv(F, layer, 8, 3);
          for (int k = F.tid; k < 1024; k += NT) { CA8[k] = g[k] * (sc[k] + 1.0f); CB8[k] = sh[k]; } }
        __syncthreads();
        if (has_ctx) n2_row_valu(F, layer, NLAT + gwv, xc, WR, CA8, CB8);
        for (int row = NLAT + gwv + NGWV; row < MT; row += NGWV) { v2u xq[4]; load_row4b(X + (size_t)row * 1024, F.lane, xq); n2_row_valu(F, layer, row, xq, WR, CA8, CB8); }
    }
    for (int u = F.vcu; u < nunits; u += F.G) {
        const int row0 = u * 128, r = row_r(row0), row = row0 + F.wave * 16 + rl;
        const v4u* xp = (const v4u*)(X + (size_t)row * 1024) + 2 * q;
        v4u x[32];
#pragma unroll
        for (int s = 0; s < 32; ++s) x[s] = xp[(s >> 1) * 8 + (s & 1)];
        if (r != rcur) {
            rcur = r;
            __syncthreads();
            { const float* g = inp(F, IN_N2G) + layer * 1024; const float* sc = modv(F, layer, r, 4); const float* sh = modv(F, layer, r, 3);
              for (int k = F.tid; k < 1024; k += NT) { CA[k] = g[k] * (sc[k] + 1.0f) * F8_SA; CB[k] = sh[k] * F8_SA; } }
            __syncthreads();
            { const int e = F.tid & 15; float cpart = 0.f;
#pragma unroll 4
              for (int i = 0; i < 32; ++i) { const int idx = F.tid + NT * i, k = idx >> 4; const float w = rw[idx]; const float wf = CA[k] * (1.0f / F8_SA) * w; cpart += CB[k] * (1.0f / F8_SA) * w;
                  const unsigned hi = f2bf(wf); const unsigned lo = f2bf(wf - __builtin_bit_cast(float, hi << 16));
                  const int c = k >> 3, j = k & 7, st = (c >> 3) * 2 + (c & 1), qq = (c & 7) >> 1, off = ((st * 64 + qq * 16 + e) * 8 + j);
                  AH[off] = (unsigned short)hi; AL[off] = (unsigned short)lo; }
              CP[(F.tid >> 4) * 16 + e] = cpart; }
            __syncthreads();
            if (F.tid < 16) { float c = 0.f; for (int gi = 0; gi < 32; ++gi) c += CP[gi * 16 + F.tid]; CC[F.tid] = c; }
            __syncthreads();
        }
        f32x4 acc = {0.f, 0.f, 0.f, 0.f}, acc2 = acc, acc3 = acc;
#pragma unroll
        for (int s = 0; s < 32; ++s) {
            const n2v8 xb = __builtin_bit_cast(n2v8, x[s]);
            const n2v8 ah = *(const LAS n2v8*)(AH + (s * 64 + F.lane) * 8), al = *(const LAS n2v8*)(AL + (s * 64 + F.lane) * 8);
            acc = __builtin_amdgcn_mfma_f32_16x16x32_bf16(ah, xb, acc, 0, 0, 0);
            acc2 = __builtin_amdgcn_mfma_f32_16x16x32_bf16(al, xb, acc2, 0, 0, 0);
            acc3 = __builtin_amdgcn_mfma_f32_16x16x32_bf16(xb, xb, acc3, 0, 0, 0);
        }
        const int i3 = F.lane & 3;
        const float dsel = i3 == 0 ? acc3[0] : i3 == 1 ? acc3[1] : i3 == 2 ? acc3[2] : acc3[3];
        const float ss = __shfl(dsel, ((rl >> 2) << 4) + rl);
        const float rstd = 1.0f / sqrtf(ss * (1.0f / 1024.0f) + EPS);
        {
            const f32x4 cc = *(const LAS f32x4*)(CC + 4 * q);
            float lg[4];
#pragma unroll
            for (int i = 0; i < 4; ++i) lg[i] = rstd * (acc[i] + acc2[i]) + cc[i];
            float mx = fmaxf(fmaxf(lg[0], lg[1]), fmaxf(lg[2], lg[3]));
            { float t0, t1; lane_swap<false>(mx, t0, t1); mx = fmaxf(t0, t1); lane_swap<true>(mx, t0, t1); mx = fmaxf(t0, t1); }
            float pe[4], den = 0.f;
#pragma unroll
            for (int i = 0; i < 4; ++i) { pe[i] = expf(lg[i] - mx); den += pe[i]; }
            { float t0, t1; lane_swap<false>(den, t0, t1); den = t0 + t1; lane_swap<true>(den, t0, t1); den = t0 + t1; }
            const float rden = 1.0f / den;
            f32x4 af; af.x = pe[0] * rden; af.y = pe[1] * rden; af.z = pe[2] * rden; af.w = pe[3] * rden;
            *(f32x4*)(AFF + (size_t)row * 16 + 4 * q) = af;
            float* at = (row < NLAT) ? AFFT + ((size_t)(row >> 12) * 16 + 4 * q) * 4096 + (row & 4095) : AFFT + (size_t)NLAT * 16 + ((size_t)((row - NLAT) >> 8) * 16 + 4 * q) * 256 + ((row - NLAT) & 255);
            const int astr = (row < NLAT) ? 4096 : 256;
            at[0] = af.x; at[astr] = af.y; at[2 * astr] = af.z; at[3 * astr] = af.w;
        }
        unsigned char* hrow = H2 + (size_t)row * 1024 + q * 16;
#pragma unroll
        for (int p = 0; p < 16; ++p) {
            const LAS f32x4* ca = (const LAS f32x4*)(CA + p * 64 + q * 16); const LAS f32x4* cb = (const LAS f32x4*)(CB + p * 64 + q * 16);
            v4u o;
#pragma unroll
            for (int hh = 0; hh < 2; ++hh) {
                const v4u xv = x[2 * p + hh]; const f32x4 a0 = ca[2 * hh], a1 = ca[2 * hh + 1], b0 = cb[2 * hh], b1 = cb[2 * hh + 1];
                const unsigned w0 = pk4_fp8(clampf_(bflo(xv.x) * rstd * a0.x + b0.x, 448.f), clampf_(bfhi(xv.x) * rstd * a0.y + b0.y, 448.f), clampf_(bflo(xv.y) * rstd * a0.z + b0.z, 448.f), clampf_(bfhi(xv.y) * rstd * a0.w + b0.w, 448.f));
                const unsigned w1 = pk4_fp8(clampf_(bflo(xv.z) * rstd * a1.x + b1.x, 448.f), clampf_(bfhi(xv.z) * rstd * a1.y + b1.y, 448.f), clampf_(bflo(xv.w) * rstd * a1.z + b1.z, 448.f), clampf_(bfhi(xv.w) * rstd * a1.w + b1.w, 448.f));
                if (hh == 0) { o.x = w0; o.y = w1; } else { o.z = w0; o.w = w1; }
            }
            *(v4u*)(hrow + p * 64) = o;
        }
    }
    __syncthreads();
}

__device__ __forceinline__ void topk_phase(Frame& F, int layer) {
    LAS unsigned* vals = (LAS unsigned*)F.lds;
    LAS unsigned* hist = vals + 4096;
    LAS unsigned* wsum = hist + 256;
    LAS unsigned* sel = wsum + 16;
    const bool need_ctx = layer < DEPTH - 1;
    const int nunits = need_ctx ? 256 : 128;
    const float* AFFT = (const float*)(F.ws + WS_AFFT);
    int* INV = (int*)(F.ws + WS_INV); int* SRC = (int*)(F.ws + WS_SRC);
    for (int u = blockIdx.x; u < nunits; u += F.G) {
        const bool isctx = u >= 128; const int be = u & 127, b = be >> 4, e = be & 15;
        const int n = isctx ? 256 : 4096, cap = isctx ? CAP_C : CAP_L;
        const float* src = isctx ? AFFT + (size_t)NLAT * 16 + (size_t)be * 256 : AFFT + (size_t)be * 4096;
        const int per = isctx ? 1 : 8; const bool act = isctx ? (F.tid < 256) : true;
        unsigned mv[8];
#pragma unroll
        for (int j = 0; j < 8; ++j) { mv[j] = 0u; if (act && j < per) { mv[j] = __builtin_bit_cast(unsigned, src[F.tid * per + j]); vals[F.tid * per + j] = mv[j]; } }
        __syncthreads();
        unsigned prefix = 0u, pmask = 0u; int need = cap;
        for (int pass = 0; pass < 4; ++pass) {
            const int shift = 24 - 8 * pass;
            if (F.tid < 256) hist[F.tid] = 0u;
            __syncthreads();
            for (int i = F.tid; i < n; i += NT) { const unsigned v = vals[i]; if ((v & pmask) == prefix) __hip_atomic_fetch_add(&hist[(v >> shift) & 255u], 1u, __ATOMIC_RELAXED, __HIP_MEMORY_SCOPE_WORKGROUP); }
            __syncthreads();
            if (F.wave == 0) {
                const unsigned c0 = hist[4 * F.lane], c1 = hist[4 * F.lane + 1], c2 = hist[4 * F.lane + 2], c3 = hist[4 * F.lane + 3];
                const unsigned sl = c0 + c1 + c2 + c3; unsigned incl = sl;
#pragma unroll
                for (int o = 1; o < 64; o <<= 1) { const unsigned t = __shfl_down(incl, o); if (F.lane + o < 64) incl += t; }
                const unsigned ab3 = incl - sl, ab2 = ab3 + c3, ab1 = ab2 + c2, ab0 = ab1 + c1;
                const unsigned nd = (unsigned)need;
                if (ab3 < nd && ab3 + c3 >= nd) { sel[0] = 4u * F.lane + 3u; sel[1] = nd - ab3; }
                if (ab2 < nd && ab2 + c2 >= nd) { sel[0] = 4u * F.lane + 2u; sel[1] = nd - ab2; }
                if (ab1 < nd && ab1 + c1 >= nd) { sel[0] = 4u * F.lane + 1u; sel[1] = nd - ab1; }
                if (ab0 < nd && ab0 + c0 >= nd) { sel[0] = 4u * F.lane; sel[1] = nd - ab0; }
            }
            __syncthreads();
            prefix |= sel[0] << shift; pmask |= 255u << shift; need = (int)sel[1];
            __syncthreads();
        }
        const unsigned T = prefix;
        unsigned cg = 0u, ce = 0u;
#pragma unroll
        for (int j = 0; j < 8; ++j) if (act && j < per) { cg += (mv[j] > T) ? 1u : 0u; ce += (mv[j] == T) ? 1u : 0u; }
        unsigned pk = cg | (ce << 16), incl = pk;
#pragma unroll
        for (int o = 1; o < 64; o <<= 1) { const unsigned t = __shfl_up(incl, o); if (F.lane >= o) incl += t; }
        if (F.lane == 63) wsum[F.wave] = incl;
        __syncthreads();
        unsigned base = 0u;
        for (int w = 0; w < F.wave; ++w) base += wsum[w];
        unsigned excl = base + incl - pk;
        unsigned g0 = excl & 0xffffu, e0 = excl >> 16;
        if (act) {
#pragma unroll
            for (int j = 0; j < 8; ++j) if (j < per) {
                const int t = F.tid * per + j; const bool gt = mv[j] > T, eq = mv[j] == T;
                const bool s = gt || (eq && (int)e0 < need);
                const int slot = (int)g0 + ((int)e0 < need ? (int)e0 : need);
                const int hrow = isctx ? NLAT + b * 256 + t : b * 4096 + t;
                const int gi = isctx ? BATCH * CAP_L + b * CAP_C + slot : b * CAP_L + slot;
                INV[(isctx ? (size_t)NLAT * 16 + (size_t)be * 256 : (size_t)be * 4096) + t] = s ? gi : -1;
                if (s) SRC[e * EROWS + gi] = hrow;
                g0 += gt ? 1u : 0u; e0 += eq ? 1u : 0u;
            }
        }
        __syncthreads();
    }
}

template <int W> __device__ __forceinline__ void store_bf16(bf16* p, const float (&v)[W]) {
    if constexpr (W == 4) { v2u w; w.x = pk2(v[0], v[1]); w.y = pk2(v[2], v[3]); *(v2u*)p = w; }
    else { v4u w; w.x = pk2(v[0], v[1]); w.y = pk2(v[2], v[3]); w.z = pk2(v[4], v[5]); w.w = pk2(v[6], v[7]); *(v4u*)p = w; }
}
struct EpiInEven {
    static constexpr int GROUPS = 4;
    bf16* Z; const float* cosa; const float* sina;
    template <int W> __device__ __forceinline__ void chunk(int row, int col, const float (&v)[W]) const {
        float o[W];
        if (col < 128 || (col >= 256 && col < 768)) {
            const float qs = col >= 256 ? QSCALE_E : 1.0f;
            if (row < NLAT) { const int pos = row & 4095, i0 = (col & 63) >> 1;
                float cc[W / 2], ss[W / 2];
                if constexpr (W == 8) { const f32x4 c4 = *(const f32x4*)(cosa + pos * 32 + i0), s4 = *(const f32x4*)(sina + pos * 32 + i0); cc[0] = c4.x; cc[1] = c4.y; cc[2] = c4.z; cc[3] = c4.w; ss[0] = s4.x; ss[1] = s4.y; ss[2] = s4.z; ss[3] = s4.w; }
                else {
#pragma unroll
                    for (int p = 0; p < W / 2; ++p) { cc[p] = cosa[pos * 32 + i0 + p]; ss[p] = sina[pos * 32 + i0 + p]; } }
#pragma unroll
                for (int p = 0; p < W / 2; ++p) { const float c = cc[p] * qs, s = ss[p] * qs; o[2 * p] = v[2 * p] * c - v[2 * p + 1] * s; o[2 * p + 1] = v[2 * p + 1] * c + v[2 * p] * s; } }
            else {
#pragma unroll
                for (int j = 0; j < W; ++j) o[j] = v[j] * qs; }
        } else if (col >= 768) {
#pragma unroll
            for (int j = 0; j < W; j += 2) { const f32x2_ g = gelu_tanh2((f32x2_){v[j], v[j + 1]}); o[j] = g.x; o[j + 1] = g.y; }
        } else {
#pragma unroll
            for (int j = 0; j < W; ++j) o[j] = v[j];
        }
        store_bf16<W>(Z + (size_t)row * ZE + col, o);
    }
};
struct EpiInOdd {
    static constexpr int GROUPS = 4;
    bf16* Z; const float* cosc; const float* sinc; unsigned long long* rs;
    template <int W> __device__ __forceinline__ float ssq(const float (&v)[W]) const { float s = 0.f;
#pragma unroll
        for (int j = 0; j < W; ++j) s += v[j] * v[j]; return s; }
    __device__ __forceinline__ int stat_kind(int col) const { return col < 256 ? 1 : (col < 640 ? 2 : 0); }
    __device__ __forceinline__ void add_stat(int row, int kind, float s) const { atomicAdd(rs + (kind == 1 ? MT : 0) + row, (unsigned long long)(s * RS_SCALE)); }
    template <int W> __device__ __forceinline__ void chunk(int row, int col, const float (&v)[W]) const {
        float o[W];
        if (col >= 640 && col < 672 && row < NLAT) { const int pos = row & 4095, i0 = (col - 640) >> 1;
#pragma unroll
            for (int p = 0; p < W / 2; ++p) { const float c = cosc[pos * 16 + i0 + p], s = sinc[pos * 16 + i0 + p]; o[2 * p] = v[2 * p] * c - v[2 * p + 1] * s; o[2 * p + 1] = v[2 * p + 1] * c + v[2 * p] * s; }
        } else {
#pragma unroll
            for (int j = 0; j < W; ++j) o[j] = v[j];
        }
        store_bf16<W>(Z + (size_t)row * ZO + col, o);
    }
};
struct EpiUpQ {
    static constexpr int GROUPS = 4;
    bf16* Q; const float* cosc; const float* sinc; const unsigned long long* rs;
    template <int W> __device__ __forceinline__ void chunk(int row, int col, const float (&v)[W]) const {
        const float rstd = QSCALE_O * __builtin_amdgcn_rsqf((float)rs[row] * (RS_INV / 384.0f) + EPS);
        float o[W]; const int w = col % 96;
        if (w >= 64 && row < NLAT) { const int pos = row & 4095, i0 = (w - 64) >> 1;
#pragma unroll
            for (int p = 0; p < W / 2; ++p) { const float c = cosc[pos * 16 + i0 + p], s = sinc[pos * 16 + i0 + p]; o[2 * p] = (v[2 * p] * c - v[2 * p + 1] * s) * rstd; o[2 * p + 1] = (v[2 * p + 1] * c + v[2 * p] * s) * rstd; }
        } else {
#pragma unroll
            for (int j = 0; j < W; ++j) o[j] = v[j] * rstd;
        }
        store_bf16<W>(Q + (size_t)row * 768 + col, o);
    }
};
struct EpiUpKV {
    static constexpr int GROUPS = 4;
    bf16* KV; const unsigned long long* rs;
    template <int W> __device__ __forceinline__ void chunk(int row, int col, const float (&v)[W]) const {
        const float rstd = __builtin_amdgcn_rsqf((float)rs[MT + row] * (RS_INV / 256.0f) + EPS);
        float o[W];
#pragma unroll
        for (int j = 0; j < W; ++j) o[j] = v[j] * rstd;
        store_bf16<W>(KV + (size_t)row * 1024 + col, o);
    }
};
struct EpiOut {
    static constexpr int GROUPS = 2;
    bf16* X; const float* mod;
    static constexpr bool GATES = true;
    __device__ __forceinline__ void gates(int row0, int col, f32x4& g0, f32x4& g1) const { const float* g = mod + ((size_t)row_r(row0) * 6 + 2) * 1024 + col; g0 = *(const f32x4*)g; g1 = *(const f32x4*)(g + 4); }
    __device__ __forceinline__ v4u preload(int row, int col) const { return *(const v4u*)(X + (size_t)row * 1024 + col); }
    __device__ __forceinline__ void chunk_gx(int row, int col, const float (&v)[8], const f32x4 g0, const f32x4 g1, const v4u xv) const {
        v4u o;
        o.x = pk2(bflo(xv.x) + g0.x * v[0], bfhi(xv.x) + g0.y * v[1]); o.y = pk2(bflo(xv.y) + g0.z * v[2], bfhi(xv.y) + g0.w * v[3]);
        o.z = pk2(bflo(xv.z) + g1.x * v[4], bfhi(xv.z) + g1.y * v[5]); o.w = pk2(bflo(xv.w) + g1.z * v[6], bfhi(xv.w) + g1.w * v[7]);
        *(v4u*)(X + (size_t)row * 1024 + col) = o;
    }
    __device__ __forceinline__ void chunk_g(int row, int col, const float (&v)[8], const f32x4 g0, const f32x4 g1) const {
        bf16* x = X + (size_t)row * 1024 + col; const v4u xv = *(const v4u*)x; v4u o;
        o.x = pk2(bflo(xv.x) + g0.x * v[0], bfhi(xv.x) + g0.y * v[1]); o.y = pk2(bflo(xv.y) + g0.z * v[2], bfhi(xv.y) + g0.w * v[3]);
        o.z = pk2(bflo(xv.z) + g1.x * v[4], bfhi(xv.z) + g1.y * v[5]); o.w = pk2(bflo(xv.w) + g1.z * v[6], bfhi(xv.w) + g1.w * v[7]);
        *(v4u*)x = o;
    }
    template <int W> __device__ __forceinline__ void chunk(int row, int col, const float (&v)[W]) const {
        const float* g = mod + ((size_t)row_r(row) * 6 + 2) * 1024 + col;
        bf16* x = X + (size_t)row * 1024 + col;
        if constexpr (W == 8) {
            const f32x4 g0 = *(const f32x4*)g, g1 = *(const f32x4*)(g + 4); const v4u xv = *(const v4u*)x; v4u o;
            o.x = pk2(bflo(xv.x) + g0.x * v[0], bfhi(xv.x) + g0.y * v[1]); o.y = pk2(bflo(xv.y) + g0.z * v[2], bfhi(xv.y) + g0.w * v[3]);
            o.z = pk2(bflo(xv.z) + g1.x * v[4], bfhi(xv.z) + g1.y * v[5]); o.w = pk2(bflo(xv.w) + g1.z * v[6], bfhi(xv.w) + g1.w * v[7]);
            *(v4u*)x = o;
        } else {
#pragma unroll
            for (int j = 0; j < W; j += 4) { const f32x4 gv = *(const f32x4*)(g + j); const v2u xv = *(const v2u*)(x + j); v2u o;
                o.x = pk2(bflo(xv.x) + gv.x * v[j], bfhi(xv.x) + gv.y * v[j + 1]); o.y = pk2(bflo(xv.y) + gv.z * v[j + 2], bfhi(xv.y) + gv.w * v[j + 3]); *(v2u*)(x + j) = o; }
        }
    }
};
struct EpiNull {
    static constexpr int GROUPS = 1;
    template <int W> __device__ __forceinline__ void chunk(int, int, const float (&v)[W]) const {
#pragma unroll
        for (int j = 0; j < W; ++j) asm volatile("" :: "v"(v[j])); }
};
struct EpiF1 {
    static constexpr int GROUPS = 1;
    bf16* Gm;
    static constexpr bool PAIR = (FP8_F2 != 0);
    __device__ __forceinline__ v2u pack8(const float (&a)[8], const float (&b)[8]) const {
        float o[8];
#pragma unroll
        for (int j = 0; j < 8; j += 2) { constexpr int SIN = FP8_F1 ? (int)(F8_SA * F8_SW) : 1, SOUT = (int)F8_SG;
            const f32x2_ g = silu_gate2<SIN, SOUT>((f32x2_){a[j], a[j + 1]}, (f32x2_){b[j], b[j + 1]}); o[j] = clampf_(g.x, 448.f); o[j + 1] = clampf_(g.y, 448.f); }
        v2u w; w.x = pk4_fp8(o[0], o[1], o[2], o[3]); w.y = pk4_fp8(o[4], o[5], o[6], o[7]); return w;
    }
    __device__ __forceinline__ void pair_dual(int row, int f, int fq, const float (&a0)[8], const float (&b0)[8], const float (&a1)[8], const float (&b1)[8]) const {
        v2u x = pack8(a0, b0), y = pack8(a1, b1);
        asm volatile("s_nop 1\n\tv_permlane16_swap_b32 %0, %1" : "+v"(x.x), "+v"(y.x));
        asm volatile("s_nop 1\n\tv_permlane16_swap_b32 %0, %1" : "+v"(x.y), "+v"(y.y));
        const bool odd = fq & 1;
        *(v4u*)((unsigned char*)Gm + (size_t)(row + (odd ? 16 : 0)) * 1024 + f - (odd ? 8 : 0)) = (v4u){x.x, x.y, y.x, y.y};
    }
    template <int W> __device__ __forceinline__ void dual(int row, int f, const float (&a)[W], const float (&b)[W]) const {
        float o[W];
        constexpr float inv = FP8_F1 ? 1.0f / (F8_SA * F8_SW) : 1.0f;
#pragma unroll
        for (int j = 0; j < W; j += 2) { constexpr int SIN = FP8_F1 ? (int)(F8_SA * F8_SW) : 1, SOUT = FP8_F2 ? (int)F8_SG : 1;
            const f32x2_ g = silu_gate2<SIN, SOUT>((f32x2_){a[j], a[j + 1]}, (f32x2_){b[j], b[j + 1]}); o[j] = g.x; o[j + 1] = g.y; }
        if constexpr (FP8_F2) {
#pragma unroll
            for (int j = 0; j < W; ++j) o[j] = clampf_(o[j], 448.f);
            unsigned char* gp = (unsigned char*)Gm + (size_t)row * 1024 + f;
            if constexpr (W == 8) { v2u w; w.x = pk4_fp8(o[0], o[1], o[2], o[3]); w.y = pk4_fp8(o[4], o[5], o[6], o[7]); *(v2u*)gp = w; }
            else *(unsigned*)gp = pk4_fp8(o[0], o[1], o[2], o[3]);
        } else store_bf16<W>(Gm + (size_t)row * 1024 + f, o);
    }
};
struct EpiF2 {
    static constexpr int GROUPS = 1;
    bf16* Y;
    static constexpr bool PAIR = (FP8_Y != 0);
    __device__ __forceinline__ v2u pack8(const float (&v)[8]) const {
        constexpr float sc = (FP8_F2 ? 1.0f / (F8_SG * F8_SW) : 1.0f) * F8_SY;
        float o[8];
#pragma unroll
        for (int j = 0; j < 8; j += 2) { const f32x2_ t = (f32x2_){v[j], v[j + 1]} * sc; o[j] = clampf_(t.x, 448.f); o[j + 1] = clampf_(t.y, 448.f); }
        v2u w; w.x = pk4_fp8(o[0], o[1], o[2], o[3]); w.y = pk4_fp8(o[4], o[5], o[6], o[7]); return w;
    }
    __device__ __forceinline__ void pair(int row, int col, int fq, const float (&va)[8], const float (&vb)[8]) const {
        v2u a = pack8(va), b = pack8(vb);
        asm volatile("s_nop 1\n\tv_permlane16_swap_b32 %0, %1" : "+v"(a.x), "+v"(b.x));
        asm volatile("s_nop 1\n\tv_permlane16_swap_b32 %0, %1" : "+v"(a.y), "+v"(b.y));
        const bool odd = fq & 1;
        *(v4u*)((unsigned char*)Y + (size_t)(row + (odd ? 16 : 0)) * 1024 + col - (odd ? 8 : 0)) = (v4u){a.x, a.y, b.x, b.y};
    }
    template <int W> __device__ __forceinline__ void chunk(int row, int col, const float (&v)[W]) const {
        constexpr float sc = (FP8_F2 ? 1.0f / (F8_SG * F8_SW) : 1.0f) * (FP8_Y ? F8_SY : 1.0f);
        float o[W];
#pragma unroll
        for (int j = 0; j < W; j += 2) { const f32x2_ t = (f32x2_){v[j], v[j + 1]} * sc; o[j] = t.x; o[j + 1] = t.y; }
        if constexpr (FP8_Y) {
#pragma unroll
            for (int j = 0; j < W; ++j) o[j] = clampf_(o[j], 448.f);
            unsigned char* yp = (unsigned char*)Y + (size_t)row * 1024 + col;
            if constexpr (W == 8) { v2u w; w.x = pk4_fp8(o[0], o[1], o[2], o[3]); w.y = pk4_fp8(o[4], o[5], o[6], o[7]); *(v2u*)yp = w; }
            else *(unsigned*)yp = pk4_fp8(o[0], o[1], o[2], o[3]);
        } else store_bf16<W>(Y + (size_t)row * 1024 + col, o);
    }
};

namespace pg8 {
#define PG8_LAS __attribute__((address_space(3)))
typedef unsigned short bf16_t;
typedef short bf16x8 __attribute__((ext_vector_type(8)));
typedef float f32x4 __attribute__((ext_vector_type(4)));
typedef int v8i_t __attribute__((ext_vector_type(8)));
typedef int v4i_t __attribute__((ext_vector_type(4)));
constexpr int BM = 256, BK = 64, HALF = 128, HTB = HALF * BK * 2, STAGE_BYTES = 8 * HTB, NXCD = 8, WGM = 8;
template <int SW> __host__ __device__ __forceinline__ int lds_byte(int r, int c) { const int st = (r >> 4) * 2 + (c >> 5), rr = r & 15, cc = c & 31, ob = rr * 64 + cc * 2; return st * 1024 + (ob ^ (((ob >> 9) & 1) << SW)); }
template <int SW> __host__ __device__ __forceinline__ void stage_rc(int b, int& R, int& C) { const int st = b / 1024, sb = b % 1024, swz = sb ^ (((sb >> 9) & 1) << SW); R = (st >> 1) * 16 + swz / 64; C = (st & 1) * 32 + (swz % 64) / 2; }
__host__ __device__ __forceinline__ int perm32(int rho) { const int n = rho >> 4, i = rho & 15; return 8 * (i >> 2) + 4 * n + (i & 3); }
struct Unit { int pm, pn, brow; };
struct Gemm { const bf16_t* A; const bf16_t* Bt; int lda, ldb, K; const int* gather; };
struct StaticOrder {
    int nM, nN, nwg, G, c, bpe, lat_only;
    __device__ void init(int M, int N, int G_, int c_, int bpe_, int lat_only_ = 0) { nM = M / BM; nN = N / BM; nwg = nM * nN; G = G_; c = c_; bpe = bpe_; lat_only = lat_only_; }
    __device__ bool next(int i, Unit& u) const {
        const long L = (long)i * G + c; if (L >= nwg) return false;
        int wgid = (int)L; { const int q = nwg / NXCD, r = nwg % NXCD, xcd = wgid % NXCD, off = wgid / NXCD; wgid = (xcd < r ? xcd * (q + 1) : r * (q + 1) + (xcd - r) * q) + off; }
        const int nig = WGM * nN, gid = wgid / nig, fm = gid * WGM, gsz = (nM - fm) < WGM ? (nM - fm) : WGM;
        u.pm = fm + ((wgid % nig) % gsz); u.pn = (wgid % nig) / gsz; if (lat_only) u.pm = (u.pm >> 4) * 17 + (u.pm & 15); u.brow = u.pn * BM + (bpe ? (u.pm / 17) * bpe : 0); return true;
    }
};
template <class E, class = void> struct EpiGates { static constexpr bool value = false; };
template <class E> struct EpiGates<E, decltype((void)E::GATES, void())> { static constexpr bool value = E::GATES; };
template <class E, class = void> struct EpiPair { static constexpr bool value = false; };
template <class E> struct EpiPair<E, decltype((void)E::PAIR, void())> { static constexpr bool value = E::PAIR; };
template <bool DUAL, int STAT, class E>
__device__ __forceinline__ void run_epi(const E& e, const f32x4 (&acc)[2][2][4][2], const Unit& u, int wr, int wc, int fr, int fq) {
    if constexpr (EpiGates<E>::value && !DUAL && STAT == 0) {
        f32x4 g0[2], g1[2];
#pragma unroll
        for (int bj = 0; bj < 2; ++bj) e.gates(u.pm * BM, u.pn * BM + bj * HALF + wc * 32 + 8 * fq, g0[bj], g1[bj]);
        v4u xp[2][4][2];
#pragma unroll
        for (int ai = 0; ai < 2; ++ai)
#pragma unroll
            for (int m = 0; m < 4; ++m)
#pragma unroll
                for (int bj = 0; bj < 2; ++bj) xp[ai][m][bj] = e.preload(u.pm * BM + ai * HALF + wr * 64 + m * 16 + fr, u.pn * BM + bj * HALF + wc * 32 + 8 * fq);
#pragma unroll
        for (int ai = 0; ai < 2; ++ai)
#pragma unroll
            for (int m = 0; m < 4; ++m)
#pragma unroll
                for (int bj = 0; bj < 2; ++bj) {
                    const float v[8] = {acc[ai][bj][m][0][0], acc[ai][bj][m][0][1], acc[ai][bj][m][0][2], acc[ai][bj][m][0][3], acc[ai][bj][m][1][0], acc[ai][bj][m][1][1], acc[ai][bj][m][1][2], acc[ai][bj][m][1][3]};
                    e.chunk_gx(u.pm * BM + ai * HALF + wr * 64 + m * 16 + fr, u.pn * BM + bj * HALF + wc * 32 + 8 * fq, v, g0[bj], g1[bj], xp[ai][m][bj]);
                }
        return;
    }
    if constexpr (EpiPair<E>::value && DUAL) {
#pragma unroll
        for (int ai = 0; ai < 2; ++ai)
#pragma unroll
            for (int m = 0; m < 4; m += 2) {
                const float a0[8] = {acc[ai][0][m][0][0], acc[ai][0][m][0][1], acc[ai][0][m][0][2], acc[ai][0][m][0][3], acc[ai][0][m][1][0], acc[ai][0][m][1][1], acc[ai][0][m][1][2], acc[ai][0][m][1][3]};
                const float b0[8] = {acc[ai][1][m][0][0], acc[ai][1][m][0][1], acc[ai][1][m][0][2], acc[ai][1][m][0][3], acc[ai][1][m][1][0], acc[ai][1][m][1][1], acc[ai][1][m][1][2], acc[ai][1][m][1][3]};
                const float a1[8] = {acc[ai][0][m + 1][0][0], acc[ai][0][m + 1][0][1], acc[ai][0][m + 1][0][2], acc[ai][0][m + 1][0][3], acc[ai][0][m + 1][1][0], acc[ai][0][m + 1][1][1], acc[ai][0][m + 1][1][2], acc[ai][0][m + 1][1][3]};
                const float b1[8] = {acc[ai][1][m + 1][0][0], acc[ai][1][m + 1][0][1], acc[ai][1][m + 1][0][2], acc[ai][1][m + 1][0][3], acc[ai][1][m + 1][1][0], acc[ai][1][m + 1][1][1], acc[ai][1][m + 1][1][2], acc[ai][1][m + 1][1][3]};
                e.pair_dual(u.pm * BM + ai * HALF + wr * 64 + m * 16 + fr, u.pn * HALF + wc * 32 + 8 * fq, fq, a0, b0, a1, b1);
            }
        return;
    }
    if constexpr (EpiPair<E>::value && !DUAL && STAT == 0) {
#pragma unroll
        for (int ai = 0; ai < 2; ++ai)
#pragma unroll
            for (int m = 0; m < 4; m += 2)
#pragma unroll
                for (int bj = 0; bj < 2; ++bj) {
                    const float va[8] = {acc[ai][bj][m][0][0], acc[ai][bj][m][0][1], acc[ai][bj][m][0][2], acc[ai][bj][m][0][3], acc[ai][bj][m][1][0], acc[ai][bj][m][1][1], acc[ai][bj][m][1][2], acc[ai][bj][m][1][3]};
                    const float vb[8] = {acc[ai][bj][m + 1][0][0], acc[ai][bj][m + 1][0][1], acc[ai][bj][m + 1][0][2], acc[ai][bj][m + 1][0][3], acc[ai][bj][m + 1][1][0], acc[ai][bj][m + 1][1][1], acc[ai][bj][m + 1][1][2], acc[ai][bj][m + 1][1][3]};
                    e.pair(u.pm * BM + ai * HALF + wr * 64 + m * 16 + fr, u.pn * BM + bj * HALF + wc * 32 + 8 * fq, fq, va, vb);
                }
        return;
    }
#pragma unroll
    for (int ai = 0; ai < 2; ++ai)
#pragma unroll
        for (int m = 0; m < 4; ++m) {
            const int row = u.pm * BM + ai * HALF + wr * 64 + m * 16 + fr;
            if constexpr (DUAL) {
                const float a[8] = {acc[ai][0][m][0][0], acc[ai][0][m][0][1], acc[ai][0][m][0][2], acc[ai][0][m][0][3], acc[ai][0][m][1][0], acc[ai][0][m][1][1], acc[ai][0][m][1][2], acc[ai][0][m][1][3]};
                const float b[8] = {acc[ai][1][m][0][0], acc[ai][1][m][0][1], acc[ai][1][m][0][2], acc[ai][1][m][0][3], acc[ai][1][m][1][0], acc[ai][1][m][1][1], acc[ai][1][m][1][2], acc[ai][1][m][1][3]};
                e.template dual<8>(row, u.pn * HALF + wc * 32 + 8 * fq, a, b);
            } else {
#pragma unroll
                for (int bj = 0; bj < 2; ++bj) {
                    const int col = u.pn * BM + bj * HALF + wc * 32 + 8 * fq;
                    const float v[8] = {acc[ai][bj][m][0][0], acc[ai][bj][m][0][1], acc[ai][bj][m][0][2], acc[ai][bj][m][0][3], acc[ai][bj][m][1][0], acc[ai][bj][m][1][1], acc[ai][bj][m][1][2], acc[ai][bj][m][1][3]};
                    if constexpr (STAT) { const int kind = e.stat_kind(u.pn * BM + bj * HALF + wc * 32);
                        if (kind) { float s = e.template ssq<8>(v); s += __shfl_xor(s, 16); s += __shfl_xor(s, 32); if (fq == 0) e.add_stat(row, kind, s); } }
                    e.template chunk<8>(row, col, v);
                }
            }
            if ((m % E::GROUPS) == E::GROUPS - 1) asm volatile("" ::: "memory");
        }
}
template <bool DUAL, int STAT, bool GATHER, bool FP8, class Epi, class Sched>
__device__ __forceinline__ void gemm_phase(PG8_LAS unsigned char* lds, const Gemm g, const Sched& S, const Epi& E, const int tid  ) {
    const int wid = __builtin_amdgcn_readfirstlane(tid >> 6), lane = tid & 63, wr = wid >> 2, wc = wid & 3, fr = lane & 15, fq = lane >> 4;
    const int K = g.K, nt = K / BK;
    int RA[2], CA[2]; unsigned voffA[2], voffB[2];
#pragma unroll
    for (int i = 0; i < 2; ++i) { int R, C; stage_rc<FP8 ? 4 : 5>(tid * 16 + i * 8192, R, C); RA[i] = R; CA[i] = C; const int Rb = (R & ~31) + perm32(R & 31); voffA[i] = (unsigned)(R * g.lda + C) * 2u; voffB[i] = (unsigned)(Rb * g.ldb + C) * 2u; }
    const size_t kstep = (size_t)(BK * 2);
    const size_t hstepB = (size_t)HALF * g.ldb * 2, hstepA = (size_t)HALF * g.lda * 2, tstepA = 2 * hstepA;
    const unsigned ldsw = (unsigned)wid * 1024u;
    const int aoff = FP8 ? lds_byte<4>(wr * 64 + fr, fq * 16) : lds_byte<5>(wr * 64 + fr, fq * 8), boff = FP8 ? lds_byte<4>(wc * 32 + fr, fq * 16) : lds_byte<5>(wc * 32 + fr, fq * 8);
#define PG8_SA(b, h) (((b) * 2 + (h)) * HTB)
#define PG8_SB(b, h) ((4 + (b) * 2 + (h)) * HTB)
#define PG8_STAGE(bufoff, gbase, voff) do { _Pragma("unroll") for (int _i = 0; _i < 2; ++_i) \
        __builtin_amdgcn_global_load_lds((const unsigned*)((const char*)(gbase) + (voff)[_i]), (PG8_LAS unsigned*)(lds + (bufoff) + ldsw + _i * 8192), 16, 0, 0); } while (0)
#define PG8_LD16(p_) (*(const PG8_LAS v4i_t*)(p_))
#define PG8_LDA(dst, b, h) do { _Pragma("unroll") for (int m = 0; m < 4; ++m) { \
        if constexpr (FP8) { const v4i_t lo_ = PG8_LD16(lds + PG8_SA(b, h) + aoff + m * 2048), hi_ = PG8_LD16(lds + PG8_SA(b, h) + ((aoff + m * 2048) ^ 16)); dst##8[m] = __builtin_shufflevector(lo_, hi_, 0, 1, 2, 3, 4, 5, 6, 7); } \
        else { _Pragma("unroll") for (int k = 0; k < 2; ++k) dst[m][k] = *(const PG8_LAS bf16x8*)(lds + PG8_SA(b, h) + aoff + m * 2048 + k * 1024); } } } while (0)
#define PG8_LDB(dst, b, h) do { _Pragma("unroll") for (int n = 0; n < 2; ++n) { \
        if constexpr (FP8) { const v4i_t lo_ = PG8_LD16(lds + PG8_SB(b, h) + boff + n * 2048), hi_ = PG8_LD16(lds + PG8_SB(b, h) + ((boff + n * 2048) ^ 16)); dst##8[n] = __builtin_shufflevector(lo_, hi_, 0, 1, 2, 3, 4, 5, 6, 7); } \
        else { _Pragma("unroll") for (int k = 0; k < 2; ++k) dst[n][k] = *(const PG8_LAS bf16x8*)(lds + PG8_SB(b, h) + boff + n * 2048 + k * 1024); } } } while (0)
#define PG8_MMA(ai, bj, At, Bt) do { __builtin_amdgcn_s_setprio(1); _Pragma("unroll") for (int m = 0; m < 4; ++m) _Pragma("unroll") for (int n = 0; n < 2; ++n) { \
        if constexpr (FP8) asm volatile("v_mfma_scale_f32_16x16x128_f8f6f4 %0, %1, %2, %0, %3, %3 op_sel_hi:[0,0,0]" : "+v"(acc[ai][bj][m][n]) : "v"(Bt##8[n]), "v"(At##8[m]), "v"(one_scale));   \
        else { _Pragma("unroll") for (int k = 0; k < 2; ++k) acc[ai][bj][m][n] = __builtin_amdgcn_mfma_f32_16x16x32_bf16(Bt[n][k], At[m][k], acc[ai][bj][m][n], 0, 0, 0); } } __builtin_amdgcn_s_setprio(0); } while (0)
#define PG8_WAIT_V(n) asm volatile("s_waitcnt vmcnt(" #n ")" ::: "memory")
#define PG8_WAIT_L(n) asm volatile("s_waitcnt lgkmcnt(" #n ")" ::: "memory")
#define PG8_BAR __builtin_amdgcn_s_barrier()
#define PG8_SCHED __builtin_amdgcn_sched_barrier(0)
#define PG8_AOFFS(dst, u) do { _Pragma("unroll") for (int _h = 0; _h < 2; ++_h) _Pragma("unroll") for (int _i = 0; _i < 2; ++_i) { const int _m = (u).pm * BM + _h * HALF + RA[_i]; \
        const int _r = g.gather ? g.gather[_m] : _m; dst[_h][_i] = (unsigned)(_r * g.lda + CA[_i]) * 2u; } } while (0)
    Unit cur, nxt; int ui = 0;
    if (!S.next(0, cur)) return;
    f32x4 acc[2][2][4][2];
#pragma unroll
    for (int a = 0; a < 2; ++a)
#pragma unroll
        for (int b = 0; b < 2; ++b)
#pragma unroll
            for (int m = 0; m < 4; ++m)
#pragma unroll
                for (int n = 0; n < 2; ++n) acc[a][b][m][n] = (f32x4){0.f, 0.f, 0.f, 0.f};
    bf16x8 At[FP8 ? 1 : 4][2], B0[FP8 ? 1 : 2][2], B1[FP8 ? 1 : 2][2];
    v8i_t At8[FP8 ? 4 : 1], B08[FP8 ? 2 : 1], B18[FP8 ? 2 : 1];
    int one_scale = 0x7f7f7f7f; asm volatile("" : "+v"(one_scale));
    unsigned curA[GATHER ? 2 : 1][2], nxtA[GATHER ? 2 : 1][2];
    const char* cA = (const char*)g.A; const char* nA = cA;
    if constexpr (GATHER) { PG8_AOFFS(curA, cur); } else { cA += (size_t)cur.pm * tstepA; }
#define PG8_STA(bufoff, base, offs, h, kof) do { if constexpr (GATHER) { PG8_STAGE(bufoff, (base) + (kof), (offs)[h]); } else { PG8_STAGE(bufoff, (base) + (kof) + (h) * hstepA, voffA); } } while (0)
    const char* cB = (const char*)g.Bt + (size_t)cur.brow * g.ldb * 2;
    PG8_STAGE(PG8_SB(0, 0), cB, voffB); PG8_STAGE(PG8_SB(0, 1), cB + hstepB, voffB); PG8_STA(PG8_SA(0, 0), cA, curA, 0, 0); PG8_STA(PG8_SA(0, 1), cA, curA, 1, 0);
    if (wr == 1) PG8_BAR;
    PG8_WAIT_V(2); PG8_BAR;
    PG8_STAGE(PG8_SB(1, 0), cB + kstep, voffB); PG8_STA(PG8_SA(1, 0), cA, curA, 0, kstep); PG8_STAGE(PG8_SB(1, 1), cB + hstepB + kstep, voffB);
    PG8_WAIT_V(6); PG8_BAR;
    for (;;) {
        const bool has_next = S.next(ui + 1, nxt);
        if constexpr (GATHER) {
            if (has_next) { PG8_AOFFS(nxtA, nxt); }
            else {
#pragma unroll
                for (int h = 0; h < 2; ++h)
#pragma unroll
                    for (int i = 0; i < 2; ++i) nxtA[h][i] = curA[h][i]; }
        } else nA = has_next ? (const char*)g.A + (size_t)nxt.pm * tstepA : cA;
        const char* nB = has_next ? (const char*)g.Bt + (size_t)nxt.brow * g.ldb * 2 : cB;
#pragma unroll 1
        for (int t = 0; t < nt; t += 2) {
            const bool last = (t == nt - 2);
            const size_t k1 = (size_t)(t + 1) * kstep, k2 = last ? 0 : (size_t)(t + 2) * kstep, k3 = k2 + kstep;
            const char* b2 = last ? nB : cB + (size_t)(t + 2) * kstep; const char* b3 = b2 + kstep;
            const char* a2 = last ? nA : cA;
            unsigned sA[GATHER ? 2 : 1][2];
            if constexpr (GATHER) {
#pragma unroll
                for (int h = 0; h < 2; ++h)
#pragma unroll
                    for (int i = 0; i < 2; ++i) sA[h][i] = last ? nxtA[h][i] : curA[h][i]; }
            PG8_LDB(B0, 0, 0); PG8_LDB(B1, 0, 1); PG8_SCHED; PG8_LDA(At, 0, 0); PG8_STA(PG8_SA(1, 1), cA, curA, 1, k1);
            PG8_WAIT_V(8); PG8_WAIT_L(0); PG8_BAR; PG8_MMA(0, 0, At, B0); PG8_MMA(0, 1, At, B1); PG8_BAR; PG8_SCHED;
            PG8_LDA(At, 0, 1); PG8_STAGE(PG8_SB(0, 0), b2, voffB); PG8_STAGE(PG8_SB(0, 1), b2 + hstepB, voffB); PG8_STA(PG8_SA(0, 0), a2, sA, 0, k2);
            PG8_WAIT_V(8); PG8_WAIT_L(0); PG8_BAR; PG8_MMA(1, 0, At, B0); PG8_MMA(1, 1, At, B1); PG8_BAR; PG8_SCHED;
            PG8_LDB(B0, 1, 0); PG8_LDB(B1, 1, 1); PG8_SCHED; PG8_LDA(At, 1, 0); PG8_STA(PG8_SA(0, 1), a2, sA, 1, k2);
            PG8_WAIT_V(8); PG8_WAIT_L(0); PG8_BAR; PG8_MMA(0, 0, At, B0); PG8_MMA(0, 1, At, B1); PG8_BAR; PG8_SCHED;
            PG8_LDA(At, 1, 1); PG8_STAGE(PG8_SB(1, 0), b3, voffB); PG8_STAGE(PG8_SB(1, 1), b3 + hstepB, voffB); PG8_STA(PG8_SA(1, 0), a2, sA, 0, k3);
            PG8_WAIT_V(8); PG8_WAIT_L(0); PG8_BAR; PG8_MMA(1, 0, At, B0); PG8_MMA(1, 1, At, B1); PG8_BAR; PG8_SCHED;
        }
        if (wr == 0) PG8_BAR;
        if constexpr (FP8) asm volatile("s_nop 15\n\ts_nop 15" ::: "memory");
        run_epi<DUAL, STAT>(E, acc, cur, wr, wc, fr, fq);
        if (!has_next) break;
#pragma unroll
        for (int a = 0; a < 2; ++a)
#pragma unroll
            for (int b = 0; b < 2; ++b)
#pragma unroll
                for (int m = 0; m < 4; ++m)
#pragma unroll
                    for (int n = 0; n < 2; ++n) acc[a][b][m][n] = (f32x4){0.f, 0.f, 0.f, 0.f};
        cur = nxt; cB = nB; cA = nA; ++ui;
        if constexpr (GATHER) {
#pragma unroll
            for (int h = 0; h < 2; ++h)
#pragma unroll
                for (int i = 0; i < 2; ++i) curA[h][i] = nxtA[h][i]; }
        if (wr == 1) PG8_BAR;
    }
    PG8_WAIT_V(0);
    PG8_BAR;
#undef PG8_SA
#undef PG8_SB
#undef PG8_STAGE
#undef PG8_LDA
#undef PG8_LDB
#undef PG8_MMA
#undef PG8_LD16
#undef PG8_WAIT_V
#undef PG8_WAIT_L
#undef PG8_BAR
#undef PG8_SCHED
#undef PG8_AOFFS
#undef PG8_STA
}
}

struct ARowsPlain { const bf16* A; int lda; __device__ __forceinline__ const bf16* operator()(int m) const { return A + (size_t)m * lda; } };
struct ARowsGather { const bf16* A; int lda; const int* src; __device__ __forceinline__ const bf16* operator()(int m) const { return A + (size_t)src[m] * lda; } };
template <bool DUAL, int STAT, class AF, class Epi>
__device__ __forceinline__ void simple_gemm(Frame& F, int M, int N, int K, const AF& af, const bf16* Bt, int ldb, int brow_per_expert  , const Epi& E) {
    LAS float* As = (LAS float*)F.lds;
    LAS float* Bs = As + 16 * 132;
    const int nM = M / 128, nN = N / 256, ntile = nM * nN;
    const int ty = F.tid >> 5, tx = F.tid & 31;
    for (int t = F.vcu; t < ntile; t += F.G) {
        const int pm = t / nN, pn = t % nN, m0 = pm * 128, n0 = pn * 256;
        const bf16* Bb = Bt + (size_t)(brow_per_expert ? (m0 / EROWS) * brow_per_expert : 0) * ldb + (size_t)n0 * ldb;
        float lo[8][4], hi[8][4];
#pragma unroll
        for (int r = 0; r < 8; ++r)
#pragma unroll
            for (int j = 0; j < 4; ++j) { lo[r][j] = 0.f; hi[r][j] = 0.f; }
        const bf16* arow = af(m0 + (F.tid >> 2));
        for (int k0 = 0; k0 < K; k0 += 16) {
            { const v2u w = *(const v2u*)(arow + k0 + (F.tid & 3) * 4); const int kk = (F.tid & 3) * 4, m = F.tid >> 2;
              As[(kk + 0) * 132 + m] = bflo(w.x); As[(kk + 1) * 132 + m] = bfhi(w.x); As[(kk + 2) * 132 + m] = bflo(w.y); As[(kk + 3) * 132 + m] = bfhi(w.y); }
            { const v4u w = *(const v4u*)(Bb + (size_t)(F.tid >> 1) * ldb + k0 + (F.tid & 1) * 8); const int kk = (F.tid & 1) * 8, n = F.tid >> 1;
              Bs[(kk + 0) * 260 + n] = bflo(w.x); Bs[(kk + 1) * 260 + n] = bfhi(w.x); Bs[(kk + 2) * 260 + n] = bflo(w.y); Bs[(kk + 3) * 260 + n] = bfhi(w.y);
              Bs[(kk + 4) * 260 + n] = bflo(w.z); Bs[(kk + 5) * 260 + n] = bfhi(w.z); Bs[(kk + 6) * 260 + n] = bflo(w.w); Bs[(kk + 7) * 260 + n] = bfhi(w.w); }
            __syncthreads();
#pragma unroll 2
            for (int kk = 0; kk < 16; ++kk) {
                const f32x4 a0 = *(const LAS f32x4*)(As + kk * 132 + ty * 8), a1 = *(const LAS f32x4*)(As + kk * 132 + ty * 8 + 4);
                const f32x4 b0 = *(const LAS f32x4*)(Bs + kk * 260 + tx * 4), b1 = *(const LAS f32x4*)(Bs + kk * 260 + 128 + tx * 4);
                const float a[8] = {a0.x, a0.y, a0.z, a0.w, a1.x, a1.y, a1.z, a1.w};
#pragma unroll
                for (int r = 0; r < 8; ++r) { lo[r][0] += a[r] * b0.x; lo[r][1] += a[r] * b0.y; lo[r][2] += a[r] * b0.z; lo[r][3] += a[r] * b0.w;
                                              hi[r][0] += a[r] * b1.x; hi[r][1] += a[r] * b1.y; hi[r][2] += a[r] * b1.z; hi[r][3] += a[r] * b1.w; }
            }
            __syncthreads();
        }
#pragma unroll
        for (int r = 0; r < 8; ++r) { const int row = m0 + ty * 8 + r;
            if constexpr (DUAL) E.template dual<4>(row, (n0 >> 1) + tx * 4, lo[r], hi[r]);
            else {
                if constexpr (STAT) { const int c0 = n0 + tx * 4, c1 = c0 + 128; const int k0 = E.stat_kind(c0), k1 = E.stat_kind(c1);
                    if (k0) E.add_stat(row, k0, E.template ssq<4>(lo[r])); if (k1) E.add_stat(row, k1, E.template ssq<4>(hi[r])); }
                E.template chunk<4>(row, n0 + tx * 4, lo[r]); E.template chunk<4>(row, n0 + 128 + tx * 4, hi[r]); }
        }
    }
}

template <int NCH> __device__ __forceinline__ float dot_chunks(const v4u* qp, const bf16* k, float acc) {
#pragma unroll
    for (int c = 0; c < NCH; ++c) { const v4u kv = *(const v4u*)(k + 8 * c); const v4u qv = qp[c];
        acc += bflo(qv.x) * bflo(kv.x) + bfhi(qv.x) * bfhi(kv.x) + bflo(qv.y) * bflo(kv.y) + bfhi(qv.y) * bfhi(kv.y)
             + bflo(qv.z) * bflo(kv.z) + bfhi(qv.z) * bfhi(kv.z) + bflo(qv.w) * bflo(kv.w) + bfhi(qv.w) * bfhi(kv.w); }
    return acc;
}
template <bool ODD>
__device__ __forceinline__ void simple_attn(Frame& F, int layer) {
    const int gw = F.vcu * NWAVES + F.wave, NGW = F.G * NWAVES;
    const bool need_ctx = layer < DEPTH - 1;
    const int nrows = need_ctx ? MT : NLAT;
    const bf16* Z = (const bf16*)(F.ws + WS_Z); const bf16* Q = (const bf16*)(F.ws + WS_Q); const bf16* KV = (const bf16*)(F.ws + WS_KV);
    bf16* OS = (bf16*)(F.ws + WS_H);
    for (int task = gw; task < nrows * 8; task += NGW) {
        const int row = task >> 3, h = task & 7, b = row_b(row);
        const bool lat = row < NLAT; const int pos = row & 4095;
        v4u qp[ODD ? 12 : 8];
        { const bf16* q = ODD ? Q + (size_t)row * 768 + h * 96 : Z + (size_t)row * ZE + 256 + h * 64;
#pragma unroll
          for (int c = 0; c < (ODD ? 12 : 8); ++c) qp[c] = *(const v4u*)(q + 8 * c); }
        int nlatk, lat0;
        if (!lat) { nlatk = 0; lat0 = 0; }
        else if (ODD) { nlatk = 4096; lat0 = 0; }
        else { lat0 = pos - 128 < 0 ? 0 : pos - 128; const int hi_ = pos + 128 > 4095 ? 4095 : pos + 128; nlatk = hi_ - lat0 + 1; }
        const int nk = nlatk + 256;
        const int kvh = h >> 2;
        float m_l = -INFINITY, l_l = 0.f;
        for (int j = F.lane; j < nk; j += 64) {
            const int krow = j < nlatk ? b * 4096 + lat0 + j : NLAT + b * 256 + (j - nlatk);
            float s;
            if (ODD) { s = dot_chunks<8>(qp, KV + (size_t)krow * 1024 + h * 128, 0.f); s = dot_chunks<4>(qp + 8, Z + (size_t)krow * ZO + 640, s); }
            else s = dot_chunks<8>(qp, Z + (size_t)krow * ZE + kvh * 64, 0.f);
            if (s > m_l) { l_l = l_l * exp2f(m_l - s) + 1.0f; m_l = s; } else l_l += exp2f(s - m_l);
        }
        float mx = wave_max(m_l);
        float l = wave_sum(l_l * exp2f(m_l - mx));
        if (!ODD) { const float sk = inp(F, IN_EVSINK)[(layer >> 1) * 8 + h] * LOG2E_; const float m2 = fmaxf(mx, sk); l = l * exp2f(mx - m2) + exp2f(sk - m2); mx = m2; }
        const float rl = 1.0f / l;
        float acc[64];
#pragma unroll
        for (int d = 0; d < 64; ++d) acc[d] = 0.f;
        for (int j = F.lane; j < nk; j += 64) {
            const int krow = j < nlatk ? b * 4096 + lat0 + j : NLAT + b * 256 + (j - nlatk);
            float s; const bf16* vp;
            if (ODD) { s = dot_chunks<8>(qp, KV + (size_t)krow * 1024 + h * 128, 0.f); s = dot_chunks<4>(qp + 8, Z + (size_t)krow * ZO + 640, s); vp = KV + (size_t)krow * 1024 + h * 128 + 64; }
            else { s = dot_chunks<8>(qp, Z + (size_t)krow * ZE + kvh * 64, 0.f); vp = Z + (size_t)krow * ZE + 128 + kvh * 64; }
            const float p = exp2f(s - mx) * rl;
#pragma unroll
            for (int c = 0; c < 8; ++c) { const v4u vv = *(const v4u*)(vp + 8 * c);
                acc[8 * c + 0] += p * bflo(vv.x); acc[8 * c + 1] += p * bfhi(vv.x); acc[8 * c + 2] += p * bflo(vv.y); acc[8 * c + 3] += p * bfhi(vv.y);
                acc[8 * c + 4] += p * bflo(vv.z); acc[8 * c + 5] += p * bfhi(vv.z); acc[8 * c + 6] += p * bflo(vv.w); acc[8 * c + 7] += p * bfhi(vv.w); }
        }
        LAS float* red = (LAS float*)(F.lds + F.wave * 16640) + F.lane * 65;
#pragma unroll
        for (int d = 0; d < 64; ++d) red[d] = acc[d];
        LDS_WAIT(); asm volatile("" ::: "memory");
        const LAS float* rd = (const LAS float*)(F.lds + F.wave * 16640) + F.lane;
        float mine = 0.f;
#pragma unroll 8
        for (int l = 0; l < 64; ++l) mine += rd[l * 65];
        LDS_WAIT(); asm volatile("" ::: "memory");
        OS[(size_t)row * 1024 + h * 64 + F.lane] = (bf16)f2bf(mine);
    }
}


namespace att {
#define ATT_LAS __attribute__((address_space(3)))
typedef short bf16x8 __attribute__((ext_vector_type(8)));
typedef short s16x4 __attribute__((ext_vector_type(4)));
typedef float f32x16 __attribute__((ext_vector_type(16)));
typedef float f32x2_t __attribute__((ext_vector_type(2)));
typedef __bf16 bf16x2_t __attribute__((ext_vector_type(2)));
__device__ __forceinline__ int crow(int r, int hi) { return (r & 3) + 8 * (r >> 2) + 4 * hi; }
__device__ __forceinline__ unsigned cvtpk(float lo, float hi) { f32x2_t v = {lo, hi}; bf16x2_t b = __builtin_convertvector(v, bf16x2_t); return __builtin_bit_cast(unsigned, b); }
__device__ __forceinline__ s16x4 vtr(const ATT_LAS char* p) { return __builtin_bit_cast(s16x4, __builtin_amdgcn_ds_read_tr16_b64_v4i16((ATT_LAS s16x4*)p)); }
__device__ __forceinline__ void glds16(const void* sbase, unsigned voff, unsigned lds_dst) { unsigned keep;
    asm volatile("s_mov_b32 %0, m0\n\ts_mov_b32 m0, %3\n\ts_nop 0\n\tglobal_load_lds_dwordx4 %1, %2\n\ts_mov_b32 m0, %0" : "=&s"(keep) : "v"(voff), "s"(sbase), "s"(lds_dst) : "memory"); }
template <int DK, int TK> struct Geo {
    static constexpr int NCH = DK / 8, KB = NCH * TK * 16, VB = TK * 128, SLOT = KB + VB, NKP = NCH * (TK / 64), NVP = TK / 8, NPW = (NKP + NVP) / 8;
    static_assert((NKP + NVP) % 8 == 0, "pieces must divide over 8 waves");
};
struct Piece { const char* base; unsigned pitch, loff, voff; };
template <int DK, int TK> using PieceArr = Piece[Geo<DK, TK>::NPW];
struct Src { const char* kb0; unsigned kp0; const char* kb1; unsigned kp1; const char* vb; unsigned vp; };
template <int DK, int TK> __device__ __forceinline__ void make_pieces(PieceArr<DK, TK>& pc, const Src& s, int wave, int lane) {
    typedef Geo<DK, TK> G;
#pragma unroll
    for (int i = 0; i < G::NPW; ++i) {
        const int p = wave * G::NPW + i;
        if (p < G::NKP) { const int ch = p % G::NCH, kh = p / G::NCH; const bool a = ch < 8;
            pc[i].base = a ? s.kb0 + 16 * ch : s.kb1 + 16 * (ch - 8); pc[i].pitch = a ? s.kp0 : s.kp1; pc[i].loff = (unsigned)(ch * TK * 16 + kh * 1024);
            pc[i].voff = (unsigned)(kh * 64 + lane) * pc[i].pitch; }
        else { const int v = p - G::NKP, dh = v / (TK / 16), kg = v % (TK / 16);
            pc[i].base = s.vb + dh * 64; pc[i].pitch = s.vp; pc[i].loff = (unsigned)(G::KB + dh * TK * 64 + kg * 1024);
            pc[i].voff = (unsigned)(kg * 16 + (lane >> 2)) * s.vp + (unsigned)(lane & 3) * 16u; }
    }
}
__device__ __forceinline__ float rowmax32(const f32x16& p0, const f32x16& p1) {
    float ta = __builtin_fmaxf(__builtin_fmaxf(p0[0], p0[1]), p1[0]), tb = __builtin_fmaxf(__builtin_fmaxf(p0[2], p0[3]), p1[1]);
    ta = __builtin_fmaxf(__builtin_fmaxf(ta, p1[2]), p1[3]);
#pragma unroll
    for (int r = 4; r < 16; r += 4) { ta = __builtin_fmaxf(__builtin_fmaxf(ta, p0[r]), p0[r + 1]); tb = __builtin_fmaxf(__builtin_fmaxf(tb, p0[r + 2]), p0[r + 3]);
                                       ta = __builtin_fmaxf(__builtin_fmaxf(ta, p1[r]), p1[r + 1]); tb = __builtin_fmaxf(__builtin_fmaxf(tb, p1[r + 2]), p1[r + 3]); }
    const float m = __builtin_fmaxf(ta, tb);
    auto rr = __builtin_amdgcn_permlane32_swap(__builtin_bit_cast(unsigned, m), __builtin_bit_cast(unsigned, m), false, false);
    return __builtin_bit_cast(float, rr[0]);
}
__host__ __device__ constexpr int att_cum(int ngrp, int gi) {
    if (ngrp == 12) { int c = 0; for (int i = 0; i < gi; ++i) c += (i >= 8 || (i & 1)) ? 3 : 2; return c; }
    return gi * 32 / ngrp;
}
template <int DK, int TK, bool MASKED, class TileFn>
__device__ __forceinline__ void attn_unit(ATT_LAS unsigned char* lds, int tid, const bf16* qrow, int ntiles, const TileFn& tf, int qi, bool has_sink, float sink_l2, bf16* orow, const PieceArr<DK, TK>& pc) {
    typedef Geo<DK, TK> G;
    constexpr int SPT = TK / 64, NQ = DK / 16, NS = ATT_CREF ? NQ : NQ + 1, NGRP = 2 * NS;
    constexpr float THR = 8.0f;
    const int lane = tid & 63, r32 = lane & 31, hi = lane >> 5;
    bf16x8 qr[NQ];
#pragma unroll
    for (int d0 = 0; d0 < NQ; ++d0) qr[d0] = *(const bf16x8*)(qrow + d0 * 16 + hi * 8);
#pragma unroll
    for (int d0 = 0; d0 < NQ; ++d0) asm volatile("" : "+v"(qr[d0]));
    f32x16 o[2];
#pragma unroll
    for (int r = 0; r < 16; ++r) { o[0][r] = 0.f; o[1][r] = 0.f; }
    const f32x16 zero16 = {0.f, 0.f, 0.f, 0.f, 0.f, 0.f, 0.f, 0.f, 0.f, 0.f, 0.f, 0.f, 0.f, 0.f, 0.f, 0.f};
    const bf16x8 kone = {(short)(hi ? 0 : 0x3F80), 0, 0, 0, 0, 0, 0, 0};
#define ATT_QEXT(mr_) ((bf16x8){(short)(hi ? 0u : (cvtpk(-(mr_), 0.f) & 0xffffu)), 0, 0, 0, 0, 0, 0, 0})
    float mref = has_sink ? ceilf(sink_l2) : 0.f, l = (has_sink && hi == 0) ? __builtin_amdgcn_exp2f(sink_l2 - mref) : 0.f, alpha = 1.0f;
    bf16x8 qext = ATT_QEXT(mref);
    f32x16 mneg;
#pragma unroll
    for (int r = 0; r < 16; ++r) mneg[r] = ATT_CREF ? -mref : 0.f;
    const unsigned lds0 = (unsigned)(size_t)lds;
#define ATT_ISSUE(T, slotb) do { const int kr_ = tf.krow0(T); _Pragma("unroll") for (int i_ = 0; i_ < G::NPW; ++i_) \
        glds16(pc[i_].base + (size_t)kr_ * pc[i_].pitch, pc[i_].voff, (unsigned)__builtin_amdgcn_readfirstlane(lds0 + (unsigned)(slotb) + pc[i_].loff)); } while (0)
    const ATT_LAS char* kb0 = (const ATT_LAS char*)lds + hi * TK * 16 + r32 * 16;
    const ATT_LAS char* vb0 = (const ATT_LAS char*)lds + G::KB + ((lane >> 4) & 1) * 32 + (lane & 3) * 8 + (4 * hi + ((lane & 15) >> 2)) * 64;
#define ATT_SB() __builtin_amdgcn_sched_barrier(0)
#define ATT_MF(A_, B_, C_) __builtin_amdgcn_mfma_f32_32x32x16_bf16(A_, B_, C_, 0, 0, 0)
#define ATT_KLD(d_, A_, C_) do { A_ = *(const ATT_LAS bf16x8*)(kb_ + (d_) * 2 * TK * 16); C_ = *(const ATT_LAS bf16x8*)(kb_ + (d_) * 2 * TK * 16 + 512); } while (0)
#define ATT_VLD(j_, L_, H_) do { L_ = vtr(vb + ((j_) & 1) * TK * 64 + ((j_) >> 1) * 1024); H_ = vtr(vb + ((j_) & 1) * TK * 64 + ((j_) >> 1) * 1024 + 512); } while (0)
    if (__builtin_amdgcn_readfirstlane(tid) >= 256) __builtin_amdgcn_s_setprio(1);
    ATT_ISSUE(0, 0);
    asm volatile("s_waitcnt vmcnt(0) lgkmcnt(0)\n\ts_barrier" ::: "memory");
    if (ntiles > 1) ATT_ISSUE(1, G::SLOT);
    f32x16 pA0, pA1, pB0, pB1;
    { const ATT_LAS char* kb_ = kb0;
#pragma unroll
      for (int d0 = 0; d0 < NQ; ++d0) { bf16x8 ka, kc; ATT_KLD(d0, ka, kc); if (d0 == 0) { pA0 = ATT_MF(ka, qr[0], mneg); pA1 = ATT_MF(kc, qr[0], mneg); } else { pA0 = ATT_MF(ka, qr[d0], pA0); pA1 = ATT_MF(kc, qr[d0], pA1); } }
      if constexpr (!ATT_CREF) { pA0 = ATT_MF(kone, qext, pA0); pA1 = ATT_MF(kone, qext, pA1); } }
    if (!has_sink) {
        const float dl = ceilf(rowmax32(pA0, pA1));
#pragma unroll
        for (int r = 0; r < 16; ++r) { pA0[r] -= dl; pA1[r] -= dl; }
        mref = dl; qext = ATT_QEXT(mref);
        if constexpr (ATT_CREF) {
#pragma unroll
            for (int r = 0; r < 16; ++r) mneg[r] = -dl; }
    }
    int sl_cur = 0;
    const int ng = ntiles * SPT;
#define ATT_PCE(X0_, X1_, e) ((e) < 16 ? X0_[(e) & 15] : X1_[(e) & 15])
#define ATT_EXP1(X0_, X1_, e) do { if ((e) < 16) X0_[(e) & 15] = __builtin_amdgcn_exp2f(X0_[(e) & 15]); else X1_[(e) & 15] = __builtin_amdgcn_exp2f(X1_[(e) & 15]); } while (0)
#define ATT_EXP2(X0_, X1_, e) do { if ((e) < 16) { X0_[(e) & 15] = __builtin_amdgcn_exp2f(X0_[(e) & 15]); X0_[((e) & 15) + 1] = __builtin_amdgcn_exp2f(X0_[((e) & 15) + 1]); } \
        else { X1_[(e) & 15] = __builtin_amdgcn_exp2f(X1_[(e) & 15]); X1_[((e) & 15) + 1] = __builtin_amdgcn_exp2f(X1_[((e) & 15) + 1]); } } while (0)
#define ATT_VADD(acc_, x_) asm volatile("v_add_f32 %0, %0, %1" : "+v"(acc_) : "v"(x_))
#define ATT_VMUL(x_, y_) asm volatile("v_mul_f32 %0, %0, %1" : "+v"(x_) : "v"(y_))
#define ATT_STEP(C0_, C1_, N0_, N1_, G_) do { \
        const int g_ = (G_), T_ = g_ / SPT, sb_ = g_ % SPT; \
        int sl_next = sl_cur; \
        if (sb_ == SPT - 1 && g_ + 1 < ng) {        \
            sl_next = (sl_cur == 2 * G::SLOT) ? 0 : sl_cur + G::SLOT; \
            asm volatile("s_waitcnt vmcnt(0) lgkmcnt(0)\n\ts_barrier" ::: "memory"); \
            if (T_ + 2 < ntiles) { const int sl2 = (sl_next == 2 * G::SLOT) ? 0 : sl_next + G::SLOT; ATT_ISSUE(T_ + 2, sl2); } \
        } \
        if constexpr (MASKED) { const int kind = tf.kind(T_, sb_); \
            if (kind == 1) { _Pragma("unroll") for (int r = 0; r < 16; ++r) { const int kj = crow(r, hi); if (kj < qi) C0_[r] = -INFINITY; if (kj + 32 < qi) C1_[r] = -INFINITY; } } \
            else if (kind == 2) { _Pragma("unroll") for (int r = 0; r < 16; ++r) { const int kj = crow(r, hi); if (kj > qi) C0_[r] = -INFINITY; if (kj + 32 > qi) C1_[r] = -INFINITY; } } } \
        const float tm_ = rowmax32(C0_, C1_); \
        const float dl_ = tm_ > THR ? ceilf(tm_) : 0.f; \
        const float alpha_old = alpha; alpha = __builtin_amdgcn_exp2f(-dl_); mref += dl_; qext = ATT_QEXT(mref); \
        if (__builtin_amdgcn_ballot_w64(alpha_old != 1.0f) != 0ull) { _Pragma("unroll") for (int r = 0; r < 16; ++r) { ATT_VMUL(o[0][r], alpha_old); ATT_VMUL(o[1][r], alpha_old); } }        \
        if (ATT_CREF && __builtin_amdgcn_ballot_w64(dl_ != 0.f) != 0ull) { _Pragma("unroll") for (int r = 0; r < 16; ++r) mneg[r] -= dl_; }        \
        float ls0 = 0.f, ls1 = 0.f, ls2 = 0.f, ls3 = 0.f; unsigned pw[4][4];        \
        { const ATT_LAS char* kb_ = kb0 + sl_next + ((g_ + 1 < ng) ? (sb_ + 1) % SPT : sb_) * 1024; \
          const ATT_LAS char* vb = vb0 + sl_cur + sb_ * 4096; \
          bf16x8 ka[3], kc[3]; s16x4 vl[4], vh[4]; \
          ATT_KLD(0, ka[0], kc[0]); ATT_KLD(1, ka[1], kc[1]); \
          ATT_SB(); \
          _Pragma("unroll") for (int d0 = 0; d0 < NS; ++d0) {         \
              if (d0 + 2 < NQ) ATT_KLD(d0 + 2, ka[(d0 + 2) % 3], kc[(d0 + 2) % 3]); \
              if (d0 == NS - 2) { ATT_VLD(0, vl[0], vh[0]); ATT_VLD(1, vl[1], vh[1]); } \
              if (d0 == NS - 1) { ATT_VLD(2, vl[2], vh[2]); } \
              if (d0 == 0) N0_ = ATT_MF(ka[0], qr[0], mneg); else if (d0 < NQ) N0_ = ATT_MF(ka[d0 % 3], qr[d0 < NQ ? d0 : 0], N0_); else N0_ = ATT_MF(kone, qext, N0_); \
              ATT_SB(); \
              _Pragma("unroll") for (int e_ = att_cum(NGRP, 2 * d0); e_ < att_cum(NGRP, 2 * d0 + 1); ++e_) { ATT_EXP1(C0_, C1_, e_); } \
              ATT_SB(); \
              if (d0 == 0) N1_ = ATT_MF(kc[0], qr[0], mneg); else if (d0 < NQ) N1_ = ATT_MF(kc[d0 % 3], qr[d0 < NQ ? d0 : 0], N1_); else N1_ = ATT_MF(kone, qext, N1_); \
              ATT_SB(); \
              _Pragma("unroll") for (int e_ = att_cum(NGRP, 2 * d0 + 1); e_ < att_cum(NGRP, 2 * d0 + 2); ++e_) { ATT_EXP1(C0_, C1_, e_); } \
              if (d0 >= NS - 4) { const int k_ = d0 - (NS - 4); pw[0][k_] = cvtpk(C0_[2 * k_], C0_[2 * k_ + 1]); }        \
              ATT_SB(); \
          } \
          _Pragma("unroll") for (int j = 0; j < 8; ++j) {              \
              const bf16x8 vf = {vl[j & 3][0], vl[j & 3][1], vl[j & 3][2], vl[j & 3][3], vh[j & 3][0], vh[j & 3][1], vh[j & 3][2], vh[j & 3][3]}; \
              if (j + 3 < 8) ATT_VLD(j + 3, vl[(j + 3) & 3], vh[(j + 3) & 3]); \
              o[j & 1] = ATT_MF(vf, __builtin_bit_cast(bf16x8, (v4u){pw[j >> 1][0], pw[j >> 1][1], pw[j >> 1][2], pw[j >> 1][3]}), o[j & 1]); \
              ATT_SB(); \
              if (j < 6) { const int q_ = 1 + (j >> 1), h_ = 2 * (j & 1);         \
                  pw[q_][h_] = cvtpk(ATT_PCE(C0_, C1_, 8 * q_ + 2 * h_), ATT_PCE(C0_, C1_, 8 * q_ + 2 * h_ + 1)); pw[q_][h_ + 1] = cvtpk(ATT_PCE(C0_, C1_, 8 * q_ + 2 * h_ + 2), ATT_PCE(C0_, C1_, 8 * q_ + 2 * h_ + 3)); } \
              ATT_VADD(ls0, ATT_PCE(C0_, C1_, 4 * j)); ATT_VADD(ls1, ATT_PCE(C0_, C1_, 4 * j + 1)); ATT_VADD(ls2, ATT_PCE(C0_, C1_, 4 * j + 2)); ATT_VADD(ls3, ATT_PCE(C0_, C1_, 4 * j + 3)); \
              ATT_SB(); \
          } \
        } \
        l = l * alpha_old + ((ls0 + ls1) + (ls2 + ls3)); sl_cur = sl_next; \
    } while (0)
    int g = 0;
#pragma unroll 1
    for (; g + 1 < ng; g += 2) { ATT_STEP(pA0, pA1, pB0, pB1, g); ATT_STEP(pB0, pB1, pA0, pA1, g + 1); }
    if (g < ng) ATT_STEP(pA0, pA1, pB0, pB1, g);
#undef ATT_STEP
#undef ATT_PCE
#undef ATT_EXP2
#undef ATT_EXP1
#undef ATT_VADD
#undef ATT_VMUL
#undef ATT_ISSUE
#undef ATT_SB
#undef ATT_MF
#undef ATT_KLD
#undef ATT_VLD
#undef ATT_QEXT
    l += __shfl_xor(l, 32);
    const float rl = __builtin_amdgcn_rcpf(l);
#pragma unroll
    for (int d0 = 0; d0 < 2; ++d0)
#pragma unroll
        for (int g4 = 0; g4 < 4; g4 += 2) {
            v2u a, b2;
            a.x = cvtpk(o[d0][4 * g4] * rl, o[d0][4 * g4 + 1] * rl); a.y = cvtpk(o[d0][4 * g4 + 2] * rl, o[d0][4 * g4 + 3] * rl);
            b2.x = cvtpk(o[d0][4 * g4 + 4] * rl, o[d0][4 * g4 + 5] * rl); b2.y = cvtpk(o[d0][4 * g4 + 6] * rl, o[d0][4 * g4 + 7] * rl);
            asm volatile("s_nop 1\n\tv_permlane32_swap_b32 %0, %1" : "+v"(a.x), "+v"(b2.x));
            asm volatile("s_nop 1\n\tv_permlane32_swap_b32 %0, %1" : "+v"(a.y), "+v"(b2.y));
            *(v4u*)(orow + 32 * d0 + 8 * g4 + 8 * hi) = (v4u){a.x, a.y, b2.x, b2.y}; }
    __builtin_amdgcn_s_setprio(0);
    asm volatile("s_waitcnt lgkmcnt(0)\n\ts_barrier" ::: "memory");
}
}

struct OddTiles {
    int b, t0;
    __device__ __forceinline__ int krow0(int T) const { const int t = T + t0; return t < 32 ? b * 4096 + t * 128 : NLAT + b * 256 + (t - 32) * 128; }
    __device__ __forceinline__ int kind(int, int) const { return 0; }
};
struct EvenTiles {
    int b, qb, jlo, nlat;
    __device__ __forceinline__ int krow0(int T) const { return T < nlat ? b * 4096 + qb * 64 - 128 + 64 * (jlo + T) : NLAT + b * 256 + 64 * (T - nlat); }
    __device__ __forceinline__ int kind(int T, int) const { if (T >= nlat) return 0; const int j = jlo + T; return j == 0 ? 1 : (j == 4 ? 2 : 0); }
};
constexpr float LOG2E = 1.4426950408889634f;
constexpr float QSC_E = 0.125f * LOG2E, QSC_O = 0.10206207261596577f * LOG2E;

__device__ __forceinline__ void mfma_attn_odd(Frame& F, int layer) {
    const bool need_ctx = layer < DEPTH - 1;
    const bf16* Z = (const bf16*)(F.ws + WS_Z); const bf16* Q = (const bf16*)(F.ws + WS_Q); const bf16* KV = (const bf16*)(F.ws + WS_KV);
    bf16* OS = (bf16*)(F.ws + WS_H);
    const int nunits = 1024 + (need_ctx ? 64 : 0);
    const int r32 = F.lane & 31;
    for (int u = F.vcu; u < nunits; u += F.G) {
        int b, h, row0, t0, nt;
        if (u < 1024) { b = u >> 7; h = (u >> 4) & 7; row0 = b * 4096 + (u & 15) * 256; t0 = 0; nt = 34; }
        else { const int c = u - 1024; b = c >> 3; h = c & 7; row0 = NLAT + b * 256; t0 = 32; nt = 2; }
        att::Src s{(const char*)(KV + h * 128), 2048u, (const char*)(Z + 640), (unsigned)(ZO * 2), (const char*)(KV + h * 128 + 64), 2048u};
        att::Piece pc[att::Geo<96, 128>::NPW]; att::make_pieces<96, 128>(pc, s, F.wave, F.lane);
        const int row = row0 + F.wave * 32 + r32;
        att::attn_unit<96, 128, false>(F.lds, F.tid, Q + (size_t)row * 768 + h * 96, nt, OddTiles{b, t0}, 0, false, 0.f, OS + (size_t)row * 1024 + h * 64, pc);
    }
}
__device__ __forceinline__ void mfma_attn_even(Frame& F, int layer) {
    const bool need_ctx = layer < DEPTH - 1;
    const bf16* Z = (const bf16*)(F.ws + WS_Z);
    bf16* OS = (bf16*)(F.ws + WS_H);
    const int nunits = 1024 + (need_ctx ? 64 : 0);
    const int r32 = F.lane & 31;
    for (int u = F.vcu; u < nunits; u += F.G) {
        int b, kvh, row0; EvenTiles tf;
        if (u < 1024) { b = u >> 7; kvh = (u >> 6) & 1; const int qb = u & 63; row0 = b * 4096 + qb * 64; const int jlo = qb < 2 ? 2 - qb : 0, jhi = qb > 61 ? 65 - qb : 4; tf = EvenTiles{b, qb, jlo, jhi - jlo + 1}; }
        else { const int c = u - 1024; b = c >> 3; kvh = (c >> 2) & 1; row0 = NLAT + b * 256 + (c & 3) * 64; tf = EvenTiles{b, 0, 0, 0}; }
        att::Src s{(const char*)(Z + kvh * 64), (unsigned)(ZE * 2), nullptr, 0u, (const char*)(Z + 128 + kvh * 64), (unsigned)(ZE * 2)};
        att::Piece pc[att::Geo<64, 64>::NPW]; att::make_pieces<64, 64>(pc, s, F.wave, F.lane);
        const int head = kvh * 4 + (F.wave >> 1), qi = (F.wave & 1) * 32 + r32, row = row0 + qi;
        const float sink = inp(F, IN_EVSINK)[(layer >> 1) * 8 + head] * LOG2E;
        att::attn_unit<64, 64, true>(F.lds, F.tid, Z + (size_t)row * ZE + 256 + head * 64, tf.nlat + 4, tf, qi, true, sink, OS + (size_t)row * 1024 + head * 64, pc);
    }
}


__device__ __forceinline__ void mfma_sgu(Frame& F, int layer) {
    const int i2 = layer >> 1;
    const bool need_ctx = layer < DEPTH - 1;
    const int nunits = need_ctx ? 272 : 256;
    const bf16* Z = (const bf16*)(F.ws + WS_Z); bf16* OS = (bf16*)(F.ws + WS_H);
    LAS unsigned char* vn = F.lds;
    LAS float* st = (LAS float*)(F.lds + 131072);
    LAS float* ngl = st + 256;
    const bf16* WsB = (const bf16*)(F.ws + WS_WSB) + (size_t)i2 * 4 * 128 * 128;
    const float* bs = inp(F, IN_EVSGUB) + i2 * 4 * 128;
    { const float* ng = inp(F, IN_EVSGUG) + i2 * 512; for (int i = F.tid; i < 512; i += NT) ngl[i] = ng[i]; }
    const int r32 = F.lane & 31, hi = F.lane >> 5;
    const bool remap = F.G == 256;
    for (int it = 0; ; ++it) {
        int u;
        if (remap) { if (it == 0) u = F.vcu; else if (it == 1 && need_ctx && F.vcu >= 64 && F.vcu < 80) u = 256 + F.vcu - 64; else break; }
        else { u = F.vcu + it * F.G; if (u >= nunits) break; }
        const int row0 = u < 256 ? u * 128 : NLAT + (u - 256) * 128;
        __syncthreads();
        {
            v4u w[16];
#pragma unroll
            for (int i = 0; i < 16; ++i) w[i] = *(const v4u*)(Z + (size_t)(row0 + F.wave * 16 + i) * ZE + 1280 + 8 * F.lane);
#pragma unroll
            for (int i = 0; i < 16; ++i) {
                const float x[8] = {bflo(w[i].x), bfhi(w[i].x), bflo(w[i].y), bfhi(w[i].y), bflo(w[i].z), bfhi(w[i].z), bflo(w[i].w), bfhi(w[i].w)};
                float s = 0.f;
#pragma unroll
                for (int j = 0; j < 8; ++j) s += x[j];
                const float mean = wave_sum(s) * (1.0f / 512.0f); float q = 0.f;
#pragma unroll
                for (int j = 0; j < 8; ++j) q += (x[j] - mean) * (x[j] - mean);
                const float var = wave_sum(q) * (1.0f / 512.0f);
                if (F.lane == 0) { st[2 * (F.wave * 16 + i)] = mean; st[2 * (F.wave * 16 + i) + 1] = 1.0f / sqrtf(var + EPS); }
            }
        }
        __syncthreads();
#pragma unroll
        for (int k = 0; k < 4; ++k) {
            const int it = F.tid + NT * k, q = it & 127, blk = it >> 7;
            const float mean = st[2 * q], rstd = st[2 * q + 1];
            const bf16* zp = Z + (size_t)(row0 + q) * ZE + 1280 + blk * 32;
            LAS unsigned char* dst = vn + blk * 8192 + (q >> 4) * 1024 + (q & 15) * 64;
#pragma unroll
            for (int c = 0; c < 4; ++c) { const v4u w = *(const v4u*)(zp + 8 * c);
                const f32x4 g0 = *(const LAS f32x4*)(ngl + blk * 32 + 8 * c), g1 = *(const LAS f32x4*)(ngl + blk * 32 + 8 * c + 4);
                v4u o; o.x = pk2((bflo(w.x) - mean) * rstd * g0.x, (bfhi(w.x) - mean) * rstd * g0.y); o.y = pk2((bflo(w.y) - mean) * rstd * g0.z, (bfhi(w.y) - mean) * rstd * g0.w);
                o.z = pk2((bflo(w.z) - mean) * rstd * g1.x, (bfhi(w.z) - mean) * rstd * g1.y); o.w = pk2((bflo(w.w) - mean) * rstd * g1.z, (bfhi(w.w) - mean) * rstd * g1.w);
                *(LAS v4u*)(dst + 16 * c) = o; }
        }
        __syncthreads();
        const int pt = F.wave & 3, p = pt * 32 + r32;
        const LAS char* ab = (const LAS char*)vn + (8 * hi + ((F.lane & 15) >> 2)) * 64 + ((F.lane >> 4) & 1) * 32 + (F.lane & 3) * 8;
#pragma unroll 1
        for (int gg = 0; gg < 2; ++gg) {
            const int g = (F.wave >> 2) * 2 + gg;
            att::bf16x8 bw[8];
#pragma unroll
            for (int ks = 0; ks < 8; ++ks) bw[ks] = *(const att::bf16x8*)(WsB + ((size_t)g * 128 + p) * 128 + 16 * ks + 8 * hi);
            const float bias = bs[g * 128 + p];
#pragma unroll 1
            for (int dd = 0; dd < 4; ++dd) {
                const int dt = g * 4 + dd;
                const bf16* up = Z + (size_t)(row0 + p) * ZE + 768 + dt * 32 + 8 * hi;
                v4u uq[2];
#pragma unroll
                for (int g2_ = 0; g2_ < 2; ++g2_) uq[g2_] = *(const v4u*)(up + 16 * g2_);
                att::f32x16 acc;
#pragma unroll
                for (int r = 0; r < 16; ++r) acc[r] = 0.f;
#pragma unroll
                for (int ks = 0; ks < 8; ++ks) {
                    const att::s16x4 lo = att::vtr(ab + dt * 8192 + ks * 1024), hh = att::vtr(ab + dt * 8192 + ks * 1024 + 256);
                    const att::bf16x8 af = {lo[0], lo[1], lo[2], lo[3], hh[0], hh[1], hh[2], hh[3]};
                    acc = __builtin_amdgcn_mfma_f32_32x32x16_bf16(af, bw[ks], acc, 0, 0, 0);
                }
                bf16* op = OS + (size_t)(row0 + p) * 1024 + 512 + dt * 32 + 8 * hi;
#pragma unroll
                for (int g4 = 0; g4 < 4; g4 += 2) { v4u uw = uq[g4 >> 1];
                    asm volatile("s_nop 1\n\tv_permlane32_swap_b32 %0, %1" : "+v"(uw.x), "+v"(uw.z));
                    asm volatile("s_nop 1\n\tv_permlane32_swap_b32 %0, %1" : "+v"(uw.y), "+v"(uw.w));
                    v2u oa, ob;
                    oa.x = pk2(bflo(uw.x) * (acc[4 * g4] + bias), bfhi(uw.x) * (acc[4 * g4 + 1] + bias)); oa.y = pk2(bflo(uw.y) * (acc[4 * g4 + 2] + bias), bfhi(uw.y) * (acc[4 * g4 + 3] + bias));
                    ob.x = pk2(bflo(uw.z) * (acc[4 * g4 + 4] + bias), bfhi(uw.z) * (acc[4 * g4 + 5] + bias)); ob.y = pk2(bflo(uw.w) * (acc[4 * g4 + 6] + bias), bfhi(uw.w) * (acc[4 * g4 + 7] + bias));
                    asm volatile("s_nop 1\n\tv_permlane32_swap_b32 %0, %1" : "+v"(oa.x), "+v"(ob.x));
                    asm volatile("s_nop 1\n\tv_permlane32_swap_b32 %0, %1" : "+v"(oa.y), "+v"(ob.y));
                    *(v4u*)(op + 8 * g4) = (v4u){oa.x, oa.y, ob.x, ob.y}; }
            }
        }
    }
    __syncthreads();
}

__device__ __forceinline__ void simple_sgu(Frame& F, int layer) {
    const int i2 = layer >> 1;
    const bool need_ctx = layer < DEPTH - 1;
    const int nunits = need_ctx ? 272 : 256;
    const bf16* Z = (const bf16*)(F.ws + WS_Z); bf16* OS = (bf16*)(F.ws + WS_H);
    LAS float* vn = (LAS float*)F.lds;
    LAS float* st = vn + 128 * 128;
    const float* ng = inp(F, IN_EVSGUG) + i2 * 512;
    const float* Ws = inp(F, IN_EVSGUW) + (size_t)i2 * 4 * 128 * 128;
    const float* bs = inp(F, IN_EVSGUB) + i2 * 4 * 128;
    for (int u = F.vcu; u < nunits; u += F.G) {
        const int row0 = u < 256 ? u * 128 : NLAT + (u - 256) * 128;
        for (int r = F.wave; r < 128; r += NWAVES) {
            const v4u w = *(const v4u*)(Z + (size_t)(row0 + r) * ZE + 1280 + 8 * F.lane);
            const float x[8] = {bflo(w.x), bfhi(w.x), bflo(w.y), bfhi(w.y), bflo(w.z), bfhi(w.z), bflo(w.w), bfhi(w.w)};
            float s = 0.f;
#pragma unroll
            for (int j = 0; j < 8; ++j) s += x[j];
            const float mean = wave_sum(s) * (1.0f / 512.0f); float q = 0.f;
#pragma unroll
            for (int j = 0; j < 8; ++j) q += (x[j] - mean) * (x[j] - mean);
            const float var = wave_sum(q) * (1.0f / 512.0f);
            if (F.lane == 0) { st[2 * r] = mean; st[2 * r + 1] = 1.0f / sqrtf(var + EPS); }
        }
        __syncthreads();
        for (int g = 0; g < 4; ++g) {
            for (int i = F.tid; i < 128 * 128; i += NT) { const int q = i >> 7, d = i & 127; const float x = bf2f(Z[(size_t)(row0 + q) * ZE + 1280 + g * 128 + d]); vn[i] = (x - st[2 * q]) * st[2 * q + 1] * ng[g * 128 + d]; }
            __syncthreads();
            const int p = F.tid >> 2, d0 = (F.tid & 3) * 32;
            float acc[32];
#pragma unroll
            for (int j = 0; j < 32; ++j) acc[j] = 0.f;
            const float* wrow = Ws + ((size_t)g * 128 + p) * 128;
            for (int q = 0; q < 128; ++q) { const float w = wrow[q];
#pragma unroll
                for (int j = 0; j < 32; j += 4) { const f32x4 v = *(const LAS f32x4*)(vn + q * 128 + d0 + j); acc[j] += w * v.x; acc[j + 1] += w * v.y; acc[j + 2] += w * v.z; acc[j + 3] += w * v.w; } }
            const float bias = bs[g * 128 + p];
            const bf16* up = Z + (size_t)(row0 + p) * ZE + 768 + g * 128 + d0;
            bf16* op = OS + (size_t)(row0 + p) * 1024 + 512 + g * 128 + d0;
#pragma unroll
            for (int j = 0; j < 32; j += 8) { const v4u uw = *(const v4u*)(up + j);
                float o[8] = {bflo(uw.x) * (acc[j] + bias), bfhi(uw.x) * (acc[j + 1] + bias), bflo(uw.y) * (acc[j + 2] + bias), bfhi(uw.y) * (acc[j + 3] + bias),
                              bflo(uw.z) * (acc[j + 4] + bias), bfhi(uw.z) * (acc[j + 5] + bias), bflo(uw.w) * (acc[j + 6] + bias), bfhi(uw.w) * (acc[j + 7] + bias)};
                store_bf16<8>(op + j, o); }
            __syncthreads();
        }
    }
}
__device__ __forceinline__ void simple_conv(Frame& F, int layer) {
    const int i2 = layer >> 1;
    const bool need_ctx = layer < DEPTH - 1;
    const int nrows = need_ctx ? MT : NLAT;
    const bf16* Z = (const bf16*)(F.ws + WS_Z); bf16* OS = (bf16*)(F.ws + WS_H);
    const float* cw = inp(F, IN_ODCONV) + i2 * 3 * 512;
    const int nthr = F.G * NT, nruns_cap = nthr >> 6, R = (nrows + nruns_cap - 1) / nruns_cap, nruns = (nrows + R - 1) / R;
    for (int it = F.vcu * NT + F.tid; it < nruns * 64; it += nthr) {
        const int run = it >> 6, c0 = (it & 63) * 8, ra = run * R, rb = (ra + R < nrows) ? ra + R : nrows;
        float w0[8], w1[8], w2[8];
#pragma unroll
        for (int j = 0; j < 8; j += 4) { const f32x4 a = *(const f32x4*)(cw + c0 + j), b = *(const f32x4*)(cw + 512 + c0 + j), c = *(const f32x4*)(cw + 1024 + c0 + j);
            w0[j] = a.x; w0[j + 1] = a.y; w0[j + 2] = a.z; w0[j + 3] = a.w; w1[j] = b.x; w1[j + 1] = b.y; w1[j + 2] = b.z; w1[j + 3] = b.w; w2[j] = c.x; w2[j + 1] = c.y; w2[j + 2] = c.z; w2[j + 3] = c.w; }
#define CONV_U(dst_, row_) do { const bf16* zr_ = Z + (size_t)(row_) * ZO; const v4u cw_ = *(const v4u*)(zr_ + 672 + 512 + c0), hw_ = *(const v4u*)(zr_ + 672 + 1024 + c0); \
            dst_[0] = bflo(cw_.x) * bflo(hw_.x); dst_[1] = bfhi(cw_.x) * bfhi(hw_.x); dst_[2] = bflo(cw_.y) * bflo(hw_.y); dst_[3] = bfhi(cw_.y) * bfhi(hw_.y); \
            dst_[4] = bflo(cw_.z) * bflo(hw_.z); dst_[5] = bfhi(cw_.z) * bfhi(hw_.z); dst_[6] = bflo(cw_.w) * bflo(hw_.w); dst_[7] = bfhi(cw_.w) * bfhi(hw_.w); } while (0)
        float up[8], uc[8], un[8];
#pragma unroll
        for (int j = 0; j < 8; ++j) { up[j] = 0.f; uc[j] = 0.f; un[j] = 0.f; }
        if (ra > 0) CONV_U(up, ra - 1);
        CONV_U(uc, ra);
        for (int row = ra; row < rb; ++row) {
            const int seqpos = row < NLAT ? (row & 4095) : ((row - NLAT) & 255), seqlen = row < NLAT ? 4096 : 256;
            const bool hasn = seqpos + 1 < seqlen, hasp = seqpos > 0;
            if (row + 1 < nrows) CONV_U(un, row + 1);
            const v4u bw = *(const v4u*)(Z + (size_t)row * ZO + 672 + c0);
            float cv[8];
#pragma unroll
            for (int j = 0; j < 8; ++j) cv[j] = (hasp ? up[j] * w0[j] : 0.f) + uc[j] * w1[j] + (hasn ? un[j] * w2[j] : 0.f);
            float o[8] = {bflo(bw.x) * cv[0], bfhi(bw.x) * cv[1], bflo(bw.y) * cv[2], bfhi(bw.y) * cv[3], bflo(bw.z) * cv[4], bfhi(bw.z) * cv[5], bflo(bw.w) * cv[6], bfhi(bw.w) * cv[7]};
            store_bf16<8>(OS + (size_t)row * 1024 + 512 + c0, o);
#pragma unroll
            for (int j = 0; j < 8; ++j) { up[j] = uc[j]; uc[j] = un[j]; }
        }
#undef CONV_U
    }
}

struct Args { const float* in[26]; float* out; unsigned char* ws; int ph_lo, ph_hi; };
constexpr int NPHASE = 2 + DEPTH * 9;

__global__ void __launch_bounds__(NT, 2) mk_fwd(Args args) {
    extern __shared__ __attribute__((aligned(16))) unsigned char lds[];
    Frame F;
    F.lds = (LAS unsigned char*)lds;
    F.tid = threadIdx.x; F.lane = F.tid & 63; F.wave = __builtin_amdgcn_readfirstlane(F.tid >> 6);
    F.G = gridDim.x; { const int bx = blockIdx.x; F.vcu = (F.G % 8 == 0) ? (bx % 8) * (F.G / 8) + bx / 8 : bx; }
    F.out = args.out; F.ws = args.ws;
    for (int u = F.tid; u < (LDS_BYTES - LDSCTL_OFF) / 4; u += NT) ((LAS unsigned*)(F.lds + LDSCTL_OFF))[u] = 0u;
    __syncthreads();
    if (F.tid < 26) ((LAS unsigned long long*)(F.lds + LDSCTL_OFF))[F.tid] = (unsigned long long)args.in[F.tid];
    __syncthreads();
    volatile LAS unsigned* MISC = (volatile LAS unsigned*)(F.lds + MISC_OFF);
    XcdBarrier bar; bar.bar = (unsigned*)(F.ws + WS_CTL) + CW_BAR; bar.x = 0; bar.st = nullptr;
    if (!MK_PER_PHASE) bar = xcd_barrier_post((unsigned*)(F.ws + WS_CTL) + CW_BAR, MISC + 8);
    const int lo = args.ph_lo, hi = args.ph_hi;
#ifndef PH_MASK
#define PH_MASK 0x3ff
#endif
#define EN(b) ((PH_MASK >> (b)) & 1)
#define LAUNDER() do { int w_ = F.wave, c_ = F.vcu; asm volatile("" : "+v"(F.tid), "+v"(F.lane), "+v"(w_), "+v"(c_)); F.wave = __builtin_amdgcn_readfirstlane(w_); F.vcu = __builtin_amdgcn_readfirstlane(c_); } while (0)
#define REP(k) for (int rep_ = 0; rep_ < (((REPEAT_MASK >> (k)) & 1) ? 2 : 1); ++rep_, __syncthreads())
#define IN(k) (lo <= (k) && (k) < hi)
#define SEAM(k) do { if (IN(k) && IN((k) + 1)) { if (!MK_PER_PHASE) { xcd_barrier(bar); if ((REPEAT_MASK >> 14) & 1) xcd_barrier(bar); } } } while (0)

    if (EN(0) && IN(0)) { REP(0) { LAUNDER(); p0_prologue(F); } SEAM(0); }
#pragma unroll 1
    for (int layer = 0; layer < DEPTH; ++layer) {
        const int pb = 1 + 9 * layer, i2 = layer >> 1; const bool odd = layer & 1;
        const bool need_ctx = layer < DEPTH - 1;
        const int MR = need_ctx ? MT : NLAT;
        unsigned char* wsm = F.ws + WS_WSMALL;
        if (((REPEAT_MASK >> 15) & 1) && layer > 0 && EN(1) && IN(pb + 0)) { LAUNDER(); n1_phase(F, layer, true); __syncthreads(); }
        if (EN(1) && IN(pb + 0)) { for (int rep_ = 0; rep_ < ((((REPEAT_MASK >> 1) & 1) && layer == 0) ? 9 : 1); ++rep_, __syncthreads()) { LAUNDER(); n1_phase(F, layer); } SEAM(pb + 0); }
        if (EN(2) && IN(pb + 1)) {
            REP(2) {
            LAUNDER();
            if (!odd) { EpiInEven E{(bf16*)(F.ws + WS_Z), (const float*)(F.ws + WS_TAB), (const float*)(F.ws + WS_TAB) + 4096 * 32};
                if constexpr (MFMA_MASK & 1) { pg8::Gemm g{(const bf16*)(F.ws + WS_H), (const bf16*)(wsm + OFF_WINE + i2 * SZ_WINE), D, D, D, nullptr}; pg8::StaticOrder S; S.init(MT, ZE, F.G, (int)blockIdx.x, 0);
                    if (((REPEAT_MASK >> 17) & 1) && rep_ == 0) { EpiNull EN_; pg8::gemm_phase<false, 0, false, false>(F.lds, g, S, EN_, F.tid); }
                    else pg8::gemm_phase<false, 0, false, false>(F.lds, g, S, E, F.tid); }
                else simple_gemm<false, 0>(F, MT, ZE, D, ARowsPlain{(const bf16*)(F.ws + WS_H), D}, (const bf16*)(wsm + OFF_WINE + i2 * SZ_WINE), D, 0, E); }
            else { EpiInOdd E{(bf16*)(F.ws + WS_Z), (const float*)(F.ws + WS_TAB) + 2 * 4096 * 32, (const float*)(F.ws + WS_TAB) + 2 * 4096 * 32 + 4096 * 16, (unsigned long long*)(F.ws + WS_RS + (rep_ ? MiB : 0))};
                if constexpr (MFMA_MASK & 2) { pg8::Gemm g{(const bf16*)(F.ws + WS_H), (const bf16*)(wsm + OFF_WINO + i2 * SZ_WINO), D, D, D, nullptr}; pg8::StaticOrder S; S.init(MT, ZO, F.G, (int)blockIdx.x, 0);
                    pg8::gemm_phase<false, 1, false, false>(F.lds, g, S, E, F.tid); }
                else simple_gemm<false, 1>(F, MT, ZO, D, ARowsPlain{(const bf16*)(F.ws + WS_H), D}, (const bf16*)(wsm + OFF_WINO + i2 * SZ_WINO), D, 0, E); }
            }
            SEAM(pb + 1);
        }
        if (EN(3) && IN(pb + 2) && odd) {
            REP(3) {
            LAUNDER();
            EpiUpQ Eq{(bf16*)(F.ws + WS_Q), (const float*)(F.ws + WS_TAB) + 2 * 4096 * 32, (const float*)(F.ws + WS_TAB) + 2 * 4096 * 32 + 4096 * 16, (const unsigned long long*)(F.ws + WS_RS)};
            EpiUpKV Ek{(bf16*)(F.ws + WS_KV), (const unsigned long long*)(F.ws + WS_RS)};
            if constexpr (MFMA_MASK & 4) {
                { pg8::Gemm g{(const bf16*)(F.ws + WS_Z) + 256, (const bf16*)(wsm + OFF_WUQ + i2 * SZ_WUQ), ZO, 384, 384, nullptr}; pg8::StaticOrder S; S.init(MR, 768, F.G, (int)blockIdx.x, 0);
                  pg8::gemm_phase<false, 0, false, false>(F.lds, g, S, Eq, F.tid); }
                LAUNDER();
                { pg8::Gemm g{(const bf16*)(F.ws + WS_Z), (const bf16*)(wsm + OFF_WUKV + i2 * SZ_WUKV), ZO, 256, 256, nullptr}; pg8::StaticOrder S; S.init(MT, 1024, F.G, (int)blockIdx.x, 0);
                  pg8::gemm_phase<false, 0, false, false>(F.lds, g, S, Ek, F.tid); }
            } else {
                simple_gemm<false, 0>(F, MR, 768, 384, ARowsPlain{(const bf16*)(F.ws + WS_Z) + 256, ZO}, (const bf16*)(wsm + OFF_WUQ + i2 * SZ_WUQ), 384, 0, Eq);
                simple_gemm<false, 0>(F, MT, 1024, 256, ARowsPlain{(const bf16*)(F.ws + WS_Z), ZO}, (const bf16*)(wsm + OFF_WUKV + i2 * SZ_WUKV), 256, 0, Ek);
            }
            }
            SEAM(pb + 2);
        }
        if (EN(4) && IN(pb + 3)) {
            REP(4) {
            LAUNDER();
            if (!odd) { REP(10) { if constexpr (MFMA_ATT & 1) mfma_attn_even(F, layer); else simple_attn<false>(F, layer); } __syncthreads(); REP(11) { LAUNDER(); if constexpr (MFMA_SGU) mfma_sgu(F, layer); else simple_sgu(F, layer); } }
            else { REP(12) { if constexpr (MFMA_ATT & 2) mfma_attn_odd(F, layer); else simple_attn<true>(F, layer); } REP(13) { LAUNDER(); simple_conv(F, layer); } }
            }
            SEAM(pb + 3);
        }
        if (EN(5) && IN(pb + 4)) {
            LAUNDER();
            EpiOut E{(bf16*)(F.ws + WS_X), (const float*)(F.ws + WS_MODV) + (size_t)layer * 9 * 6144};
            if constexpr (MFMA_MASK & 8) { pg8::Gemm g{(const bf16*)(F.ws + WS_H), (const bf16*)(wsm + (odd ? OFF_WOUTO : OFF_WOUTE) + i2 * SZ_WOUT), D, D, D, nullptr}; pg8::StaticOrder S; S.init(MR, D, F.G, (int)blockIdx.x, 0);
                if constexpr ((REPEAT_MASK >> 5) & 1) { EpiOut E2{(bf16*)(F.ws + WS_X + 68 * MiB), E.mod}; pg8::gemm_phase<false, 0, false, false>(F.lds, g, S, E2, F.tid); __syncthreads(); LAUNDER(); }
                pg8::gemm_phase<false, 0, false, false>(F.lds, g, S, E, F.tid); CONV_TAIL(S, layer, 0, 36); if constexpr ((REPEAT_MASK >> 16) & 1) { __syncthreads(); CONV_TAIL(S, layer, 0, 36); }
}
            else simple_gemm<false, 0>(F, MR, D, D, ARowsPlain{(const bf16*)(F.ws + WS_H), D}, (const bf16*)(wsm + (odd ? OFF_WOUTO : OFF_WOUTE) + i2 * SZ_WOUT), D, 0, E);
            SEAM(pb + 4);
        }
        if (EN(6) && IN(pb + 5)) { REP(6) { LAUNDER(); if constexpr (FP8_F1 && N2_MFMA) n2_phase_mfma(F, layer); else n2_phase(F, layer); } SEAM(pb + 5); }
        if (EN(7) && IN(pb + 6)) { REP(7) { LAUNDER(); topk_phase(F, layer); } SEAM(pb + 6); }
        if (EN(8) && IN(pb + 7)) {
            REP(8) {
            LAUNDER();
            EpiF1 E{(bf16*)(F.ws + WS_Z)};
            constexpr int KU = FP8_F1 ? D / 2 : D;
            if constexpr (MFMA_MASK & 16) { pg8::Gemm g{(const bf16*)(F.ws + WS_H), (const bf16*)(F.ws + WS_W13 + (size_t)layer * 16 * (FP8_F1 ? SZ_W13 / 2 : SZ_W13)), KU, KU, KU, (const int*)(F.ws + WS_SRC)}; pg8::StaticOrder S; S.init(need_ctx ? GROWS : NE * BATCH * CAP_L, 2048, F.G, (int)blockIdx.x, 2048, need_ctx ? 0 : 1);
                pg8::gemm_phase<true, 0, true, FP8_F1 != 0>(F.lds, g, S, E, F.tid); CONV_TAIL(S, layer, 36, 45); }
            else simple_gemm<true, 0>(F, GROWS, 2048, D, ARowsGather{(const bf16*)(F.ws + WS_H), D, (const int*)(F.ws + WS_SRC)}, (const bf16*)(F.ws + WS_W13 + (size_t)layer * 16 * SZ_W13), D, 2048, E);
            }
            SEAM(pb + 7);
        }
        if (EN(9) && IN(pb + 8)) {
            REP(9) {
            LAUNDER();
            EpiF2 E{(bf16*)(F.ws + WS_Y)};
            constexpr int KU = FP8_F2 ? FF / 2 : FF;
            if constexpr (MFMA_MASK & 32) { pg8::Gemm g{(const bf16*)(F.ws + WS_Z), (const bf16*)(F.ws + WS_W2 + (size_t)layer * 16 * (FP8_F2 ? SZ_W2 / 2 : SZ_W2)), KU, KU, KU, nullptr}; pg8::StaticOrder S; S.init(need_ctx ? GROWS : NE * BATCH * CAP_L, D, F.G, (int)blockIdx.x, 1024, need_ctx ? 0 : 1);
                if (((REPEAT_MASK >> 17) & 1) && rep_ == 0) { EpiNull EN_; pg8::gemm_phase<false, 0, false, FP8_F2 != 0>(F.lds, g, S, EN_, F.tid); }
                else { pg8::gemm_phase<false, 0, false, FP8_F2 != 0>(F.lds, g, S, E, F.tid); CONV_TAIL(S, layer, 45, 64); } }
            else simple_gemm<false, 0>(F, GROWS, D, FF, ARowsPlain{(const bf16*)(F.ws + WS_Z), FF}, (const bf16*)(F.ws + WS_W2 + (size_t)layer * 16 * SZ_W2), FF, 1024, E);
            }
            SEAM(pb + 8);
        }
    }
    if (EN(1) && IN(NPHASE - 1)) { LAUNDER(); n1_phase(F, 4); }
#undef IN
#undef SEAM
}

extern "C" void kernel_launch(void* const* d_in, const int* in_sizes, int n_in, void* d_out, int out_size, void* d_ws, size_t ws_size, hipStream_t stream) {
    static int grid = 0;
    if (grid == 0) {
        if (n_in != 26 || out_size != NLAT * D || ws_size < WS_END) { fprintf(stderr, "kernel_launch: unexpected problem (n_in %d out %d ws %zu)\n", n_in, out_size, ws_size); grid = -1; return; }
        int dev = 0, cus = 0, per_cu = 0;
        if (hipGetDevice(&dev) != hipSuccess || hipDeviceGetAttribute(&cus, hipDeviceAttributeMultiprocessorCount, dev) != hipSuccess) { grid = -1; return; }
        if (hipFuncSetAttribute((const void*)mk_fwd, hipFuncAttributeMaxDynamicSharedMemorySize, LDS_BYTES) != hipSuccess) { grid = -1; return; }
        if (hipOccupancyMaxActiveBlocksPerMultiprocessor(&per_cu, (const void*)mk_fwd, NT, LDS_BYTES) != hipSuccess || per_cu < 1) fprintf(stderr, "kernel_launch: occupancy query says %d\n", per_cu);
        (void)hipGetLastError();
        grid = cus;
    }
    if (grid < 0) return;
    if (hipMemsetAsync((char*)d_ws + WS_CTL, 0, CTL_ZERO_BYTES, stream) != hipSuccess) return;
    Args a{};
    for (int i = 0; i < 26; ++i) a.in[i] = (const float*)d_in[i];
    a.out = (float*)d_out; a.ws = (unsigned char*)d_ws;
#if MK_PER_PHASE
    for (int p = 0; p < NPHASE; ++p) {
        if (p >= 1 && p < NPHASE - 1 && ((p - 1) % 9) == 2 && (((p - 1) / 9) & 1) == 0) continue;
        a.ph_lo = p; a.ph_hi = p + 1;
        hipLaunchKernelGGL(mk_fwd, dim3(grid), dim3(NT), LDS_BYTES, stream, a);
    }
#else
    a.ph_lo = 0; a.ph_hi = NPHASE;
    hipLaunchKernelGGL(mk_fwd, dim3(grid), dim3(NT), LDS_BYTES, stream, a);
#endif
}
```
